# Optimizing an MI355X kernel written in HIP

```python
import jax, jax.numpy as jnp
from jax import lax
import numpy as np

D_MODEL = 1024
BATCH = 16
SEQ = 2048
DEPTH = 1

MEM_LEN = 256
EPS = 1e-6

NSA_HEADS = 8
NSA_KV_GROUPS = 2
NSA_HEAD_DIM = 128
CMP_BLOCK = 32
CMP_STRIDE = 16
CMP_HIDDEN = 256
SEL_BLOCK = 64
N_SELECT = 16
WINDOW = 512
Q_BLOCK = 128
ROPE_THETA = 500000.0
ROT_DIM = NSA_HEAD_DIM // 4

RET_HEADS = 4
RET_QK_DIM = 64
RET_V_DIM = 128
RET_CHUNK = 128
RET_THETA = 10000.0

MEM_HEADS = 4
MEM_HEAD_DIM = 128

NSA_WIDTH = NSA_HEADS * NSA_HEAD_DIM
RET_WIDTH = RET_HEADS * RET_V_DIM
MEM_WIDTH = MEM_HEADS * MEM_HEAD_DIM
MIX_WIDTH = NSA_WIDTH + RET_WIDTH + MEM_WIDTH
NSA_KV_WIDTH = NSA_KV_GROUPS * NSA_HEAD_DIM
IN_SPLITS = (NSA_WIDTH, 3 * 2 * NSA_KV_WIDTH, 3 * NSA_HEADS, RET_HEADS * RET_QK_DIM,
             RET_HEADS * RET_QK_DIM, RET_WIDTH, MEM_WIDTH, MIX_WIDTH)
IN_WIDTH = 6168

kernel_name = "hymba_nsa_retention_memory_layer"


def rms_norm(x, g):
    xf = x.astype(jnp.float32)
    y = xf * lax.rsqrt(jnp.mean(xf * xf, axis=-1, keepdims=True) + EPS)
    return (y * g.astype(jnp.float32)).astype(x.dtype)


def rotary(x, pos, rot_dim, theta):
    half = rot_dim // 2
    inv_freq = theta ** (-jnp.arange(half, dtype=jnp.float32) / half)
    ang = pos.astype(jnp.float32)[..., None] * inv_freq
    cos, sin = jnp.cos(ang), jnp.sin(ang)
    x1 = x[..., :half].astype(jnp.float32)
    x2 = x[..., half:rot_dim].astype(jnp.float32)
    out = jnp.concatenate([x1 * cos - x2 * sin, x1 * sin + x2 * cos,
                           x[..., rot_dim:].astype(jnp.float32)], axis=-1)
    return out.astype(x.dtype)


def masked_softmax(s, mask):
    s = jnp.where(mask, s.astype(jnp.float32), -jnp.inf)
    m = jnp.max(s, axis=-1, keepdims=True)
    m = jnp.where(jnp.isfinite(m), m, 0.0)
    p = jnp.exp(s - m)
    return p / jnp.maximum(jnp.sum(p, axis=-1, keepdims=True), 1e-30)


def compress_blocks(k, pos_emb, w1, w2):
    B, G, T, dh = k.shape
    n_cmp = (T - CMP_BLOCK) // CMP_STRIDE + 1
    idx = np.arange(n_cmp)[:, None] * CMP_STRIDE + np.arange(CMP_BLOCK)[None, :]
    blocks = k[:, :, idx] + pos_emb.astype(k.dtype)
    h = jax.nn.gelu(blocks.reshape(B, G, n_cmp, CMP_BLOCK * dh) @ w1)
    return h @ w2


def nsa_heads(q, k_cmp, v_cmp, k_slc, v_slc, k_win, v_win, gates,
              cmp_pos_k, cmp_w1_k, cmp_w2_k, cmp_pos_v, cmp_w1_v, cmp_w2_v):
    B, G, R, T, dh = q.shape
    scale = dh ** -0.5
    t = np.arange(T)

    n_cmp = (T - CMP_BLOCK) // CMP_STRIDE + 1
    cmp_start = np.arange(n_cmp) * CMP_STRIDE
    kc = compress_blocks(k_cmp, cmp_pos_k, cmp_w1_k, cmp_w2_k)
    vc = compress_blocks(v_cmp, cmp_pos_v, cmp_w1_v, cmp_w2_v)
    s = jnp.einsum('bgrtd,bgnd->bgrtn', q, kc) * scale
    p_cmp = masked_softmax(s, (cmp_start + CMP_BLOCK - 1)[None, :] <= t[:, None])
    o_cmp = jnp.einsum('bgrtn,bgnd->bgrtd', p_cmp.astype(vc.dtype), vc)

    n_sb = T // SEL_BLOCK
    sel_start = np.arange(n_sb) * SEL_BLOCK
    overlap = np.clip(np.minimum(cmp_start[:, None] + CMP_BLOCK, sel_start[None, :] + SEL_BLOCK)
                      - np.maximum(cmp_start[:, None], sel_start[None, :]), 0, None)
    overlap = jnp.asarray(overlap.astype(np.float32) / CMP_BLOCK)
    imp = jnp.einsum('bgrtn,nj->bgtj', p_cmp, overlap)
    blk = np.arange(n_sb)[None, :]
    cur = (t // SEL_BLOCK)[:, None]
    forced = (blk == 0) | (blk == cur) | (blk == cur - 1)
    valid = blk * SEL_BLOCK <= t[:, None]
    imp = jnp.where(forced, jnp.inf, jnp.where(valid, imp, -jnp.inf))
    n_sel = min(N_SELECT, n_sb)
    _, sel_idx = lax.top_k(imp, n_sel)

    kb_slc = k_slc.reshape(B, G, n_sb, SEL_BLOCK, dh)
    vb_slc = v_slc.reshape(B, G, n_sb, SEL_BLOCK, dh)
    k_win_pad = jnp.pad(k_win, ((0, 0), (0, 0), (WINDOW, 0), (0, 0)))
    v_win_pad = jnp.pad(v_win, ((0, 0), (0, 0), (WINDOW, 0), (0, 0)))
    nqb = T // Q_BLOCK
    gather = jax.vmap(lambda kg, ig: kg[ig])

    def one_block(item):
        b = item // nqb
        t0 = (item % nqb) * Q_BLOCK
        qb = lax.dynamic_slice_in_dim(q[b], t0, Q_BLOCK, axis=2)
        tq = t0 + jnp.arange(Q_BLOCK)
        idx = lax.dynamic_slice_in_dim(sel_idx[b], t0, Q_BLOCK, axis=1)
        ks = gather(kb_slc[b], idx).reshape(G, Q_BLOCK, n_sel * SEL_BLOCK, dh)
        vs = gather(vb_slc[b], idx).reshape(G, Q_BLOCK, n_sel * SEL_BLOCK, dh)
        kpos = (idx[..., None] * SEL_BLOCK + jnp.arange(SEL_BLOCK)).reshape(G, Q_BLOCK, -1)
        s_sl = jnp.einsum('grqd,gqkd->grqk', qb, ks) * scale
        p_sl = masked_softmax(s_sl, (kpos <= tq[None, :, None])[:, None])
        o_sl = jnp.einsum('grqk,gqkd->grqd', p_sl.astype(vs.dtype), vs)
        kw = lax.dynamic_slice_in_dim(k_win_pad[b], t0, Q_BLOCK + WINDOW, axis=1)
        vw = lax.dynamic_slice_in_dim(v_win_pad[b], t0, Q_BLOCK + WINDOW, axis=1)
        kwpos = t0 - WINDOW + jnp.arange(Q_BLOCK + WINDOW)
        rel = tq[:, None] - kwpos[None, :]
        mask_w = (rel >= 0) & (rel < WINDOW) & (kwpos[None, :] >= 0)
        s_w = jnp.einsum('grqd,gkd->grqk', qb, kw) * scale
        p_w = masked_softmax(s_w, mask_w)
        o_w = jnp.einsum('grqk,gkd->grqd', p_w.astype(vw.dtype), vw)
        return o_sl, o_w

    o_slc, o_win = lax.map(one_block, jnp.arange(B * nqb))

    def unblock(o):
        return o.reshape(B, nqb, G, R, Q_BLOCK, dh).transpose(0, 2, 3, 1, 4, 5).reshape(B, G, R, T, dh)

    o_slc, o_win = unblock(o_slc), unblock(o_win)
    g = gates.reshape(B, T, 3, G, R).transpose(2, 0, 3, 4, 1)[..., None]
    o = g[0] * o_cmp + g[1] * o_slc + g[2] * o_win
    return o.transpose(0, 3, 1, 2, 4).reshape(B, T, G * R * dh)


def retention_heads(q, k, v, pos, gn_gain):
    B, H, T, dk = q.shape
    dv = v.shape[-1]
    q = rotary(q, pos, dk, RET_THETA)
    k = rotary(k, pos, dk, RET_THETA) * (dk ** -0.5)
    log_gamma = jnp.log1p(-(2.0 ** (-5.0 - jnp.arange(H, dtype=jnp.float32))))
    C = RET_CHUNK
    n = jnp.arange(C, dtype=jnp.float32)
    diff = n[:, None] - n[None, :]
    decay = jnp.where(diff >= 0, jnp.exp(log_gamma[:, None, None] * jnp.maximum(diff, 0.0)), 0.0)
    xi = jnp.exp(log_gamma[:, None] * (n + 1.0))[..., None]
    zeta = jnp.exp(log_gamma[:, None] * (C - 1.0 - n))[..., None]
    gamma_c = jnp.exp(log_gamma * C)[:, None, None]
    nc = T // C

    def to_chunks(a):
        return a.reshape(B, H, nc, C, a.shape[-1]).transpose(2, 0, 1, 3, 4)

    def step(state, inp):
        qc, kc, vc = inp
        inner = jnp.einsum('bhnd,bhmd->bhnm', qc, kc) * decay
        out = (jnp.einsum('bhnm,bhme->bhne', inner, vc)
               + jnp.einsum('bhnd,bhde->bhne', qc, state) * xi)
        state = state * gamma_c + jnp.einsum('bhmd,bhme->bhde', kc * zeta, vc)
        return state, out

    state0 = jnp.zeros((B, H, dk, dv), jnp.float32)
    _, o = lax.scan(step, state0, (to_chunks(q), to_chunks(k), to_chunks(v)))
    o = o.transpose(1, 0, 3, 2, 4).reshape(B, T, H, dv).astype(jnp.float32)
    mu = jnp.mean(o, axis=-1, keepdims=True)
    var = jnp.mean(jnp.square(o - mu), axis=-1, keepdims=True)
    o = ((o - mu) * lax.rsqrt(var + EPS)).reshape(B, T, H * dv) * gn_gain.astype(jnp.float32)
    return o.astype(v.dtype)


def memory_heads(qm, mem_n, w_mem_kv):
    B, M, _ = mem_n.shape
    kv = (mem_n @ w_mem_kv).reshape(B, M, 2, MEM_HEADS, MEM_HEAD_DIM)
    km, vm = kv[:, :, 0], kv[:, :, 1]
    s = jnp.einsum('bthd,bmhd->bhtm', qm, km) * (MEM_HEAD_DIM ** -0.5)
    p = jax.nn.softmax(s.astype(jnp.float32), axis=-1)
    o = jnp.einsum('bhtm,bmhd->bthd', p.astype(vm.dtype), vm)
    return o.reshape(B, qm.shape[1], MEM_WIDTH)


def hybrid_layer(x, mem, positions, norm_pre, w_in, cmp_pos_k, cmp_w1_k, cmp_w2_k,
                 cmp_pos_v, cmp_w1_v, cmp_w2_v, ret_gn, mem_norm, w_mem_kv, w_out, norm_post):
    B, T, _ = x.shape
    h = rms_norm(x, norm_pre)
    z = h @ w_in
    q_nsa, kv_nsa, g_nsa, q_ret, k_ret, v_ret, q_mem, gate = jnp.split(
        z, list(np.cumsum(IN_SPLITS)[:-1]), axis=-1)

    R = NSA_HEADS // NSA_KV_GROUPS
    q_nsa = q_nsa.reshape(B, T, NSA_KV_GROUPS, R, NSA_HEAD_DIM).transpose(0, 2, 3, 1, 4)
    q_nsa = rotary(q_nsa, positions[:, None, None, :], ROT_DIM, ROPE_THETA)
    kvn = kv_nsa.reshape(B, T, 3, 2, NSA_KV_GROUPS, NSA_HEAD_DIM).transpose(2, 3, 0, 4, 1, 5)
    kpos = positions[:, None, :]
    k_cmp = rotary(kvn[0, 0], kpos, ROT_DIM, ROPE_THETA)
    k_slc = rotary(kvn[1, 0], kpos, ROT_DIM, ROPE_THETA)
    k_win = rotary(kvn[2, 0], kpos, ROT_DIM, ROPE_THETA)
    gates = jax.nn.sigmoid(g_nsa).reshape(B, T, 3, NSA_HEADS)
    o_nsa = nsa_heads(q_nsa, k_cmp, kvn[0, 1], k_slc, kvn[1, 1], k_win, kvn[2, 1], gates,
                      cmp_pos_k, cmp_w1_k, cmp_w2_k, cmp_pos_v, cmp_w1_v, cmp_w2_v)

    q_ret = q_ret.reshape(B, T, RET_HEADS, RET_QK_DIM).transpose(0, 2, 1, 3)
    k_ret = k_ret.reshape(B, T, RET_HEADS, RET_QK_DIM).transpose(0, 2, 1, 3)
    v_ret = v_ret.reshape(B, T, RET_HEADS, RET_V_DIM).transpose(0, 2, 1, 3)
    o_ret = retention_heads(q_ret, k_ret, v_ret, positions[:, None, :], ret_gn)

    o_mem = memory_heads(q_mem.reshape(B, T, MEM_HEADS, MEM_HEAD_DIM), rms_norm(mem, mem_norm), w_mem_kv)

    mixed = jnp.concatenate([o_nsa, o_ret, o_mem], axis=-1) * jax.nn.silu(gate)
    y = mixed @ w_out
    return x + rms_norm(y, norm_post)


def setup_inputs(seed: int = 0) -> dict:
    key = jax.random.key(seed)
    ks = jax.random.split(key, 20)
    f32 = jnp.float32

    def w(k, shape, fan_in):
        return jax.random.normal(k, shape, f32) * (fan_in ** -0.5)

    def gain(k, shape):
        return 1.0 + 0.05 * jax.random.normal(k, shape, f32)

    x = jax.random.normal(ks[0], (BATCH, SEQ, D_MODEL), f32)
    mem = jax.random.normal(ks[1], (BATCH, MEM_LEN, D_MODEL), f32)
    offsets = jax.random.randint(ks[2], (BATCH, 1), 0, 1024, dtype=jnp.int32)
    positions = (offsets + jnp.arange(SEQ, dtype=jnp.int32)[None, :]).astype(jnp.int32)
    L = DEPTH
    return {
        "x": x,
        "mem": mem,
        "positions": positions,
        "norm_pre": gain(ks[3], (L, D_MODEL)),
        "w_in": w(ks[4], (L, D_MODEL, IN_WIDTH), D_MODEL),
        "cmp_pos_k": 0.1 * jax.random.normal(ks[5], (L, CMP_BLOCK, NSA_HEAD_DIM), f32),
        "cmp_w1_k": w(ks[6], (L, CMP_BLOCK * NSA_HEAD_DIM, CMP_HIDDEN), CMP_BLOCK * NSA_HEAD_DIM),
        "cmp_w2_k": w(ks[7], (L, CMP_HIDDEN, NSA_HEAD_DIM), CMP_HIDDEN),
        "cmp_pos_v": 0.1 * jax.random.normal(ks[8], (L, CMP_BLOCK, NSA_HEAD_DIM), f32),
        "cmp_w1_v": w(ks[9], (L, CMP_BLOCK * NSA_HEAD_DIM, CMP_HIDDEN), CMP_BLOCK * NSA_HEAD_DIM),
        "cmp_w2_v": w(ks[10], (L, CMP_HIDDEN, NSA_HEAD_DIM), CMP_HIDDEN),
        "ret_gn": gain(ks[11], (L, RET_WIDTH)),
        "mem_norm": gain(ks[12], (L, D_MODEL)),
        "w_mem_kv": w(ks[13], (L, D_MODEL, 2 * MEM_WIDTH), D_MODEL),
        "w_out": w(ks[14], (L, MIX_WIDTH, D_MODEL), MIX_WIDTH),
        "norm_post": gain(ks[15], (L, D_MODEL)),
    }


def reference(x, mem, positions, norm_pre, w_in, cmp_pos_k, cmp_w1_k, cmp_w2_k,
              cmp_pos_v, cmp_w1_v, cmp_w2_v, ret_gn, mem_norm, w_mem_kv, w_out, norm_post):
    for layer in range(DEPTH):
        x = hybrid_layer(x, mem, positions, norm_pre[layer], w_in[layer],
                         cmp_pos_k[layer], cmp_w1_k[layer], cmp_w2_k[layer],
                         cmp_pos_v[layer], cmp_w1_v[layer], cmp_w2_v[layer],
                         ret_gn[layer], mem_norm[layer], w_mem_kv[layer],
                         w_out[layer], norm_post[layer])
    return x
```

```cpp
#include <hip/hip_runtime.h>
#include <hip/hip_cooperative_groups.h>
#include <cstdio>
#include <cstdint>
namespace cg = cooperative_groups;

#ifndef MEGA
#define MEGA 1
#endif
#ifndef PROBE_DUP
#define PROBE_DUP -1
#endif
#ifndef PROBE_ATT
#define PROBE_ATT 1
#endif

typedef _Float16 f16;
typedef _Float16 f16x8 __attribute__((ext_vector_type(8)));
typedef _Float16 f16x4 __attribute__((ext_vector_type(4)));
typedef float f32x16 __attribute__((ext_vector_type(16)));
typedef float f32x4 __attribute__((ext_vector_type(4)));
#define DI __device__ __forceinline__
#define MFMA(a, b, c) __builtin_amdgcn_mfma_f32_32x32x16_f16((a), (b), (c), 0, 0, 0)
#define SBAR() __builtin_amdgcn_sched_barrier(0)
#define LAS __attribute__((address_space(3)))

constexpr int NB = 16, NT = 2048, DM = 1024, NTOK = NB * NT, ZW = 6144;
constexpr int ZC_QN = 0, ZC_KV = 1024, ZC_QR = 2560, ZC_KR = 2816, ZC_VR = 3072, ZC_QM = 3584, ZC_GATE = 4096;
constexpr float QSCALE = 0.08838834764831845f * 1.4426950408889634f;
constexpr float THR = 8.f;
constexpr float NEG = -1e30f;

constexpr size_t al256(size_t x) { return (x + 255) / 256 * 256; }
constexpr size_t WS_Z = 0;
constexpr size_t WS_GATES = WS_Z + (size_t)NTOK * ZW * 2;
constexpr size_t WS_WINT = WS_GATES + (size_t)NTOK * 24 * 4;
constexpr size_t WS_WOUTT = WS_WINT + al256((size_t)6168 * 1024 * 2);
constexpr size_t WS_WMEMT = WS_WOUTT + (size_t)1024 * 2048 * 2;
constexpr size_t WS_W1T = WS_WMEMT + (size_t)1024 * 1024 * 2;
constexpr size_t WS_W2T = WS_W1T + (size_t)2 * 256 * 4096 * 2;
constexpr size_t WS_MEMN = WS_W2T + (size_t)2 * 128 * 256 * 2;
constexpr size_t WS_KVM = WS_MEMN + (size_t)4096 * 1024 * 2;
constexpr size_t WS_ROT = WS_KVM + (size_t)4096 * 1024 * 2;
constexpr size_t WS_PB1 = WS_ROT + (size_t)NTOK * 48 * 2 * 4;
constexpr size_t WS_HID = WS_PB1 + (size_t)2 * 16 * 256 * 4;
constexpr size_t WS_KC = WS_HID + (size_t)2 * 4096 * 256 * 2;
constexpr size_t WS_PSS = WS_KC + (size_t)2 * 4096 * 128 * 2;
constexpr size_t WS_CTR = WS_PSS + (size_t)NTOK * 16 * 4;
constexpr size_t WS_BAR = WS_CTR + 4096;
constexpr size_t WS_Y = WS_BAR + 16384;
constexpr size_t WS_END = WS_Y + (size_t)NTOK * 1024 * 2;

constexpr int LDS_IMG = 8 * 128 * 144;
constexpr int LDS_BYTES = LDS_IMG + 64;

struct Params {
  const float* x; const float* mem; const int* pos; const float* norm_pre; const float* w_in;
  const float* cpk; const float* w1k; const float* w2k; const float* cpv; const float* w1v; const float* w2v;
  const float* ret_gn; const float* mem_norm; const float* w_mem_kv; const float* w_out; const float* norm_post;
  float* out; char* ws;
  int dry;
  int pad_;
};

DI int crow(int r, int h) { return (r & 3) + 8 * (r >> 2) + 4 * h; }
DI unsigned swz128(int r, int c) { return (unsigned)(r * 128 + ((c ^ ((r >> 1) & 7)) << 4)); }
DI unsigned off_a(int row, int ch) { return (unsigned)(2048 * (row >> 3) + 512 * (ch >> 2) + 64 * (row & 7) + 16 * ((ch & 3) ^ ((row >> 2) & 3))); }
DI float xhalf_max(float v) { auto rr = __builtin_amdgcn_permlane32_swap(__float_as_uint(v), __float_as_uint(v), false, false); return fmaxf(__uint_as_float(rr[0]), __uint_as_float(rr[1])); }
DI float xhalf_sum(float v) { auto rr = __builtin_amdgcn_permlane32_swap(__float_as_uint(v), __float_as_uint(v), false, false); return __uint_as_float(rr[0]) + __uint_as_float(rr[1]); }
DI float fexp2(float x) { return __builtin_amdgcn_exp2f(x); }
DI float sigmoidf_(float x) { return __builtin_amdgcn_rcpf(1.f + __expf(-x)); }
DI float siluf_(float x) { return x * __builtin_amdgcn_rcpf(1.f + __expf(-x)); }
DI float gelu_tanh(float x) { float u = 0.7978845608028654f * (x + 0.044715f * x * x * x); float e = __expf(2.f * u); float t = 1.f - 2.f / (e + 1.f); return 0.5f * x * (1.f + t); }
template <int OFF> DI f16x4 tr_read(unsigned addr) { f16x4 r; asm volatile("ds_read_b64_tr_b16 %0, %1 offset:%2" : "=&v"(r) : "v"(addr), "i"(OFF) : "memory"); return r; }

struct TrU { const float* src; f16* dst; int N, ldd, k0, n0, remap; };
DI void tr_decode(const Params& p, int u, TrU& t) {
  char* ws = p.ws;
  int kt, nt; t.remap = 0;
  if (u < 1552) { t.src = p.w_in; t.N = 6168; t.dst = (f16*)(ws + WS_WINT); t.ldd = 1024; kt = u / 97; nt = u - kt * 97; t.remap = 1; }
  else if (u < 2064) { u -= 1552; t.src = p.w_out; t.N = 1024; t.dst = (f16*)(ws + WS_WOUTT); t.ldd = 2048; kt = u >> 4; nt = u & 15; }
  else if (u < 2320) { u -= 2064; t.src = p.w_mem_kv; t.N = 1024; t.dst = (f16*)(ws + WS_WMEMT); t.ldd = 1024; kt = u >> 4; nt = u & 15; }
  else if (u < 2832) { u -= 2320; const int kv = u >> 8, v = u & 255; t.src = kv ? p.w1v : p.w1k; t.N = 256; t.dst = (f16*)(ws + WS_W1T) + (size_t)kv * 256 * 4096; t.ldd = 4096; kt = v >> 2; nt = v & 3; }
  else { u -= 2832; const int kv = u >> 3, v = u & 7; t.src = kv ? p.w2v : p.w2k; t.N = 128; t.dst = (f16*)(ws + WS_W2T) + (size_t)kv * 128 * 256; t.ldd = 256; kt = v >> 1; nt = v & 1; }
  t.k0 = kt * 64; t.n0 = nt * 64;
}
DI void tr_load(const TrU& t, float (&v)[8], int tid) {
#pragma unroll
  for (int i = 0; i < 8; ++i) { const int e = tid + 512 * i, kk = e >> 6, nn = e & 63; const int n = min(t.n0 + nn, t.N - 1); v[i] = t.src[(size_t)(t.k0 + kk) * t.N + n]; }
}
constexpr int N_TR_UNITS = 2848;

#define MFMA16(a, b, c) __builtin_amdgcn_mfma_f32_16x16x32_f16((a), (b), (c), 0, 0, 0)
DI void phase_prep(const Params& p, char* smem) {
  const int tid = threadIdx.x, lane = tid & 63, wid = tid >> 6;
  const int G = gridDim.x;
  char* ws = p.ws;
  if (blockIdx.x == 0 && tid < 128) ((unsigned*)(ws + WS_CTR))[tid] = 0u;
  {
    LAS unsigned char* lds_ = (LAS unsigned char*)smem;
    {
      float wv[48];
#pragma unroll
      for (int i = 0; i < 48; ++i) { const int e = tid + 512 * i, k = e / 24, n = e - 24 * k; wv[i] = p.w_in[(size_t)k * 6168 + 2560 + n]; }
#pragma unroll
      for (int i = 0; i < 48; ++i) { const int e = tid + 512 * i, k = e / 24, n = e - 24 * k; *(LAS f16*)(lds_ + 32768 + n * 2064 + k * 2) = (f16)wv[i]; }
    }
    for (int e = tid; e < 8 * 1032; e += 512) { const int n = 24 + e / 1032, k = e % 1032; *(LAS f16*)(lds_ + 32768 + n * 2064 + k * 2) = (f16)0.f; }
    __syncthreads();
  }
  {
    float* tile = (float*)smem;
    int u = blockIdx.x; TrU t; float v[8];
    if (u < N_TR_UNITS) { tr_decode(p, u, t); tr_load(t, v, tid); }
    while (u < N_TR_UNITS) {
#pragma unroll
      for (int i = 0; i < 8; ++i) { const int e = tid + 512 * i; tile[(e >> 6) * 65 + (e & 63)] = v[i]; }
      __syncthreads();
      TrU tn = t; const int un = u + G;
      if (un < N_TR_UNITS) { tr_decode(p, un, tn); tr_load(tn, v, tid); }
#pragma unroll
      for (int i = 0; i < 4; ++i) {
        const int e = tid + 512 * i, nn = e >> 5, kk = (e & 31) * 2; const int n = t.n0 + nn;
        if (n < t.N) {
          int nd = n;
          if (t.remap) nd = (n < 2560) ? n : ((n < 2584) ? (6144 + n - 2560) : (n - 24));
          typedef _Float16 h2 __attribute__((ext_vector_type(2)));
          h2 w; w[0] = (f16)tile[kk * 65 + nn]; w[1] = (f16)tile[(kk + 1) * 65 + nn];
          *(h2*)(t.dst + (size_t)nd * t.ldd + t.k0 + kk) = w;
        }
      }
      __syncthreads();
      t = tn; u = un;
    }
  }
  f16* H = (f16*)p.out; f16* MEMN = (f16*)(ws + WS_MEMN);
#define RMS_ROW(V, DST) do { float ss_ = 0.f; \
      _Pragma("unroll") for (int i = 0; i < 4; ++i) ss_ += V[i][0] * V[i][0] + V[i][1] * V[i][1] + V[i][2] * V[i][2] + V[i][3] * V[i][3]; \
      _Pragma("unroll") for (int o = 32; o >= 1; o >>= 1) ss_ += __shfl_xor(ss_, o); \
      const float rstd_ = rsqrtf(ss_ * (1.f / 1024.f) + 1e-6f); \
      _Pragma("unroll") for (int i = 0; i < 4; ++i) { f16x4 o4; o4[0] = (f16)(V[i][0] * rstd_ * gn[i][0]); o4[1] = (f16)(V[i][1] * rstd_ * gn[i][1]); o4[2] = (f16)(V[i][2] * rstd_ * gn[i][2]); o4[3] = (f16)(V[i][3] * rstd_ * gn[i][3]); \
        *(f16x4*)((DST) + i * 256 + lane * 4) = o4; } } while (0)
#define RMS_LOAD(V, SRC) do { _Pragma("unroll") for (int i = 0; i < 4; ++i) V[i] = *(const f32x4*)((SRC) + i * 256 + lane * 4); } while (0)
  {
    f32x4 gn[4];
#pragma unroll
    for (int i = 0; i < 4; ++i) gn[i] = *(const f32x4*)(p.norm_pre + i * 256 + lane * 4);
    f32x4 va[4], vb[4], na[4], nb[4];
    float* GATES = (float*)(ws + WS_GATES);
    LAS unsigned char* lds_ = (LAS unsigned char*)smem;
    const int fr = lane & 15, fq = lane >> 4;
    for (int gi = blockIdx.x; gi < NTOK / 128; gi += G) {
      const int rowbase = 128 * gi + 16 * wid;
      { const float* s0 = p.x + (size_t)rowbase * 1024; RMS_LOAD(va, s0); RMS_LOAD(vb, s0 + 1024); }
#define RMS_STEP(CA, CB, NA, NB, j_) do { \
        if ((j_) + 1 < 8) { const float* s0 = p.x + (size_t)(rowbase + 2 * ((j_) + 1)) * 1024; RMS_LOAD(NA, s0); RMS_LOAD(NB, s0 + 1024); } \
        f16* d0 = H + (size_t)(rowbase + 2 * (j_)) * 1024; \
        RMS_ROW(CA, d0); RMS_ROW(CB, d0 + 1024); } while (0)
#pragma unroll 1
      for (int j = 0; j < 8; j += 2) { RMS_STEP(va, vb, na, nb, j); RMS_STEP(na, nb, va, vb, j + 1); }
#undef RMS_STEP
      asm volatile("s_waitcnt vmcnt(0)" ::: "memory");
      const f16* hrow = H + (size_t)(rowbase + fr) * 1024 + 8 * fq;
      f32x4 g0 = {0.f, 0.f, 0.f, 0.f}, g1 = {0.f, 0.f, 0.f, 0.f};
#pragma unroll 1
      for (int k0 = 0; k0 < 32; k0 += 16) {
        f16x8 af[16];
#pragma unroll
        for (int k = 0; k < 16; ++k) af[k] = *(const f16x8*)(hrow + 32 * (k0 + k));
#pragma unroll
        for (int k = 0; k < 16; ++k) {
          const f16x8 b0 = *(const LAS f16x8*)(lds_ + 32768 + fr * 2064 + (32 * (k0 + k) + 8 * fq) * 2);
          const f16x8 b1 = *(const LAS f16x8*)(lds_ + 32768 + (16 + fr) * 2064 + (32 * (k0 + k) + 8 * fq) * 2);
          g0 = MFMA16(b0, af[k], g0); g1 = MFMA16(b1, af[k], g1);
        }
      }
      float* gp = GATES + (size_t)(rowbase + fr) * 24 + 4 * fq;
#pragma unroll
      for (int j = 0; j < 4; ++j) { g0[j] = sigmoidf_(g0[j]); g1[j] = sigmoidf_(g1[j]); }
      *(f32x4*)gp = g0;
      if (fq < 2) *(f32x4*)(gp + 16) = g1;
    }
  }
  {
    f32x4 gn[4];
#pragma unroll
    for (int i = 0; i < 4; ++i) gn[i] = *(const f32x4*)(p.mem_norm + i * 256 + lane * 4);
    for (int u = blockIdx.x; u < 4096 / 8; u += G) {
      f32x4 va[4]; const int row = u * 8 + wid;
      RMS_LOAD(va, p.mem + (size_t)row * 1024);
      RMS_ROW(va, MEMN + (size_t)row * 1024);
    }
  }
#undef RMS_ROW
#undef RMS_LOAD
  float* ROT = (float*)(ws + WS_ROT);
  for (int e = blockIdx.x * 512 + tid; e < NTOK * 48; e += G * 512) {
    int tok = e / 48, f = e - tok * 48;
    float invf;
    if (f < 16) invf = exp2f(-((float)f / 16.f) * 18.931568569324174f);
    else invf = exp2f(-((float)(f - 16) / 32.f) * 13.287712379549449f);
    const float ang = (float)p.pos[tok] * invf;
    float sn, cs; sincosf(ang, &sn, &cs);
    ROT[(size_t)e * 2] = cs; ROT[(size_t)e * 2 + 1] = sn;
  }
  float* PB1 = (float*)(ws + WS_PB1);
  for (int u = G - 1 - (int)blockIdx.x; u < 32; u += G) {
    const int kv = u >> 4, ch = u & 15; const float* w1 = kv ? p.w1v : p.w1k; const float* cp = kv ? p.cpv : p.cpk;
    const int i0 = ch * 256 + wid * 32;
    f32x4 acc = {0.f, 0.f, 0.f, 0.f};
#pragma unroll 16
    for (int i = 0; i < 32; ++i) { const float c = cp[i0 + i]; const f32x4 w = *(const f32x4*)(w1 + (size_t)(i0 + i) * 256 + lane * 4); acc[0] += c * w[0]; acc[1] += c * w[1]; acc[2] += c * w[2]; acc[3] += c * w[3]; }
    float* red = (float*)smem;
    *(f32x4*)(red + wid * 256 + lane * 4) = acc;
    __syncthreads();
    if (tid < 256) { float sacc = 0.f;
#pragma unroll
      for (int w = 0; w < 8; ++w) sacc += red[w * 256 + tid];
      PB1[(kv * 16 + ch) * 256 + tid] = sacc; }
    __syncthreads();
  }
}

template <class KA, class KB>
DI void gemm_core(f32x16 (&acc)[4][2], const char* baseA, long strideA, unsigned voffA, const char* baseB, long strideB, unsigned voffB,
                  KA koffA, KB koffB, int nk, char* smem) {
  int tid_ = threadIdx.x; asm volatile("" : "+v"(tid_)); const int tid = tid_, lane = tid & 63, wid = tid >> 6, wm = wid >> 2, wn = wid & 3;
  const int lr = tid >> 3, lc = tid & 7;
  const unsigned so = swz128(lr, lc);
  f16x8 ra[4], rb[4], sa[4], sb[4];
#define GLOAD(RA, RB, kt) do { const char* a_ = baseA + koffA(kt) * 2; const char* b_ = baseB + koffB(kt) * 2; \
    RA[0] = *(const f16x8*)(a_ + (size_t)voffA); RA[1] = *(const f16x8*)(a_ + strideA + (size_t)voffA); RA[2] = *(const f16x8*)(a_ + 2 * strideA + (size_t)voffA); RA[3] = *(const f16x8*)(a_ + 3 * strideA + (size_t)voffA); \
    RB[0] = *(const f16x8*)(b_ + (size_t)voffB); RB[1] = *(const f16x8*)(b_ + strideB + (size_t)voffB); RB[2] = *(const f16x8*)(b_ + 2 * strideB + (size_t)voffB); RB[3] = *(const f16x8*)(b_ + 3 * strideB + (size_t)voffB); } while (0)
#define LSTORE(RA, RB, st) do { char* b_ = smem + (st) * 65536 + so; \
    *(f16x8*)(b_) = RA[0]; *(f16x8*)(b_ + 8192) = RA[1]; *(f16x8*)(b_ + 16384) = RA[2]; *(f16x8*)(b_ + 24576) = RA[3]; \
    *(f16x8*)(b_ + 32768) = RB[0]; *(f16x8*)(b_ + 32768 + 8192) = RB[1]; *(f16x8*)(b_ + 32768 + 16384) = RB[2]; *(f16x8*)(b_ + 32768 + 24576) = RB[3]; } while (0)
  const int l31 = lane & 31, h = lane >> 5, xx = (l31 >> 1) & 7;
  const unsigned fbase = l31 * 128;
  unsigned cx[4];
#pragma unroll
  for (int s = 0; s < 4; ++s) cx[s] = (unsigned)(((2 * s + h) ^ xx) << 4);
#define COMPUTE(kt) do { \
      const char* A = smem + ((kt) & 1) * 65536 + (128 * wm) * 128 + fbase; \
      const char* Bm = smem + ((kt) & 1) * 65536 + 32768 + (64 * wn) * 128 + fbase; \
      _Pragma("unroll") for (int s = 0; s < 4; ++s) { \
        f16x8 hf[4], wf[2]; \
        _Pragma("unroll") for (int i = 0; i < 4; ++i) hf[i] = *(const f16x8*)(A + i * 4096 + cx[s]); \
        _Pragma("unroll") for (int j = 0; j < 2; ++j) wf[j] = *(const f16x8*)(Bm + j * 4096 + cx[s]); \
        _Pragma("unroll") for (int i = 0; i < 4; ++i) _Pragma("unroll") for (int j = 0; j < 2; ++j) acc[i][j] = MFMA(wf[j], hf[i], acc[i][j]); \
      } } while (0)
  GLOAD(ra, rb, 0); GLOAD(sa, sb, 1);
  LSTORE(ra, rb, 0); __syncthreads();
  for (int kt = 0; kt < nk; kt += 2) {
    if (kt + 2 < nk) GLOAD(ra, rb, kt + 2);
    COMPUTE(kt);
    LSTORE(sa, sb, 1);
    __syncthreads();
    if (kt + 3 < nk) GLOAD(sa, sb, kt + 3);
    COMPUTE(kt + 1);
    if (kt + 2 < nk) LSTORE(ra, rb, 0);
    __syncthreads();
  }
#undef GLOAD
#undef LSTORE
#undef COMPUTE
}

template <class XF>
DI void store_tile_f16(const f32x16 (&acc)[4][2], f16* dst, long ld, char* smem, bool active, XF xf) {
  int tid_ = threadIdx.x; asm volatile("" : "+v"(tid_)); const int tid = tid_, lane = tid & 63, wid = tid >> 6, wm = wid >> 2, wn = wid & 3, l31 = lane & 31, h = lane >> 5;
  char* img = smem + wid * (128 * 144);
#pragma unroll
  for (int i = 0; i < 4; ++i)
#pragma unroll
    for (int j = 0; j < 2; ++j)
#pragma unroll
      for (int g = 0; g < 4; ++g) {
        f16x4 v; v[0] = (f16)acc[i][j][4 * g]; v[1] = (f16)acc[i][j][4 * g + 1]; v[2] = (f16)acc[i][j][4 * g + 2]; v[3] = (f16)acc[i][j][4 * g + 3];
        *(f16x4*)(img + (32 * i + l31) * 144 + (32 * j + 8 * g + 4 * h) * 2) = v;
      }
  __syncthreads();
  if (active) {
    f16* d = dst + (long)(128 * wm) * ld + 64 * wn;
#pragma unroll 2
    for (int it = 0; it < 16; ++it) {
      const int row = it * 8 + (lane >> 3), ch = lane & 7;
      const char* rowp = img + row * 144;
      f16x8 v = *(const f16x8*)(rowp + ch * 16);
      v = xf(v, rowp, 128 * wm + row, wn, ch);
      *(f16x8*)(d + (long)row * ld + ch * 8) = v;
    }
  }
  __syncthreads();
}
struct XfNone { DI f16x8 operator()(f16x8 v, const char*, int, int, int) const { return v; } };
struct XfGelu { DI f16x8 operator()(f16x8 v, const char*, int, int, int) const { f16x8 r;
#pragma unroll
  for (int e = 0; e < 8; ++e) r[e] = (f16)gelu_tanh((float)v[e]);
  return r; } };
struct XfZ {
  int seg; const float* rot;
  DI f16x8 operator()(f16x8 v, const char* rowp, int trow, int wn, int ch) const {
    f16x8 r = v;
    if (seg == 6) {
#pragma unroll
      for (int e = 0; e < 8; ++e) r[e] = (f16)siluf_((float)v[e]);
    } else if (seg == 0 || seg == 1) {
      float sc = (seg == 0) ? QSCALE : 1.f;
      if (((wn & 1) == 0) && ch < 4) {
        const f16x8 pv = *(const f16x8*)(rowp + (ch ^ 2) * 16);
        const float* rp = rot + (size_t)trow * 96 + 16 * (ch & 1);
        const bool first = ch < 2;
#pragma unroll
        for (int e2 = 0; e2 < 4; ++e2) {
          const f32x4 cs = *(const f32x4*)(rp + 4 * e2);
#pragma unroll
          for (int q = 0; q < 2; ++q) {
            const int e = 2 * e2 + q; const float c = cs[2 * q], sn = cs[2 * q + 1];
            const float x1 = first ? (float)v[e] : (float)pv[e], x2 = first ? (float)pv[e] : (float)v[e];
            r[e] = (f16)((first ? (x1 * c - x2 * sn) : (x1 * sn + x2 * c)) * sc);
          }
        }
      } else {
#pragma unroll
        for (int e = 0; e < 8; ++e) r[e] = (f16)((float)v[e] * sc);
      }
    } else if (seg == 3 || seg == 4) {
      const float sc = (seg == 4) ? 0.125f : 1.f;
      const f16x8 pv = *(const f16x8*)(rowp + (ch ^ 4) * 16);
      const float* rp = rot + (size_t)trow * 96 + 32 + 16 * (ch & 3);
      const bool first = ch < 4;
#pragma unroll
      for (int e2 = 0; e2 < 4; ++e2) {
        const f32x4 cs = *(const f32x4*)(rp + 4 * e2);
#pragma unroll
        for (int q = 0; q < 2; ++q) {
          const int e = 2 * e2 + q; const float c = cs[2 * q], sn = cs[2 * q + 1];
          const float x1 = first ? (float)v[e] : (float)pv[e], x2 = first ? (float)pv[e] : (float)v[e];
          r[e] = (f16)((first ? (x1 * c - x2 * sn) : (x1 * sn + x2 * c)) * sc);
        }
      }
    } else if (seg == 5) {
#pragma unroll
      for (int e = 0; e < 8; ++e) r[e] = (f16)((float)v[e] * QSCALE);
    }
    return r;
  }
};

struct KStd { DI long operator()(int kt) const { return (long)kt * 64; } };
struct KCmp { DI long operator()(int kt) const { return (long)(kt >> 1) * ZW + (kt & 1) * 64; } };

DI void zero_acc(f32x16 (&acc)[4][2]) {
#pragma unroll
  for (int i = 0; i < 4; ++i)
#pragma unroll
    for (int j = 0; j < 2; ++j)
#pragma unroll
      for (int r = 0; r < 16; ++r) acc[i][j][r] = 0.f;
}


constexpr int HTB = 128 * 64 * 2;
DI int lds_byte(int r, int c) { const int st = (r >> 4) * 2 + (c >> 5), rr = r & 15, cc = c & 31, ob = rr * 64 + cc * 2; return st * 1024 + (ob ^ (((ob >> 9) & 1) << 5)); }
DI void stage_rc(int b, int& R, int& C) { const int st = b / 1024, sb = b % 1024, swz = sb ^ (((sb >> 9) & 1) << 5); R = (st >> 1) * 16 + swz / 64; C = (st & 1) * 32 + (swz % 64) / 2; }
DI int perm32(int rho) { const int n = rho >> 4, i = rho & 15; return 8 * (i >> 2) + 4 * n + (i & 3); }
DI int brow_of(int bmode, int h, int R) {
  return bmode == 0 ? 128 * h + R : (bmode == 1 ? 128 * h + (R & ~31) + perm32(R & 31) : 64 * (R >> 5) + 32 * h + perm32(R & 31));
}
struct GUnit { const char* A; const char* B; int bmode, seg, pm, pn; };

template <class Sched, class Epi>
DI void gemm_stream(LAS unsigned char* lds, int K, long lda, long ldb, const Sched& S, const Epi& E) {
  int tid_ = threadIdx.x; asm volatile("" : "+v"(tid_));
  const int tid = tid_ & 511, wid = __builtin_amdgcn_readfirstlane(tid >> 6), lane = tid & 63, wr = wid >> 2, wc = wid & 3, fr = lane & 15, fq = lane >> 4;
  const int nt = K / 64;
  unsigned voffA[2], voffB0[2], voffB1[2];
#pragma unroll
  for (int i = 0; i < 2; ++i) { int R_, C_; stage_rc(tid * 16 + i * 8192, R_, C_); voffA[i] = (unsigned)(R_ * lda + C_ * 2); }
  const size_t kstep = 128, hstepA = (size_t)128 * lda;
  const unsigned ldsw = (unsigned)wid * 1024u;
  const int aoff = lds_byte(wr * 64 + fr, fq * 8), boff = lds_byte(wc * 32 + fr, fq * 8);
#define GS_SA(b, h) (((b) * 2 + (h)) * HTB)
#define GS_SB(b, h) ((4 + (b) * 2 + (h)) * HTB)
#define GS_STAGE(bufoff, gbase, voff) do { _Pragma("unroll") for (int _i = 0; _i < 2; ++_i) \
    __builtin_amdgcn_global_load_lds((const unsigned*)((const char*)(gbase) + (voff)[_i]), (LAS unsigned*)(lds + (bufoff) + ldsw + _i * 8192), 16, 0, 0); } while (0)
#define GS_LDA(dst, b, h) do { _Pragma("unroll") for (int m = 0; m < 4; ++m) _Pragma("unroll") for (int k = 0; k < 2; ++k) dst[m][k] = *(const LAS f16x8*)(lds + GS_SA(b, h) + aoff + m * 2048 + k * 1024); } while (0)
#define GS_LDB(dst, b, h) do { _Pragma("unroll") for (int n = 0; n < 2; ++n) _Pragma("unroll") for (int k = 0; k < 2; ++k) dst[n][k] = *(const LAS f16x8*)(lds + GS_SB(b, h) + boff + n * 2048 + k * 1024); } while (0)
#define GS_MMA(ai, bj, At, Bt) do { __builtin_amdgcn_s_setprio(1); _Pragma("unroll") for (int m = 0; m < 4; ++m) _Pragma("unroll") for (int n = 0; n < 2; ++n) _Pragma("unroll") for (int k = 0; k < 2; ++k) \
    acc[ai][bj][m][n] = MFMA16(Bt[n][k], At[m][k], acc[ai][bj][m][n]); __builtin_amdgcn_s_setprio(0); } while (0)
#define GS_WAIT_V(n) asm volatile("s_waitcnt vmcnt(" #n ")" ::: "memory")
#define GS_WAIT_L(n) asm volatile("s_waitcnt lgkmcnt(" #n ")" ::: "memory")
#define GS_BAR __builtin_amdgcn_s_barrier()
#define GS_SCHED __builtin_amdgcn_sched_barrier(0)
#define GS_SETB(mode) do { int tq_ = threadIdx.x; asm volatile("" : "+v"(tq_)); _Pragma("unroll") for (int _i = 0; _i < 2; ++_i) { int R_, C_; stage_rc(tq_ * 16 + _i * 8192, R_, C_); \
    voffB0[_i] = (unsigned)(brow_of(mode, 0, R_) * ldb + C_ * 2); voffB1[_i] = (unsigned)(brow_of(mode, 1, R_) * ldb + C_ * 2); } } while (0)
  GUnit cur, nxt; int ui = 0;
  if (!S.next(0, cur)) return;
  f32x4 acc[2][2][4][2];
#pragma unroll
  for (int a = 0; a < 2; ++a)
#pragma unroll
    for (int b = 0; b < 2; ++b)
#pragma unroll
      for (int m = 0; m < 4; ++m)
#pragma unroll
        for (int n = 0; n < 2; ++n) acc[a][b][m][n] = (f32x4){0.f, 0.f, 0.f, 0.f};
  f16x8 At[4][2], B0[2][2], B1[2][2];
  const char* cA = cur.A; const char* cB = cur.B;
  GS_SETB(cur.bmode);
  GS_STAGE(GS_SB(0, 0), cB, voffB0); GS_STAGE(GS_SA(0, 0), cA, voffA); GS_STAGE(GS_SB(0, 1), cB, voffB1); GS_STAGE(GS_SA(0, 1), cA + hstepA, voffA);
  if (wr == 1) GS_BAR;
  GS_WAIT_V(4); GS_BAR;
  GS_STAGE(GS_SB(1, 0), cB + kstep, voffB0); GS_STAGE(GS_SA(1, 0), cA + kstep, voffA); GS_STAGE(GS_SB(1, 1), cB + kstep, voffB1);
  GS_WAIT_V(6); GS_BAR;
  for (;;) {
    const bool has_next = S.next(ui + 1, nxt);
    const char* nA = has_next ? nxt.A : cA; const char* nB = has_next ? nxt.B : cB;
    for (int t = 0; t < nt; t += 2) {
      const bool last = (t == nt - 2);
      const char* a1 = cA + (size_t)(t + 1) * kstep;
      const char* a2 = last ? nA : cA + (size_t)(t + 2) * kstep; const char* b2 = last ? nB : cB + (size_t)(t + 2) * kstep;
      const char* a3 = a2 + kstep; const char* b3 = b2 + kstep;
      if (last && has_next) GS_SETB(nxt.bmode);
      GS_LDB(B0, 0, 0); GS_SCHED; GS_LDA(At, 0, 0); GS_STAGE(GS_SA(1, 1), a1 + hstepA, voffA);
      GS_WAIT_L(8); GS_BAR; GS_WAIT_L(0); GS_MMA(0, 0, At, B0); GS_BAR; GS_SCHED;
      GS_LDB(B1, 0, 1); GS_STAGE(GS_SB(0, 0), b2, voffB0);
      GS_BAR; GS_WAIT_L(0); GS_MMA(0, 1, At, B1); GS_BAR;
      GS_LDA(At, 0, 1); GS_STAGE(GS_SA(0, 0), a2, voffA);
      GS_BAR; GS_WAIT_L(0); GS_MMA(1, 0, At, B0); GS_BAR; GS_SCHED;
      GS_STAGE(GS_SB(0, 1), b2, voffB1);
      GS_WAIT_V(6); GS_BAR; GS_MMA(1, 1, At, B1); GS_BAR;
      GS_LDB(B0, 1, 0); GS_SCHED; GS_LDA(At, 1, 0); GS_STAGE(GS_SA(0, 1), a2 + hstepA, voffA);
      GS_WAIT_L(8); GS_BAR; GS_WAIT_L(0); GS_MMA(0, 0, At, B0); GS_BAR; GS_SCHED;
      GS_LDB(B1, 1, 1); GS_STAGE(GS_SB(1, 0), b3, voffB0);
      GS_BAR; GS_WAIT_L(0); GS_MMA(0, 1, At, B1); GS_BAR;
      GS_LDA(At, 1, 1); GS_STAGE(GS_SA(1, 0), a3, voffA);
      GS_BAR; GS_WAIT_L(0); GS_MMA(1, 0, At, B0); GS_BAR; GS_SCHED;
      GS_STAGE(GS_SB(1, 1), b3, voffB1);
      GS_WAIT_V(6); GS_BAR; GS_MMA(1, 1, At, B1); GS_BAR;
    }
    E(acc, cur, wr, wc, fr, fq);
    if (!has_next) break;
#pragma unroll
    for (int a = 0; a < 2; ++a)
#pragma unroll
      for (int b = 0; b < 2; ++b)
#pragma unroll
        for (int m = 0; m < 4; ++m)
#pragma unroll
          for (int n = 0; n < 2; ++n) acc[a][b][m][n] = (f32x4){0.f, 0.f, 0.f, 0.f};
    cur = nxt; cA = nA; cB = nB; ++ui;
  }
  GS_WAIT_V(0);
  if (wr == 0) GS_BAR;
  GS_BAR;
#undef GS_SA
#undef GS_SB
#undef GS_STAGE
#undef GS_LDA
#undef GS_LDB
#undef GS_MMA
#undef GS_WAIT_V
#undef GS_WAIT_L
#undef GS_BAR
#undef GS_SCHED
#undef GS_SETB
}

struct Sched1 {
  const char* H; const char* W; const char* MEMN; const char* WMEM; int b, G;
  DI bool next(int i, GUnit& u) const {
    int kind, mt, nt;
    if (G == 256) {
      if (i < 12) { const int xcd = b & 7, l = b >> 3; const int st = i * 8 + xcd; const int mg = st / 3, ng = st % 3; kind = 0; mt = mg * 4 + (l & 3); nt = ng * 8 + (l >> 2); }
      else return false;
    } else {
      const int L = i * G + b;
      if (L < 3072) { kind = 0; mt = L / 24; nt = L % 24; }
      else return false;
    }
    u.pm = mt; u.pn = nt;
    if (kind == 1) { u.A = MEMN + (size_t)mt * 256 * 2048; u.B = WMEM + (size_t)nt * 256 * 2048; u.seg = 8; u.bmode = 1; return true; }
    int seg = 2;
    if (nt == 4 || nt == 6 || nt == 8) seg = 1;     else if (nt == 11) seg = 4;
    else if (nt == 14 || nt == 15) seg = 5; else if (nt >= 16 && nt < 24) seg = 6; else if (nt == 24) seg = 7;
    u.seg = seg; u.bmode = (seg <= 1) ? 0 : ((seg == 3 || seg == 4) ? 2 : 1);
    u.A = H + (size_t)mt * 256 * 2048; u.B = W + (size_t)(nt < 24 ? nt * 256 : 6144) * 2048;
    return true;
  }
};
DI unsigned pk2(float a, float b) { typedef _Float16 h2 __attribute__((ext_vector_type(2))); h2 v; v[0] = (f16)a; v[1] = (f16)b; return __builtin_bit_cast(unsigned, v); }
struct Epi1 {
  f16* Z; f16* KVM; float* GATES; const float* ROT;
  DI void operator()(const f32x4 (&acc)[2][2][4][2], const GUnit& u, int wr, int wc, int fr, int fq) const {
    typedef unsigned u32x4_ __attribute__((ext_vector_type(4)));
    typedef unsigned u32x2_ __attribute__((ext_vector_type(2)));
    const int seg = u.seg;
    const int row0 = u.pm * 256 + wr * 64 + fr;
    if (seg == 7) {
      if (wc == 0 && fq < 3) {
#pragma unroll
        for (int ai = 0; ai < 2; ++ai)
#pragma unroll
          for (int m = 0; m < 4; ++m) {
            float* gp = GATES + (size_t)(row0 + ai * 128 + m * 16) * 24 + 8 * fq;
            f32x4 v0 = acc[ai][0][m][0], v1 = acc[ai][0][m][1];
#pragma unroll
            for (int j = 0; j < 4; ++j) { v0[j] = sigmoidf_(v0[j]); v1[j] = sigmoidf_(v1[j]); }
            *(f32x4*)gp = v0; *(f32x4*)(gp + 4) = v1;
          }
      }
      return;
    }
    if (seg == 0 || seg == 1) {
      const float sc = (seg == 0) ? QSCALE : 1.f;
      if (wc == 0) {
#pragma unroll
        for (int ai = 0; ai < 2; ++ai) {
          f32x4 ca[4], cb[4];
#pragma unroll
          for (int m = 0; m < 4; ++m) { const float* rp = ROT + (size_t)(row0 + ai * 128 + m * 16) * 96 + 8 * fq; ca[m] = *(const f32x4*)rp; cb[m] = *(const f32x4*)(rp + 4); }
#pragma unroll
          for (int m = 0; m < 4; ++m) {
            f16* zp = Z + (size_t)(row0 + ai * 128 + m * 16) * ZW + u.pn * 256 + 4 * fq;
            const float cs[4] = {ca[m][0], ca[m][2], cb[m][0], cb[m][2]}, sn[4] = {ca[m][1], ca[m][3], cb[m][1], cb[m][3]};
#pragma unroll
            for (int bj = 0; bj < 2; ++bj) {
              const f32x4 x1 = acc[ai][bj][m][0], x2 = acc[ai][bj][m][1];
              f32x4 o1, o2;
#pragma unroll
              for (int j = 0; j < 4; ++j) { o1[j] = (x1[j] * cs[j] - x2[j] * sn[j]) * sc; o2[j] = (x1[j] * sn[j] + x2[j] * cs[j]) * sc; }
              u32x2_ w1, w2; w1.x = pk2(o1[0], o1[1]); w1.y = pk2(o1[2], o1[3]); w2.x = pk2(o2[0], o2[1]); w2.y = pk2(o2[2], o2[3]);
              *(u32x2_*)(zp + bj * 128) = w1; *(u32x2_*)(zp + bj * 128 + 16) = w2;
            }
          }
        }
      } else {
#pragma unroll
        for (int ai = 0; ai < 2; ++ai)
#pragma unroll
          for (int m = 0; m < 4; ++m) {
            f16* zp = Z + (size_t)(row0 + ai * 128 + m * 16) * ZW + u.pn * 256 + 32 * wc + 4 * fq;
#pragma unroll
            for (int bj = 0; bj < 2; ++bj) {
              const f32x4 x1 = acc[ai][bj][m][0] * sc, x2 = acc[ai][bj][m][1] * sc;
              u32x2_ w1, w2; w1.x = pk2(x1[0], x1[1]); w1.y = pk2(x1[2], x1[3]); w2.x = pk2(x2[0], x2[1]); w2.y = pk2(x2[2], x2[3]);
              *(u32x2_*)(zp + bj * 128) = w1; *(u32x2_*)(zp + bj * 128 + 16) = w2;
            }
          }
      }
      return;
    }
    if (seg == 3 || seg == 4) {
      const float sc = (seg == 4) ? 0.125f : 1.f;
#pragma unroll
      for (int ai = 0; ai < 2; ++ai) {
        f32x4 tt[4][4];
#pragma unroll
        for (int m = 0; m < 4; ++m) {
          const float* rp = ROT + (size_t)(row0 + ai * 128 + m * 16) * 96 + 32 + 16 * fq;
          tt[m][0] = *(const f32x4*)rp; tt[m][1] = *(const f32x4*)(rp + 4); tt[m][2] = *(const f32x4*)(rp + 8); tt[m][3] = *(const f32x4*)(rp + 12);
        }
#pragma unroll
        for (int m = 0; m < 4; ++m) {
          f16* zp = Z + (size_t)(row0 + ai * 128 + m * 16) * ZW + u.pn * 256 + 64 * wc + 8 * fq;
          const f32x4 t0 = tt[m][0], t1 = tt[m][1], t2 = tt[m][2], t3 = tt[m][3];
          const float cs[8] = {t0[0], t0[2], t1[0], t1[2], t2[0], t2[2], t3[0], t3[2]}, sn[8] = {t0[1], t0[3], t1[1], t1[3], t2[1], t2[3], t3[1], t3[3]};
          float lo[8], hi[8];
#pragma unroll
          for (int n = 0; n < 2; ++n)
#pragma unroll
            for (int j = 0; j < 4; ++j) { const int e = 4 * n + j; const float x1 = acc[ai][0][m][n][j], x2 = acc[ai][1][m][n][j]; lo[e] = (x1 * cs[e] - x2 * sn[e]) * sc; hi[e] = (x1 * sn[e] + x2 * cs[e]) * sc; }
          u32x4_ wl, wh; wl.x = pk2(lo[0], lo[1]); wl.y = pk2(lo[2], lo[3]); wl.z = pk2(lo[4], lo[5]); wl.w = pk2(lo[6], lo[7]);
          wh.x = pk2(hi[0], hi[1]); wh.y = pk2(hi[2], hi[3]); wh.z = pk2(hi[4], hi[5]); wh.w = pk2(hi[6], hi[7]);
          *(u32x4_*)zp = wl; *(u32x4_*)(zp + 32) = wh;
        }
      }
      return;
    }
    f16* base = (seg == 8) ? KVM : Z; const long ld = (seg == 8) ? 1024 : ZW;
#pragma unroll
    for (int ai = 0; ai < 2; ++ai)
#pragma unroll
      for (int m = 0; m < 4; ++m) {
        f16* zp = base + (size_t)(row0 + ai * 128 + m * 16) * ld + u.pn * 256 + 32 * wc + 8 * fq;
#pragma unroll
        for (int bj = 0; bj < 2; ++bj) {
          f32x4 v0 = acc[ai][bj][m][0], v1 = acc[ai][bj][m][1];
          if (seg == 5) { v0 *= QSCALE; v1 *= QSCALE; }
          u32x4_ w; w.x = pk2(v0[0], v0[1]); w.y = pk2(v0[2], v0[3]); w.z = pk2(v1[0], v1[1]); w.w = pk2(v1[2], v1[3]);
          *(u32x4_*)(zp + bj * 128) = w;
        }
      }
  }
};
DI void phase_gemm1(const Params& p, char* smem) {
  Sched1 S; S.H = (const char*)p.out; S.W = p.ws + WS_WINT; S.MEMN = p.ws + WS_MEMN; S.WMEM = p.ws + WS_WMEMT; S.b = blockIdx.x; S.G = gridDim.x;
  Epi1 E; E.Z = (f16*)(p.ws + WS_Z); E.KVM = (f16*)(p.ws + WS_KVM); E.GATES = (float*)(p.ws + WS_GATES); E.ROT = (const float*)(p.ws + WS_ROT);
  gemm_stream((LAS unsigned char*)smem, 1024, 2048, 2048, S, E);
}

struct SchedOne {
  const char* A; const char* B; int pm, pn;
  DI bool next(int i, GUnit& u) const { if (i != 0) return false; u.A = A; u.B = B; u.pm = pm; u.pn = pn; u.seg = 8; u.bmode = 1; return true; }
};
DI void memkv_unit(const Params& p, int mt, int nt, char* smem) {
  SchedOne S; S.A = p.ws + WS_MEMN + (size_t)mt * 256 * 2048; S.B = p.ws + WS_WMEMT + (size_t)nt * 256 * 2048; S.pm = mt; S.pn = nt;
  Epi1 E; E.Z = (f16*)(p.ws + WS_Z); E.KVM = (f16*)(p.ws + WS_KVM); E.GATES = (float*)(p.ws + WS_GATES); E.ROT = (const float*)(p.ws + WS_ROT);
  gemm_stream((LAS unsigned char*)smem, 1024, 2048, 2048, S, E);
}

struct Sched2 {
  const char* A; const char* W; int b, G;
  DI bool next(int i, GUnit& u) const {
    int mt, nt;
    if (G == 256) { if (i >= 2) return false; const int xcd = b & 7, l = b >> 3; const int st = i * 8 + xcd; mt = st * 8 + (l & 7); nt = l >> 3; }
    else { const int L = i * G + b; if (L >= 512) return false; mt = L >> 2; nt = L & 3; }
    u.pm = mt; u.pn = nt; u.seg = 0; u.bmode = 1;
    u.A = A + (size_t)mt * 256 * ZW * 2; u.B = W + (size_t)nt * 256 * 4096;
    return true;
  }
};
struct Epi2 {
  f16* Y; float* PSS;
  DI void operator()(const f32x4 (&acc)[2][2][4][2], const GUnit& u, int wr, int wc, int fr, int fq) const {
    typedef unsigned u32x4_ __attribute__((ext_vector_type(4)));
    const int row0 = u.pm * 256 + wr * 64 + fr, col0 = u.pn * 256 + wc * 32 + 8 * fq;
#pragma unroll
    for (int ai = 0; ai < 2; ++ai)
#pragma unroll
      for (int m = 0; m < 4; ++m) {
        const int r = row0 + ai * 128 + m * 16;
        f16* yp = Y + (size_t)r * 1024 + col0; float ss = 0.f;
#pragma unroll
        for (int bj = 0; bj < 2; ++bj) {
          const f32x4 v0 = acc[ai][bj][m][0], v1 = acc[ai][bj][m][1];
          ss += (v0[0] * v0[0] + v0[1] * v0[1]) + (v0[2] * v0[2] + v0[3] * v0[3]) + (v1[0] * v1[0] + v1[1] * v1[1]) + (v1[2] * v1[2] + v1[3] * v1[3]);
          u32x4_ w; w.x = pk2(v0[0], v0[1]); w.y = pk2(v0[2], v0[3]); w.z = pk2(v1[0], v1[1]); w.w = pk2(v1[2], v1[3]);
          *(u32x4_*)(yp + bj * 128) = w;
        }
        ss += __shfl_xor(ss, 16); ss += __shfl_xor(ss, 32);
        if (fq == 0) PSS[(size_t)r * 16 + u.pn * 4 + wc] = ss;
      }
  }
};
DI void phase_gemm2(const Params& p, char* smem) {
  Sched2 S; S.A = p.ws + WS_Z + (size_t)ZC_GATE * 2; S.W = p.ws + WS_WOUTT; S.b = blockIdx.x; S.G = gridDim.x;
  Epi2 E; E.Y = (f16*)(p.ws + WS_Y); E.PSS = (float*)(p.ws + WS_PSS);
  gemm_stream((LAS unsigned char*)smem, 2048, (long)ZW * 2, 4096, S, E);
}

struct KCmpS { int k0; DI long operator()(int kt) const { const int k = kt + k0; return (long)(k >> 1) * ZW + (k & 1) * 64; } };
struct KStdS { int k0; DI long operator()(int kt) const { return (long)(kt + k0) * 64; } };
DI void unit_drain() { asm volatile("s_waitcnt vmcnt(0)" ::: "memory"); __syncthreads(); }
DI void publish_arrive(unsigned* ctr) {
  __builtin_amdgcn_fence(__ATOMIC_RELEASE, "agent");
  asm volatile("s_waitcnt vmcnt(0)" ::: "memory");
  __hip_atomic_fetch_add(ctr, 1u, __ATOMIC_RELAXED, __HIP_MEMORY_SCOPE_AGENT);
}
DI void wait_count(unsigned* ctr, unsigned target) {
  if (threadIdx.x == 0) {
    unsigned sp = 0;
    while (__hip_atomic_load(ctr, __ATOMIC_RELAXED, __HIP_MEMORY_SCOPE_AGENT) < target) { __builtin_amdgcn_s_sleep(2); if (++sp > (1u << 24)) break; }
    __builtin_amdgcn_fence(__ATOMIC_ACQUIRE, "agent");
    asm volatile("s_waitcnt vmcnt(0)" ::: "memory");
  }
  __syncthreads();
}
DI void csplit_unit(const Params& p, int kv, int b, int ks, char* smem) {
  int tid_ = threadIdx.x; asm volatile("" : "+v"(tid_)); const int tid = tid_, lane = tid & 63, wid = tid >> 6;
  const int lr = tid >> 3, lc = tid & 7;
  const char* Z = (const char*)(p.ws + WS_Z);
  const char* W1 = (const char*)(p.ws + WS_W1T) + (size_t)kv * 256 * 4096 * 2;
  const unsigned voffA = (unsigned)((lr & 31) * 16 * ZW * 2 + (lr >> 5) * 256 + lc * 16);
  const unsigned voffB = (unsigned)(lr * 8192 + lc * 16);
  f32x16 acc[4][2]; zero_acc(acc);
  KCmpS ka; ka.k0 = ks * 8; KStdS kb; kb.k0 = ks * 8;
  gemm_core(acc, Z + ((size_t)(b * NT) * ZW + ZC_KV + kv * 256) * 2, (long)32 * 16 * ZW * 2, voffA, W1, 64 * 8192, voffB, ka, kb, 8, smem);
  float* slab = p.out + (size_t)(((kv * 16 + b) * 8 + ks)) * 65536;
#pragma unroll
  for (int i = 0; i < 4; ++i)
#pragma unroll
    for (int j = 0; j < 2; ++j)
#pragma unroll
      for (int g = 0; g < 4; ++g) {
        f32x4 v; v[0] = acc[i][j][4 * g]; v[1] = acc[i][j][4 * g + 1]; v[2] = acc[i][j][4 * g + 2]; v[3] = acc[i][j][4 * g + 3];
        *(f32x4*)(slab + (size_t)((((wid * 4 + i) * 2 + j) * 4 + g) * 64 + lane) * 4) = v;
      }
  unit_drain();
}
DI void cfin_unit(const Params& p, int kv, int b, char* smem) {
  int tid_ = threadIdx.x; asm volatile("" : "+v"(tid_)); const int tid = tid_, lane = tid & 63, wid = tid >> 6, wn = wid & 3, l31 = lane & 31, h = lane >> 5;
  const int lr = tid >> 3, lc = tid & 7;
  f16* HID = (f16*)(p.ws + WS_HID) + (size_t)kv * 4096 * 256;
  wait_count((unsigned*)(p.ws + WS_CTR) + 16 + kv * 16 + b, 8u);
  {
    float* bias = (float*)(smem + 131072);
    if (tid < 256) { const float* PB1 = (const float*)(p.ws + WS_PB1) + kv * 16 * 256; float sacc = 0.f; for (int c = 0; c < 16; ++c) sacc += PB1[c * 256 + tid]; bias[tid] = sacc; }
    __syncthreads();
    f32x16 acc[4][2];
#pragma unroll
    for (int j = 0; j < 2; ++j)
#pragma unroll
      for (int r = 0; r < 16; ++r) { const float bv = bias[64 * wn + 32 * j + crow(r, h)]; acc[0][j][r] = bv; acc[1][j][r] = bv; acc[2][j][r] = bv; acc[3][j][r] = bv; }
    const float* slab0 = p.out + (size_t)((kv * 16 + b) * 8) * 65536;
#pragma unroll 1
    for (int ks = 0; ks < 8; ks += 2) {
      const float* slab = slab0 + (size_t)ks * 65536;
#pragma unroll
      for (int i = 0; i < 4; ++i) {
#pragma unroll
        for (int qh = 0; qh < 2; ++qh) {
          f32x4 tv[4], tw[4];
#pragma unroll
          for (int q = 0; q < 4; ++q) {
            const size_t o_ = (size_t)(((wid * 4 + i) * 8 + 4 * qh + q) * 64 + lane) * 4;
            tv[q] = *(const f32x4*)(slab + o_); tw[q] = *(const f32x4*)(slab + 65536 + o_);
          }
#pragma unroll
          for (int g = 0; g < 4; ++g) {
            acc[i][qh][4 * g] += tv[g][0] + tw[g][0]; acc[i][qh][4 * g + 1] += tv[g][1] + tw[g][1]; acc[i][qh][4 * g + 2] += tv[g][2] + tw[g][2]; acc[i][qh][4 * g + 3] += tv[g][3] + tw[g][3];
          }
        }
      }
    }
    __syncthreads();
    {
      const int wm = wid >> 2;
      char* img = smem + wid * (128 * 144);
#pragma unroll
      for (int i = 0; i < 4; ++i)
#pragma unroll
        for (int j = 0; j < 2; ++j)
#pragma unroll
          for (int g = 0; g < 4; ++g) {
            f16x4 v; v[0] = (f16)acc[i][j][4 * g]; v[1] = (f16)acc[i][j][4 * g + 1]; v[2] = (f16)acc[i][j][4 * g + 2]; v[3] = (f16)acc[i][j][4 * g + 3];
            *(f16x4*)(img + (32 * i + l31) * 144 + (32 * j + 8 * g + 4 * h) * 2) = v;
          }
      __syncthreads();
#pragma unroll 2
      for (int it = 0; it < 16; ++it) {
        const int row = it * 8 + (lane >> 3), ch = lane & 7;
        const int slot = 128 * wm + row; const int lrr = slot & 63, ii = slot >> 6;
        const int n = (lrr & 31) + 32 * ii, g = lrr >> 5;
        f16x8 v = *(const f16x8*)(img + row * 144 + ch * 16);
        v = XfGelu()(v, nullptr, 0, 0, 0);
        *(f16x8*)(HID + (size_t)(b * 256 + g * 128 + n) * 256 + 64 * wn + ch * 8) = v;
      }
      __syncthreads();
    }
  }
  __threadfence_block();
  __syncthreads();
  {
    const char* W2 = (const char*)(p.ws + WS_W2T) + (size_t)kv * 128 * 256 * 2;
    const unsigned voff = (unsigned)(lr * 512 + lc * 16);
    f32x16 acc[4][2]; zero_acc(acc);
    gemm_core(acc, (const char*)HID + (size_t)(b * 256) * 512, 64 * 512, voff, W2, 64 * 512, voff, KStd(), KStd(), 4, smem);
    if (l31 == 31) {
#pragma unroll
      for (int j = 0; j < 2; ++j)
#pragma unroll
        for (int r = 0; r < 16; ++r) acc[3][j][r] = 0.f;
    }
    f16* KC = (f16*)(p.ws + WS_KC) + (size_t)kv * 4096 * 128;
    store_tile_f16(acc, KC + (size_t)(b * 256) * 128, 128, smem, wn < 2, XfNone());
  }
  unit_drain();
}

struct KV128 { f16x8 k[2], v[2]; };
DI void kv_gload(KV128& r, const char* K, const char* V, unsigned voff, long ldb) {
  r.k[0] = *(const f16x8*)(K + (size_t)voff); r.k[1] = *(const f16x8*)(K + 32 * ldb + (size_t)voff);
  r.v[0] = *(const f16x8*)(V + (size_t)voff); r.v[1] = *(const f16x8*)(V + 32 * ldb + (size_t)voff);
}
DI void kv_lstore(const KV128& r, char* stage, unsigned so) {
  *(f16x8*)(stage + so) = r.k[0]; *(f16x8*)(stage + so + 8192) = r.k[1];
  *(f16x8*)(stage + 16384 + so) = r.v[0]; *(f16x8*)(stage + 16384 + so + 8192) = r.v[1];
}
DI void qk128(f32x16& p0, f32x16& p1, const char* Kst, const f16x8 (&qf)[8], unsigned kbe, unsigned kbo) {
  const f32x16 zero = {0.f, 0.f, 0.f, 0.f, 0.f, 0.f, 0.f, 0.f, 0.f, 0.f, 0.f, 0.f, 0.f, 0.f, 0.f, 0.f};
  f16x8 ka[4], kb[4];
#define QK_LD(dst, s0) do { dst[0] = *(const f16x8*)(Kst + kbe + 512 * ((s0) >> 1)); dst[1] = *(const f16x8*)(Kst + kbe + 512 * ((s0) >> 1) + 8192); \
    dst[2] = *(const f16x8*)(Kst + kbo + 512 * ((s0) >> 1)); dst[3] = *(const f16x8*)(Kst + kbo + 512 * ((s0) >> 1) + 8192); } while (0)
  QK_LD(ka, 0);
  QK_LD(kb, 2);
  p0 = MFMA(ka[0], qf[0], zero); p1 = MFMA(ka[1], qf[0], zero); p0 = MFMA(ka[2], qf[1], p0); p1 = MFMA(ka[3], qf[1], p1);
  QK_LD(ka, 4);
  p0 = MFMA(kb[0], qf[2], p0); p1 = MFMA(kb[1], qf[2], p1); p0 = MFMA(kb[2], qf[3], p0); p1 = MFMA(kb[3], qf[3], p1);
  QK_LD(kb, 6);
  p0 = MFMA(ka[0], qf[4], p0); p1 = MFMA(ka[1], qf[4], p1); p0 = MFMA(ka[2], qf[5], p0); p1 = MFMA(ka[3], qf[5], p1);
  p0 = MFMA(kb[0], qf[6], p0); p1 = MFMA(kb[1], qf[6], p1); p0 = MFMA(kb[2], qf[7], p0); p1 = MFMA(kb[3], qf[7], p1);
#undef QK_LD
  __builtin_amdgcn_sched_group_barrier(0x100, 8, 0);
  __builtin_amdgcn_sched_group_barrier(0x008, 4, 0);
  __builtin_amdgcn_sched_group_barrier(0x100, 4, 0);
  __builtin_amdgcn_sched_group_barrier(0x008, 4, 0);
  __builtin_amdgcn_sched_group_barrier(0x100, 4, 0);
  __builtin_amdgcn_sched_group_barrier(0x008, 8, 0);
}
DI f16x8 pack8(const f32x16& x, int s) {
  f16x8 r;
#pragma unroll
  for (int j = 0; j < 8; ++j) r[j] = (f16)x[8 * s + j];
  return r;
}
struct VFrag { f16x4 l0, h0, l1, h1, l2, h2, l3, h3; };
template <int DT> DI void pv_rd(VFrag& f, unsigned vb0, unsigned vb1) {
  f.l0 = tr_read<512 * DT>(vb0); f.h0 = tr_read<512 * DT + 2048>(vb1);
  f.l1 = tr_read<512 * DT + 4096>(vb0); f.h1 = tr_read<512 * DT + 4096 + 2048>(vb1);
  f.l2 = tr_read<512 * DT + 8192>(vb0); f.h2 = tr_read<512 * DT + 8192 + 2048>(vb1);
  f.l3 = tr_read<512 * DT + 12288>(vb0); f.h3 = tr_read<512 * DT + 12288 + 2048>(vb1);
}
DI void pv_mm(f32x16& od, const VFrag& f, const f16x8 (&pb)[4]) {
#define PK(L, H) (f16x8){L[0], L[1], L[2], L[3], H[0], H[1], H[2], H[3]}
  od = MFMA(PK(f.l0, f.h0), pb[0], od);
  od = MFMA(PK(f.l1, f.h1), pb[1], od);
  od = MFMA(PK(f.l2, f.h2), pb[2], od);
  od = MFMA(PK(f.l3, f.h3), pb[3], od);
#undef PK
}
DI void pv_tile(f32x16 (&o)[4], unsigned vb0, unsigned vb1, const f32x16& p0, const f32x16& p1) {
  f16x8 pb[4]; pb[0] = pack8(p0, 0); pb[1] = pack8(p0, 1); pb[2] = pack8(p1, 0); pb[3] = pack8(p1, 1);
  VFrag fa, fb;
  pv_rd<0>(fa, vb0, vb1);
  pv_rd<1>(fb, vb0, vb1);
  asm volatile("s_waitcnt lgkmcnt(8)" ::: "memory"); SBAR();
  pv_mm(o[0], fa, pb);
  pv_rd<2>(fa, vb0, vb1);
  asm volatile("s_waitcnt lgkmcnt(8)" ::: "memory"); SBAR();
  pv_mm(o[1], fb, pb);
  pv_rd<3>(fb, vb0, vb1);
  asm volatile("s_waitcnt lgkmcnt(8)" ::: "memory"); SBAR();
  pv_mm(o[2], fa, pb);
  asm volatile("s_waitcnt lgkmcnt(0)" ::: "memory"); SBAR();
  pv_mm(o[3], fb, pb);
}
DI void qk_exp(f32x16& n0, f32x16& n1, const char* Kst, const f16x8 (&qf)[8], unsigned kbe, unsigned kbo, f32x16& c0, f32x16& c1, float me, float& ps) {
  const f32x16 zero = {0.f, 0.f, 0.f, 0.f, 0.f, 0.f, 0.f, 0.f, 0.f, 0.f, 0.f, 0.f, 0.f, 0.f, 0.f, 0.f};
  f16x8 ka[4], kb[4];
#define QK_LD(dst, s0) do { dst[0] = *(const f16x8*)(Kst + kbe + 512 * ((s0) >> 1)); dst[1] = *(const f16x8*)(Kst + kbe + 512 * ((s0) >> 1) + 8192); \
    dst[2] = *(const f16x8*)(Kst + kbo + 512 * ((s0) >> 1)); dst[3] = *(const f16x8*)(Kst + kbo + 512 * ((s0) >> 1) + 8192); } while (0)
#define EXP8(c, b0) do { _Pragma("unroll") for (int j_ = 0; j_ < 8; ++j_) { c[(b0) + j_] = fexp2(c[(b0) + j_] - me); s_ += c[(b0) + j_]; } } while (0)
  float s_ = 0.f;
  QK_LD(ka, 0);
  n0 = MFMA(ka[0], qf[0], zero); n1 = MFMA(ka[1], qf[0], zero); n0 = MFMA(ka[2], qf[1], n0); n1 = MFMA(ka[3], qf[1], n1);
  QK_LD(kb, 2);
  EXP8(c0, 0);
  n0 = MFMA(kb[0], qf[2], n0); n1 = MFMA(kb[1], qf[2], n1); n0 = MFMA(kb[2], qf[3], n0); n1 = MFMA(kb[3], qf[3], n1);
  QK_LD(ka, 4);
  EXP8(c0, 8);
  n0 = MFMA(ka[0], qf[4], n0); n1 = MFMA(ka[1], qf[4], n1); n0 = MFMA(ka[2], qf[5], n0); n1 = MFMA(ka[3], qf[5], n1);
  QK_LD(kb, 6);
  EXP8(c1, 0);
  n0 = MFMA(kb[0], qf[6], n0); n1 = MFMA(kb[1], qf[6], n1); n0 = MFMA(kb[2], qf[7], n0); n1 = MFMA(kb[3], qf[7], n1);
  EXP8(c1, 8);
  ps = s_;
#undef QK_LD
}
DI void exp_only(f32x16& c0, f32x16& c1, float me, float& ps) {
  float s_ = 0.f;
  EXP8(c0, 0); EXP8(c0, 8); EXP8(c1, 0); EXP8(c1, 8);
  ps = s_;
#undef EXP8
}
DI void pv_max(f32x16 (&o)[4], unsigned vb0, unsigned vb1, const f32x16& p0, const f32x16& p1, const f32x16& n0, const f32x16& n1, float& pm) {
  f16x8 pb[4]; pb[0] = pack8(p0, 0); pb[1] = pack8(p0, 1); pb[2] = pack8(p1, 0); pb[3] = pack8(p1, 1);
  VFrag fa;
  float mx = n0[0];
  pv_rd<0>(fa, vb0, vb1);
  asm volatile("s_waitcnt lgkmcnt(0)" ::: "memory"); SBAR();
  pv_mm(o[0], fa, pb);
  pv_rd<1>(fa, vb0, vb1);
#pragma unroll
  for (int r = 1; r < 8; ++r) mx = fmaxf(mx, n0[r]);
  asm volatile("s_waitcnt lgkmcnt(0)" ::: "memory"); SBAR();
  pv_mm(o[1], fa, pb);
  pv_rd<2>(fa, vb0, vb1);
#pragma unroll
  for (int r = 8; r < 16; ++r) mx = fmaxf(mx, n0[r]);
  asm volatile("s_waitcnt lgkmcnt(0)" ::: "memory"); SBAR();
  pv_mm(o[2], fa, pb);
  pv_rd<3>(fa, vb0, vb1);
#pragma unroll
  for (int r = 0; r < 8; ++r) mx = fmaxf(mx, n1[r]);
  asm volatile("s_waitcnt lgkmcnt(0)" ::: "memory"); SBAR();
  pv_mm(o[3], fa, pb);
#pragma unroll
  for (int r = 8; r < 16; ++r) mx = fmaxf(mx, n1[r]);
  pm = mx;
}
DI float rowmax32(const f32x16& c0, const f32x16& c1) {
  float pm = c0[0];
#pragma unroll
  for (int r = 1; r < 16; ++r) pm = fmaxf(pm, c0[r]);
#pragma unroll
  for (int r = 0; r < 16; ++r) pm = fmaxf(pm, c1[r]);
  return xhalf_max(pm);
}
DI void osm_decide(float pmn, float& m, float& l, f32x16 (&o)[4]) {
  if (!__all(pmn - m <= THR)) {
    float mn = fmaxf(m, pmn); float alpha = fexp2(m - mn); m = mn; l *= alpha;
#pragma unroll
    for (int d = 0; d < 4; ++d)
#pragma unroll
      for (int r = 0; r < 16; ++r) o[d][r] *= alpha;
  }
}
DI void osm_step(f32x16& p0, f32x16& p1, float& m, float& l, f32x16 (&o)[4], bool sel = true) {
  float pm = p0[0];
#pragma unroll
  for (int r = 1; r < 16; ++r) pm = fmaxf(pm, p0[r]);
#pragma unroll
  for (int r = 0; r < 16; ++r) pm = fmaxf(pm, p1[r]);
  pm = xhalf_max(pm);
  pm = sel ? pm : NEG;
  if (!__all(pm - m <= THR)) {
    float mn = fmaxf(m, pm); float alpha = fexp2(m - mn); m = mn; l *= alpha;
#pragma unroll
    for (int d = 0; d < 4; ++d)
#pragma unroll
      for (int r = 0; r < 16; ++r) o[d][r] *= alpha;
  }
  const float me = sel ? m : 1e30f;
  float ps = 0.f;
#pragma unroll
  for (int r = 0; r < 16; ++r) { p0[r] = fexp2(p0[r] - me); ps += p0[r]; }
#pragma unroll
  for (int r = 0; r < 16; ++r) { p1[r] = fexp2(p1[r] - me); ps += p1[r]; }
  l += ps;
}
DI void zero_o(f32x16 (&o)[4]) {
#pragma unroll
  for (int d = 0; d < 4; ++d)
#pragma unroll
    for (int r = 0; r < 16; ++r) o[d][r] = 0.f;
}


DI void glds16(const char* g, LAS unsigned char* l) { __builtin_amdgcn_global_load_lds((const unsigned*)g, (LAS unsigned*)l, 16, 0, 0); }
DI unsigned dma_voff128(int wid, int lane, long ldb) {
  const int r3 = wid >> 1, c2 = ((wid & 1) << 1) | (lane >> 5), r7 = (lane >> 2) & 7, x = lane & 3;
  const int row = 8 * r3 + r7, rr = ((r7 >> 2) | ((r3 & 1) << 1)) & 3, ch = 4 * c2 + (x ^ rr);
  return (unsigned)(row * ldb + ch * 16);
}
DI unsigned dma_voff64(int wid, int lane, long ldb) {
  const int row = 8 * wid + (lane >> 3), c = (lane & 7) ^ ((row >> 1) & 7);
  return (unsigned)(row * ldb + c * 16);
}
DI void dma_kv128(LAS unsigned char* stage, unsigned ldsw, const char* K, const char* V, unsigned voff, long ldb) {
  glds16(K + (size_t)voff, stage + ldsw); glds16(K + 32 * ldb + (size_t)voff, stage + ldsw + 8192);
  glds16(V + (size_t)voff, stage + 16384 + ldsw); glds16(V + 32 * ldb + (size_t)voff, stage + 16384 + ldsw + 8192);
}
#define VWAIT(n) asm volatile("s_waitcnt vmcnt(" #n ")" ::: "memory")
DI void ring_wait4(int rem) {
  if (rem >= 3) VWAIT(12); else if (rem == 2) VWAIT(8); else if (rem == 1) VWAIT(4); else VWAIT(0);
}
DI void ring_wait3(int rem) {
  if (rem >= 3) VWAIT(9); else if (rem == 2) VWAIT(6); else if (rem == 1) VWAIT(3); else VWAIT(0);
}
DI void ring_bar() { asm volatile("s_waitcnt lgkmcnt(0)" ::: "memory"); __builtin_amdgcn_s_barrier(); asm volatile("" ::: "memory"); }

DI void nsa_unit(const Params& p, int b, int g, int qt, char* smem) {
  const int wid = __builtin_amdgcn_readfirstlane(threadIdx.x >> 6);
  int tid_ = threadIdx.x; asm volatile("" : "+v"(tid_)); const int tid = tid_, lane = tid & 63, l31 = lane & 31, h = lane >> 5;
  const int tl = 8 * wid + (l31 >> 2), rr = l31 & 3, head = 4 * g + rr;
  const int t = 64 * qt + tl;
  const unsigned row = (unsigned)(b * NT + t);
  char* Zc = p.ws + WS_Z;
  LAS unsigned char* lds = (LAS unsigned char*)smem;
  const unsigned ldsw = (unsigned)wid * 1024u;
  const char* KC = p.ws + WS_KC + (size_t)((b * 2 + g) * 128) * 256;
  const char* VC = KC + (size_t)4096 * 256;
  const unsigned cvo = dma_voff128(wid, lane, 256), zvo = dma_voff128(wid, lane, ZW * 2);
  const char* Zb = Zc + (size_t)b * NT * ZW * 2;
  const int cKs = ZC_KV + 512 + g * 128, cVs = ZC_KV + 768 + g * 128, cKw = ZC_KV + 1024 + g * 128, cVw = ZC_KV + 1280 + g * 128;
  const int nwin = (qt >= 8) ? 9 : (qt + 1);
  const int NTILE = 3 + qt + nwin;
#define NSA_ISSUE(n_) do { const int n__ = (n_); LAS unsigned char* st__ = lds + (n__ & 3) * 32768; \
    if (n__ < 2) dma_kv128(st__, ldsw, KC + n__ * 64 * 256, VC + n__ * 64 * 256, cvo, 256); \
    else if (n__ < 3 + qt) { const size_t ko__ = (size_t)(64 * (qt - (n__ - 2))) * ZW * 2; dma_kv128(st__, ldsw, Zb + ko__ + cKs * 2, Zb + ko__ + cVs * 2, zvo, ZW * 2); } \
    else { const size_t ko__ = (size_t)(64 * (qt - (n__ - 3 - qt))) * ZW * 2; dma_kv128(st__, ldsw, Zb + ko__ + cKw * 2, Zb + ko__ + cVw * 2, zvo, ZW * 2); } } while (0)
  f16x8 qf[8];
  {
    const char* qrow = Zc + (size_t)((row * ZW + ZC_QN + head * 128 + 8 * h) * 2u);
#pragma unroll
    for (int s = 0; s < 8; ++s) qf[s] = *(const f16x8*)(qrow + 32 * s);
  }
  f32x4 rt[4];
  { const float* rp = (const float*)(p.ws + WS_ROT) + (size_t)row * 96 + 16 * h;
#pragma unroll
    for (int i = 0; i < 4; ++i) rt[i] = *(const f32x4*)(rp + 4 * i); }
  float g0, g1, g2;
  { const float* gp = (const float*)(p.ws + WS_GATES) + (size_t)(row * 24u + head); g0 = gp[0]; g1 = gp[8]; g2 = gp[16]; }
  NSA_ISSUE(2);
  wait_count((unsigned*)(p.ws + WS_CTR) + 64 + b, 2u);
  NSA_ISSUE(0); NSA_ISSUE(1);
  int issued = 3;
  const unsigned kbe = 2048 * (l31 >> 3) + 64 * (l31 & 7) + 16 * ((h) ^ ((l31 >> 2) & 3));
  const unsigned kbo = 2048 * (l31 >> 3) + 64 * (l31 & 7) + 16 * ((2 + h) ^ ((l31 >> 2) & 3));
  const int q4 = (lane & 15) >> 2, p4 = lane & 3, blk = (lane >> 4) & 1;
  const unsigned sbase = (unsigned)(uintptr_t)smem;
  const unsigned vr0 = sbase + 16384 + 64 * (4 * h + q4) + 16 * ((2 * blk + (p4 >> 1)) ^ (h)) + 8 * (p4 & 1);
  const unsigned vr1 = sbase + 16384 + 64 * (4 * h + q4) + 16 * ((2 * blk + (p4 >> 1)) ^ (2 + h)) + 8 * (p4 & 1);
  char* otg = (char*)p.out + (size_t)(64u << 20) + (size_t)(((b * 2 + g) * 32 + qt)) * 65536 + tid * 16;
  f32x16 o[4];
  unsigned selmask;
  {
    ring_wait4(0); ring_bar();
    {
#pragma unroll
      for (int e = 0; e < 8; ++e) {
        const float cs = rt[e >> 1][2 * (e & 1)], sn = rt[e >> 1][2 * (e & 1) + 1];
        const float x1 = (float)qf[0][e], x2 = (float)qf[1][e];
        qf[0][e] = (f16)((x1 * cs - x2 * sn) * QSCALE); qf[1][e] = (f16)((x1 * sn + x2 * cs) * QSCALE);
      }
#pragma unroll
      for (int s = 2; s < 8; ++s)
#pragma unroll
        for (int e = 0; e < 8; ++e) qf[s][e] = (f16)((float)qf[s][e] * QSCALE);
    }
    f32x16 c0, c1, c2, c3;
    qk128(c0, c1, smem, qf, kbe, kbo);
    qk128(c2, c3, smem + 32768, qf, kbe, kbo);
    const int nmax = (t - 31) >> 4;
    float mx = NEG;
#pragma unroll
    for (int r = 0; r < 16; ++r) {
      const int n = crow(r, h);
      c0[r] = (n <= nmax) ? c0[r] : NEG; c1[r] = (n + 32 <= nmax) ? c1[r] : NEG; c2[r] = (n + 64 <= nmax) ? c2[r] : NEG; c3[r] = (n + 96 <= nmax) ? c3[r] : NEG;
      mx = fmaxf(mx, fmaxf(fmaxf(c0[r], c1[r]), fmaxf(c2[r], c3[r])));
    }
    mx = xhalf_max(mx);
    float ls = 0.f;
#pragma unroll
    for (int r = 0; r < 16; ++r) {
      c0[r] = (c0[r] > -1e29f) ? fexp2(c0[r] - mx) : 0.f; c1[r] = (c1[r] > -1e29f) ? fexp2(c1[r] - mx) : 0.f;
      c2[r] = (c2[r] > -1e29f) ? fexp2(c2[r] - mx) : 0.f; c3[r] = (c3[r] > -1e29f) ? fexp2(c3[r] - mx) : 0.f;
      ls += (c0[r] + c1[r]) + (c2[r] + c3[r]);
    }
    ls = xhalf_sum(ls);
    const float inv = (ls > 0.f) ? 1.f / ls : 0.f;
#pragma unroll
    for (int r = 0; r < 16; ++r) { c0[r] *= inv; c1[r] *= inv; c2[r] *= inv; c3[r] *= inv; }
    if (qt <= 15) {
      selmask = (1u << (qt + 1)) - 1u;
    } else {
      float av[16], cv[16];
#pragma unroll
      for (int k = 0; k < 4; ++k)
#pragma unroll
        for (int gg = 0; gg < 4; ++gg) {
          const f32x16& c = (k == 0) ? c0 : (k == 1) ? c1 : (k == 2) ? c2 : c3;
          float half3 = 0.5f * c[4 * gg + 3];
          av[4 * k + gg] = c[4 * gg] + c[4 * gg + 1] + c[4 * gg + 2] + half3; cv[4 * k + gg] = half3;
        }
      float imp[16];
#pragma unroll
      for (int i = 0; i < 16; ++i) {
        auto x2 = __builtin_amdgcn_permlane32_swap(__float_as_uint(cv[i]), __float_as_uint(cv[i]), false, false);
        float oc = h ? __uint_as_float(x2[0]) : __uint_as_float(x2[1]);
        cv[i] = oc;
      }
#pragma unroll
      for (int i = 0; i < 16; ++i) {
        float carry = h ? cv[i] : (i > 0 ? cv[i - 1] : 0.f);
        float v = av[i] + carry;
        v += __shfl_xor(v, 1); v += __shfl_xor(v, 2);
        imp[i] = v;
      }
      float* impL = (float*)(smem + 131072) + wid * 256;
      if (rr == 0) {
#pragma unroll
        for (int i = 0; i < 16; ++i) impL[(l31 >> 2) * 32 + 2 * i + h] = imp[i];
      }
      asm volatile("s_waitcnt lgkmcnt(0)" ::: "memory");
      __builtin_amdgcn_wave_barrier();
      const int sub = rr + 4 * h;
      const float* vrow = impL + (l31 >> 2) * 32;
      f32x4 mine = *(const f32x4*)(vrow + 4 * sub);
      int cnt[4] = {0, 0, 0, 0};
#pragma unroll 4
      for (int j2 = 1; j2 <= qt - 2; ++j2) {
        float w = vrow[j2];
#pragma unroll
        for (int e = 0; e < 4; ++e) { int j = 4 * sub + e; cnt[e] += (w > mine[e] || (w == mine[e] && j2 < j)) ? 1 : 0; }
      }
      unsigned nib = 0;
#pragma unroll
      for (int e = 0; e < 4; ++e) { int j = 4 * sub + e; if (j >= 1 && j <= qt - 2 && cnt[e] < 13) nib |= 1u << j; }
      nib |= (unsigned)__shfl_xor((int)nib, 1); nib |= (unsigned)__shfl_xor((int)nib, 2); nib |= (unsigned)__shfl_xor((int)nib, 32);
      selmask = nib | 1u | (1u << qt) | (1u << (qt - 1));
    }
    zero_o(o);
    pv_tile(o, vr0, vr1, c0, c1);
    pv_tile(o, vr0 + 32768, vr1 + 32768, c2, c3);
#pragma unroll
    for (int d = 0; d < 4; ++d)
#pragma unroll
      for (int g2_ = 0; g2_ < 2; ++g2_) {
        f16x8 v;
#pragma unroll
        for (int e = 0; e < 8; ++e) v[e] = (f16)(g0 * o[d][8 * g2_ + e]);
        *(f16x8*)(otg + (2 * d + g2_) * 8192) = v;
      }
  }
  f16x8 rv[8];
#define NSA_STEP(n_) do { ring_wait4(issued - 1 - (n_)); ring_bar(); while (issued <= (n_) + 2 && issued < NTILE) { NSA_ISSUE(issued); ++issued; } } while (0)
  float m, l = 0.f;
  zero_o(o);
  {
    const int na = 2, nb = 2 + qt;
    f32x16 c0, c1;
    NSA_STEP(na);
    qk128(c0, c1, smem + (na & 3) * 32768, qf, kbe, kbo);
    {
      int tlx = tl - 4 * h; asm volatile("" : "+v"(tlx));
#pragma unroll
      for (int r = 0; r < 16; ++r) { const int key = crow(r, 0); c0[r] = (key <= tlx) ? c0[r] : NEG; c1[r] = (key + 32 <= tlx) ? c1[r] : NEG; }
    }
    m = rowmax32(c0, c1);
    bool selc = true;
    f32x16 x0, x1;
#define SLC_STEP(C0, C1, X0, X1) do { \
      NSA_STEP(n + 1); \
      const float me = selc ? m : 1e30f; float ps, pmn; \
      qk_exp(X0, X1, smem + ((n + 1) & 3) * 32768, qf, kbe, kbo, C0, C1, me, ps); \
      l += ps; \
      pv_max(o, vr0 + (n & 3) * 32768, vr1 + (n & 3) * 32768, C0, C1, X0, X1, pmn); \
      const bool seln = (selmask >> (qt - (n + 1 - 2))) & 1u; \
      pmn = xhalf_max(pmn); pmn = seln ? pmn : NEG; \
      osm_decide(pmn, m, l, o); \
      selc = seln; } while (0)
    int n = na;
    for (; n + 1 < nb; n += 2) { SLC_STEP(c0, c1, x0, x1); ++n; SLC_STEP(x0, x1, c0, c1); --n; }
    if (n < nb) { SLC_STEP(c0, c1, x0, x1); c0 = x0; c1 = x1; }
#undef SLC_STEP
#pragma unroll
    for (int k = 0; k < 8; ++k) rv[k] = *(const f16x8*)(otg + k * 8192);
    { const float me = selc ? m : 1e30f; float ps; exp_only(c0, c1, me, ps); l += ps; pv_tile(o, vr0 + (nb & 3) * 32768, vr1 + (nb & 3) * 32768, c0, c1); }
  }
  {
    float lt = xhalf_sum(l); float sc = g1 / lt;
#pragma unroll
    for (int d = 0; d < 4; ++d)
#pragma unroll
      for (int g2_ = 0; g2_ < 2; ++g2_) {
        f16x8 v = rv[2 * d + g2_];
#pragma unroll
        for (int e = 0; e < 8; ++e) v[e] = (f16)((float)v[e] + sc * o[d][8 * g2_ + e]);
        *(f16x8*)(otg + (2 * d + g2_) * 8192) = v;
      }
  }
  f16* mp = (f16*)(Zc + (size_t)((row * ZW + ZC_GATE + head * 128 + 4 * h) * 2u));
  f16x8 pvs[8]; f16x4 gts[16];
  l = 0.f; zero_o(o);
  {
    const int na = 3 + qt, nb = NTILE - 1;
    f32x16 c0, c1;
    NSA_STEP(na);
    qk128(c0, c1, smem + (na & 3) * 32768, qf, kbe, kbo);
    {
      int tlx = tl - 4 * h; asm volatile("" : "+v"(tlx));
#pragma unroll
      for (int r = 0; r < 16; ++r) { const int key = crow(r, 0); c0[r] = (key <= tlx) ? c0[r] : NEG; c1[r] = (key + 32 <= tlx) ? c1[r] : NEG; }
    }
    m = rowmax32(c0, c1);
    f32x16 x0, x1;
#define WIN_STEP(C0, C1, X0, X1) do { \
      NSA_STEP(n + 1); \
      float ps, pmn; \
      qk_exp(X0, X1, smem + ((n + 1) & 3) * 32768, qf, kbe, kbo, C0, C1, m, ps); \
      l += ps; \
      pv_max(o, vr0 + (n & 3) * 32768, vr1 + (n & 3) * 32768, C0, C1, X0, X1, pmn); \
      pmn = xhalf_max(pmn); \
      osm_decide(pmn, m, l, o); } while (0)
    int n = na;
    for (; n + 1 < nb; n += 2) { WIN_STEP(c0, c1, x0, x1); ++n; WIN_STEP(x0, x1, c0, c1); --n; }
    if (n < nb) { WIN_STEP(c0, c1, x0, x1); c0 = x0; c1 = x1; }
#undef WIN_STEP
    if (nwin == 9) {
      int tlx = tl - 4 * h; asm volatile("" : "+v"(tlx));
#pragma unroll
      for (int r = 0; r < 16; ++r) { const int key = crow(r, 0); c0[r] = (key > tlx) ? c0[r] : NEG; c1[r] = (key + 32 > tlx) ? c1[r] : NEG; }
    }
#pragma unroll
    for (int i = 0; i < 8; ++i) pvs[i] = *(const f16x8*)(otg + i * 8192);
#pragma unroll
    for (int i = 0; i < 16; ++i) gts[i] = *(const f16x4*)(mp + 32 * (i >> 2) + 8 * (i & 3));
    { float ps; exp_only(c0, c1, m, ps); l += ps; pv_tile(o, vr0 + (nb & 3) * 32768, vr1 + (nb & 3) * 32768, c0, c1); }
  }
#undef NSA_STEP
#undef NSA_ISSUE
  const float scw = g2 / xhalf_sum(l);
#pragma unroll
  for (int d = 0; d < 4; ++d)
#pragma unroll
    for (int g2_ = 0; g2_ < 2; ++g2_) {
      const f16x8 pv = pvs[2 * d + g2_];
#pragma unroll
      for (int q = 0; q < 2; ++q) {
        const int gg = 2 * g2_ + q;
        const f16x4 gt = gts[4 * d + gg]; f16x4 v;
#pragma unroll
        for (int e = 0; e < 4; ++e) v[e] = (f16)(((float)pv[4 * q + e] + scw * o[d][4 * gg + e]) * siluf_((float)gt[e]));
        *(f16x4*)(mp + 32 * d + 8 * gg) = v;
      }
    }
  ring_bar();
}

DI void mem_unit(const Params& p, int b, int hm, int half, char* smem) {
  const int wid = __builtin_amdgcn_readfirstlane(threadIdx.x >> 6);
  int tid_ = threadIdx.x; asm volatile("" : "+v"(tid_)); const int tid = tid_, lane = tid & 63, l31 = lane & 31, h = lane >> 5;
  f16* Z = (f16*)(p.ws + WS_Z);
  LAS unsigned char* lds = (LAS unsigned char*)smem;
  const unsigned ldsw = (unsigned)wid * 1024u;
  const char* Kb = p.ws + WS_KVM + ((size_t)(b * 256) * 1024 + hm * 128) * 2;
  const char* Vb = Kb + 1024;
  const unsigned kvo = dma_voff128(wid, lane, 2048);
  const size_t row0 = (size_t)b * NT + 1024 * half + 32 * wid + l31;
  wait_count((unsigned*)(p.ws + WS_CTR) + 80 + b, 4u);
  f16x8 qa[8], qb[8];
#define MEM_QLOAD(Q, i_) do { const f16* qrow = Z + (row0 + 256 * (i_)) * ZW + ZC_QM + hm * 128 + 8 * h; \
    _Pragma("unroll") for (int s = 0; s < 8; ++s) Q[s] = *(const f16x8*)(qrow + 16 * s); } while (0)
  MEM_QLOAD(qa, 0);
#pragma unroll
  for (int i = 0; i < 4; ++i) dma_kv128(lds + i * 32768, ldsw, Kb + (size_t)(64 * i) * 2048, Vb + (size_t)(64 * i) * 2048, kvo, 2048);
  const unsigned kbe = 2048 * (l31 >> 3) + 64 * (l31 & 7) + 16 * ((h) ^ ((l31 >> 2) & 3));
  const unsigned kbo = 2048 * (l31 >> 3) + 64 * (l31 & 7) + 16 * ((2 + h) ^ ((l31 >> 2) & 3));
  const int q4 = (lane & 15) >> 2, p4 = lane & 3, blk = (lane >> 4) & 1;
  const unsigned sbase = (unsigned)(uintptr_t)smem;
  const unsigned vr0 = sbase + 16384 + 64 * (4 * h + q4) + 16 * ((2 * blk + (p4 >> 1)) ^ (h)) + 8 * (p4 & 1);
  const unsigned vr1 = sbase + 16384 + 64 * (4 * h + q4) + 16 * ((2 * blk + (p4 >> 1)) ^ (2 + h)) + 8 * (p4 & 1);
  asm volatile("s_waitcnt vmcnt(0)" ::: "memory");
  ring_bar();
#define MEM_QTILE(Q, QN, i_) do { \
    f16* mp = Z + (row0 + 256 * (i_)) * ZW + ZC_GATE + 1536 + hm * 128 + 4 * h; \
    f16x4 gts[16]; \
    _Pragma("unroll") for (int i = 0; i < 16; ++i) gts[i] = *(const f16x4*)(mp + 32 * (i >> 2) + 8 * (i & 3)); \
    if ((i_) + 1 < 4) MEM_QLOAD(QN, (i_) + 1); \
    f32x16 o[4]; zero_o(o); \
    float m = NEG, l = 0.f; \
    _Pragma("unroll 1") for (int kt = 0; kt < 4; ++kt) { \
      f32x16 p0, p1; \
      qk128(p0, p1, smem + kt * 32768, Q, kbe, kbo); \
      osm_step(p0, p1, m, l, o); \
      pv_tile(o, vr0 + kt * 32768, vr1 + kt * 32768, p0, p1); \
    } \
    const float inv = 1.f / xhalf_sum(l); \
    _Pragma("unroll") for (int d = 0; d < 4; ++d) \
      _Pragma("unroll") for (int gg = 0; gg < 4; ++gg) { \
        const f16x4 gt = gts[4 * d + gg]; f16x4 v; \
        _Pragma("unroll") for (int e = 0; e < 4; ++e) v[e] = (f16)(o[d][4 * gg + e] * inv * siluf_((float)gt[e])); \
        *(f16x4*)(mp + 32 * d + 8 * gg) = v; \
      } } while (0)
#pragma unroll 1
  for (int i2 = 0; i2 < 4; i2 += 2) { MEM_QTILE(qa, qb, i2); MEM_QTILE(qb, qa, i2 + 1); }
#undef MEM_QTILE
#undef MEM_QLOAD
  ring_bar();
}

DI void ret_qk(f32x16& n0, f32x16& n1, const char* stg, const f16x8 (&qf)[4], int l31, int h, int xx) {
  const f32x16 zero = {0.f, 0.f, 0.f, 0.f, 0.f, 0.f, 0.f, 0.f, 0.f, 0.f, 0.f, 0.f, 0.f, 0.f, 0.f, 0.f};
#pragma unroll
  for (int s = 0; s < 4; ++s) {
    const unsigned cxs = (unsigned)(((2 * s + h) ^ xx) << 4);
    const f16x8 k0 = *(const f16x8*)(stg + l31 * 128 + cxs);
    const f16x8 k1 = *(const f16x8*)(stg + (l31 + 32) * 128 + cxs);
    n0 = MFMA(k0, qf[s], s == 0 ? zero : n0); n1 = MFMA(k1, qf[s], s == 0 ? zero : n1);
  }
}
DI void ret_qk_decay(f32x16& n0, f32x16& n1, const char* stg, const f16x8 (&qf)[4], int l31, int h, int xx, f32x16& c0, f32x16& c1, const float (&fac)[16], float base, float e32) {
  const f32x16 zero = {0.f, 0.f, 0.f, 0.f, 0.f, 0.f, 0.f, 0.f, 0.f, 0.f, 0.f, 0.f, 0.f, 0.f, 0.f, 0.f};
  const float base1 = base * e32;
#pragma unroll
  for (int s = 0; s < 4; ++s) {
    const unsigned cxs = (unsigned)(((2 * s + h) ^ xx) << 4);
    const f16x8 k0 = *(const f16x8*)(stg + l31 * 128 + cxs);
    const f16x8 k1 = *(const f16x8*)(stg + (l31 + 32) * 128 + cxs);
    n0 = MFMA(k0, qf[s], s == 0 ? zero : n0); n1 = MFMA(k1, qf[s], s == 0 ? zero : n1);
#pragma unroll
    for (int j = 0; j < 4; ++j) { const int r = 4 * s + j; c0[r] *= base * fac[r]; c1[r] *= base1 * fac[r]; }
  }
}
DI void ret_decay(f32x16& c0, f32x16& c1, const float (&fac)[16], float base, float e32) {
  const float base1 = base * e32;
#pragma unroll
  for (int r = 0; r < 16; ++r) { c0[r] *= base * fac[r]; c1[r] *= base1 * fac[r]; }
}
DI void ret_unit(const Params& p, int b, int hr, int tq, char* smem) {
  const int wid = __builtin_amdgcn_readfirstlane(threadIdx.x >> 6);
  int tid_ = threadIdx.x; asm volatile("" : "+v"(tid_)); const int tid = tid_, lane = tid & 63, l31 = lane & 31, h = lane >> 5;
  const int t = 256 * tq + 32 * wid + l31;
  const size_t row = (size_t)b * NT + t;
  f16* Z = (f16*)(p.ws + WS_Z);
  LAS unsigned char* lds = (LAS unsigned char*)smem;
  const unsigned ldsw = (unsigned)wid * 1024u;
  const char* Kb = p.ws + WS_Z + ((size_t)b * NT * ZW + ZC_KR + hr * 64) * 2;
  const char* Vb = p.ws + WS_Z + ((size_t)b * NT * ZW + ZC_VR + hr * 128) * 2;
  const unsigned kvo = dma_voff64(wid, lane, ZW * 2), vvo = dma_voff128(wid, lane, ZW * 2);
  const int ntile = 4 * (tq + 1);
#define RET_ISSUE(n_) do { const int n__ = (n_); LAS unsigned char* st__ = lds + (n__ & 3) * 32768; const size_t ko__ = (size_t)(64 * n__) * ZW * 2; \
    glds16(Kb + ko__ + (size_t)kvo, st__ + ldsw); glds16(Vb + ko__ + (size_t)vvo, st__ + 16384 + ldsw); glds16(Vb + ko__ + (size_t)32 * ZW * 2 + (size_t)vvo, st__ + 16384 + ldsw + 8192); } while (0)
#define RET_STEP(n_) do { ring_wait3(issued - 1 - (n_)); ring_bar(); while (issued <= (n_) + 2 && issued < ntile) { RET_ISSUE(issued); ++issued; } } while (0)
  f16x8 qf[4];
  {
    const f16* qrow = Z + row * ZW + ZC_QR + hr * 64 + 8 * h;
#pragma unroll
    for (int s = 0; s < 4; ++s) qf[s] = *(const f16x8*)(qrow + 16 * s);
  }
  f32x4 rt[2][4];
  { const float* rp = (const float*)(p.ws + WS_ROT) + row * 96 + 32 + 16 * h;
#pragma unroll
    for (int s = 0; s < 2; ++s)
#pragma unroll
      for (int i = 0; i < 4; ++i) rt[s][i] = *(const f32x4*)(rp + 32 * s + 4 * i); }
  RET_ISSUE(0); RET_ISSUE(1); RET_ISSUE(2);
  int issued = 3;
#pragma unroll
  for (int s = 0; s < 2; ++s)
#pragma unroll
    for (int e = 0; e < 8; ++e) {
      const float cs = rt[s][e >> 1][2 * (e & 1)], sn = rt[s][e >> 1][2 * (e & 1) + 1];
      const float x1 = (float)qf[s][e], x2 = (float)qf[s + 2][e];
      qf[s][e] = (f16)(x1 * cs - x2 * sn); qf[s + 2][e] = (f16)(x1 * sn + x2 * cs);
    }
  const float lg = log2f(1.f - exp2f(-5.f - (float)hr));
  float fac[16];
#pragma unroll
  for (int r = 0; r < 16; ++r) fac[r] = fexp2(-lg * (float)crow(r, h));
  const float e32 = fexp2(-lg * 32.f);
  const int xx = (l31 >> 1) & 7;
  const int q4 = (lane & 15) >> 2, p4 = lane & 3, blk = (lane >> 4) & 1;
  const unsigned sbase = (unsigned)(uintptr_t)smem;
  const unsigned vr0 = sbase + 16384 + 64 * (4 * h + q4) + 16 * ((2 * blk + (p4 >> 1)) ^ (h)) + 8 * (p4 & 1);
  const unsigned vr1 = sbase + 16384 + 64 * (4 * h + q4) + 16 * ((2 * blk + (p4 >> 1)) ^ (2 + h)) + 8 * (p4 & 1);
  f32x16 o[4]; zero_o(o);
  const int mykt = 4 * tq + (wid >> 1);
  const int tlw = 32 * (wid & 1) + l31;
  f32x16 c0, c1, x0, x1;
  RET_STEP(0);
  ret_qk(c0, c1, smem, qf, l31, h, xx);
#define RET_BODY(C0, C1, X0, X1) do { \
    RET_STEP(kt + 1); \
    if (kt <= mykt) { \
      const float base = fexp2(lg * (float)(t - 64 * kt)); \
      if (kt < mykt) ret_qk_decay(X0, X1, smem + ((kt + 1) & 3) * 32768, qf, l31, h, xx, C0, C1, fac, base, e32); \
      else { \
        ret_decay(C0, C1, fac, base, e32); \
        int tlx = tlw - 4 * h; asm volatile("" : "+v"(tlx)); \
        _Pragma("unroll") for (int r = 0; r < 16; ++r) { const int key = crow(r, 0); C0[r] = (key <= tlx) ? C0[r] : 0.f; C1[r] = (key + 32 <= tlx) ? C1[r] : 0.f; } \
      } \
      pv_tile(o, vr0 + (kt & 3) * 32768, vr1 + (kt & 3) * 32768, C0, C1); \
    } } while (0)
  int kt = 0;
  for (; kt + 2 < ntile; kt += 2) { RET_BODY(c0, c1, x0, x1); ++kt; RET_BODY(x0, x1, c0, c1); --kt; }
  if (kt + 1 < ntile) { RET_BODY(c0, c1, x0, x1); c0 = x0; c1 = x1; ++kt; }
  if (kt <= mykt) {
    const float base = fexp2(lg * (float)(t - 64 * kt));
    ret_decay(c0, c1, fac, base, e32);
    int tlx = tlw - 4 * h; asm volatile("" : "+v"(tlx));
#pragma unroll
    for (int r = 0; r < 16; ++r) { const int key = crow(r, 0); c0[r] = (key <= tlx) ? c0[r] : 0.f; c1[r] = (key + 32 <= tlx) ? c1[r] : 0.f; }
    pv_tile(o, vr0 + (kt & 3) * 32768, vr1 + (kt & 3) * 32768, c0, c1);
  }
#undef RET_BODY
#undef RET_STEP
#undef RET_ISSUE
  f16* mp = Z + row * ZW + ZC_GATE + 1024 + hr * 128 + 4 * h;
  const float* gn = p.ret_gn + hr * 128 + 4 * h;
  f16x4 gts[16]; f32x4 gvs[16];
#pragma unroll
  for (int i = 0; i < 16; ++i) { gts[i] = *(const f16x4*)(mp + 32 * (i >> 2) + 8 * (i & 3)); gvs[i] = *(const f32x4*)(gn + 32 * (i >> 2) + 8 * (i & 3)); }
  float s1 = 0.f;
#pragma unroll
  for (int d = 0; d < 4; ++d)
#pragma unroll
    for (int r = 0; r < 16; ++r) s1 += o[d][r];
  s1 = xhalf_sum(s1);
  const float mu = s1 * (1.f / 128.f);
  float s2 = 0.f;
#pragma unroll
  for (int d = 0; d < 4; ++d)
#pragma unroll
    for (int r = 0; r < 16; ++r) { float c = o[d][r] - mu; s2 += c * c; }
  s2 = xhalf_sum(s2);
  const float rstd = rsqrtf(s2 * (1.f / 128.f) + 1e-6f);
#pragma unroll
  for (int d = 0; d < 4; ++d)
#pragma unroll
    for (int gg = 0; gg < 4; ++gg) {
      const f16x4 gt = gts[4 * d + gg]; const f32x4 gv = gvs[4 * d + gg]; f16x4 v;
#pragma unroll
      for (int e = 0; e < 4; ++e) v[e] = (f16)((o[d][4 * gg + e] - mu) * rstd * gv[e] * siluf_((float)gt[e]));
      *(f16x4*)(mp + 32 * d + 8 * gg) = v;
    }
  ring_bar();
}

constexpr int ATTN_UNITS = 288 + 64 + 512 + 128 + 1024;
DI unsigned* attn_dispatch(const Params& p, int u, char* smem) {
  int kind, a0, a1;
  if (u < 256) { kind = 3; a0 = u >> 5; a1 = u & 31; }
  else if (u < 288) { kind = 4; a0 = 0; a1 = u - 256; }
  else if (u < 352) { kind = 6; a0 = (u - 288) & 3; a1 = (u - 288) >> 2; }
  else {
    const int v = u - 352;
    if (v < 512) { kind = 1; a0 = 7 - (v >> 6); a1 = v & 63; }
    else if (v < 640) { const int w = v - 512; kind = 2; a0 = w >> 6; a1 = w & 63; }
    else { const int w = v - 640; kind = 0; a0 = 31 - (w >> 5); a1 = w & 31; }
  }
  unsigned* ctrs = (unsigned*)(p.ws + WS_CTR);
  unsigned* pend = nullptr;
  if (p.dry > 1) { const int kb = (kind == 0) ? 2 : (kind == 1) ? 4 : (kind == 2) ? 8 : 16; if (!(p.dry & kb)) return nullptr; }
  if (kind == 0) nsa_unit(p, a1 >> 1, a1 & 1, a0, smem);
  else if (kind == 1) ret_unit(p, a1 >> 2, a1 & 3, a0, smem);
  else if (kind == 2) mem_unit(p, a1 >> 2, a1 & 3, a0, smem);
  else if (kind == 6) { memkv_unit(p, a1, a0, smem); unit_drain(); pend = ctrs + 80 + a1; }
  else if (kind == 3) { csplit_unit(p, a1 >> 4, a1 & 15, a0, smem); pend = ctrs + 16 + a1; }
  else { cfin_unit(p, a1 >> 4, a1 & 15, smem); pend = ctrs + 64 + (a1 & 15); }
  return pend;
}

DI void phase_attn(const Params& p, char* smem, int ulo, int uhi, int cidx) {
  unsigned* ctr = (unsigned*)(p.ws + WS_CTR) + cidx;
  int* su = (int*)(smem + LDS_IMG + 16);
  unsigned* pend = nullptr;
  int nextu = 0;
  if (threadIdx.x == 0) nextu = ulo + (int)blockIdx.x;
  for (;;) {
    if (threadIdx.x == 0) {
      if (pend) publish_arrive(pend);
      *su = nextu;
    }
    __syncthreads();
    const int u = *su;
    __syncthreads();
    if (u >= uhi) { pend = nullptr; break; }
    if (threadIdx.x == 0) nextu = ulo + (int)gridDim.x + (int)atomicAdd(ctr, 1u);
    pend = attn_dispatch(p, u, smem);
  }
}

DI void phase_final(const Params& p) {
  int tid_ = threadIdx.x; asm volatile("" : "+v"(tid_));
  const int tid = tid_ & 511, lane = tid & 63, wid = __builtin_amdgcn_readfirstlane(tid >> 6);
  const float* PSS = (const float*)(p.ws + WS_PSS);
  const int G = gridDim.x;
  f32x4 g[4];
#pragma unroll
  for (int i = 0; i < 4; ++i) g[i] = *(const f32x4*)(p.norm_post + (i >> 1) * 512 + lane * 8 + 4 * (i & 1));
#define FIN_LOAD(Y, X, S, u_) do { const int row_ = (u_) * 8 + wid; \
    S = (lane < 16) ? PSS[(size_t)row_ * 16 + lane] : 0.f; \
    const f16* yi_ = (const f16*)(p.ws + WS_Y) + (size_t)row_ * 1024; const float* xi_ = p.x + (size_t)row_ * 1024; \
    Y[0] = *(const f16x8*)(yi_ + lane * 8); Y[1] = *(const f16x8*)(yi_ + 512 + lane * 8); \
    _Pragma("unroll") for (int i = 0; i < 4; ++i) X[i] = *(const f32x4*)(xi_ + (i >> 1) * 512 + lane * 8 + 4 * (i & 1)); } while (0)
#define FIN_ROW(Y, X, S, u_) do { float ss_ = S; \
    _Pragma("unroll") for (int o = 8; o >= 1; o >>= 1) ss_ += __shfl_xor(ss_, o); \
    ss_ = __shfl(ss_, 0); \
    const float rstd_ = rsqrtf(ss_ * (1.f / 1024.f) + 1e-6f); \
    float* yo_ = p.out + (size_t)((u_) * 8 + wid) * 1024; \
    _Pragma("unroll") for (int i = 0; i < 4; ++i) { const f16x8& y_ = Y[i >> 1]; const int q_ = i & 1; f32x4 r_; \
      r_[0] = X[i][0] + (float)y_[4 * q_] * rstd_ * g[i][0]; r_[1] = X[i][1] + (float)y_[4 * q_ + 1] * rstd_ * g[i][1]; \
      r_[2] = X[i][2] + (float)y_[4 * q_ + 2] * rstd_ * g[i][2]; r_[3] = X[i][3] + (float)y_[4 * q_ + 3] * rstd_ * g[i][3]; \
      *(f32x4*)(yo_ + (i >> 1) * 512 + lane * 8 + 4 * q_) = r_; } } while (0)
  f16x8 ya[2], yb[2]; f32x4 xa[4], xb[4]; float sa = 0.f, sb = 0.f;
  int u = blockIdx.x;
  if (u < NTOK / 8) FIN_LOAD(ya, xa, sa, u);
  while (u < NTOK / 8) {
    { const int un = u + G; if (un < NTOK / 8) FIN_LOAD(yb, xb, sb, un); FIN_ROW(ya, xa, sa, u); u = un; }
    if (u >= NTOK / 8) break;
    { const int un = u + G; if (un < NTOK / 8) FIN_LOAD(ya, xa, sa, un); FIN_ROW(yb, xb, sb, u); u = un; }
  }
#undef FIN_LOAD
#undef FIN_ROW
}

#define XB_TMO      128
#define XB_XCNT(j)  (256  + 64 * (j))
#define XB_XSUB(j)  (1280 + 64 * (j))
#define XB_XGEN(j)  (2304 + 64 * (j))
#define XB_TOP      3328
#define XB_TOPGEN   3392
#define XCD_BAR_WORDS 3456
#define XB_SPIN_CAP (1u << 22)
DI unsigned xb_ld(unsigned* p) { return __hip_atomic_load(p, __ATOMIC_RELAXED, __HIP_MEMORY_SCOPE_AGENT); }
DI unsigned xb_add(unsigned* p, unsigned v) { return __hip_atomic_fetch_add(p, v, __ATOMIC_RELAXED, __HIP_MEMORY_SCOPE_AGENT); }
DI unsigned xb_xcc_id() { return (unsigned)__builtin_amdgcn_s_getreg((3 << 11) | 20) & 0xFu; }
#define XB_SPIN(cond, bar) do { unsigned _sp = 0; while (cond) { __builtin_amdgcn_s_sleep(1); \
    if ((++_sp & 255u) == 0u) { if (xb_ld(&(bar)[XB_TMO])) break; if (_sp > XB_SPIN_CAP) { atomicAdd(&(bar)[XB_TMO], 1u); break; } } } } while (0)
struct XcdBarrier { unsigned* bar; unsigned x; volatile LAS unsigned* st; };
DI XcdBarrier xcd_barrier_post(unsigned* bar, volatile LAS unsigned* st) {
  XcdBarrier b; b.bar = bar; b.x = xb_xcc_id(); b.st = st;
  if (threadIdx.x == 0) (void)xb_add(&bar[XB_XCNT(b.x)], 1u);
  return b;
}
DI void xcd_barrier_complete(unsigned* bar, unsigned x, unsigned& nloc, unsigned& nx) {
  const unsigned G = gridDim.x * gridDim.y * gridDim.z;
  unsigned sum, cnt, mine, sp = 0u;
  for (;;) {
    sum = 0u; cnt = 0u; mine = 0u;
#pragma unroll
    for (unsigned j = 0; j < 16; ++j) { const unsigned c = xb_ld(&bar[XB_XCNT(j)]); sum += c; cnt += (c > 0u) ? 1u : 0u; mine = (j == x) ? c : mine; }
    if (sum == G) break;
    __builtin_amdgcn_s_sleep(1);
    if ((++sp & 255u) == 0u) { if (xb_ld(&bar[XB_TMO])) break; if (sp > XB_SPIN_CAP) { atomicAdd(&bar[XB_TMO], 1u); break; } }
  }
  nloc = mine > 0u ? mine : 1u; nx = cnt > 0u ? cnt : 1u;
}
DI void xcd_barrier(const XcdBarrier& b) {
  asm volatile("s_waitcnt vmcnt(0)" ::: "memory");
  __syncthreads();
  if (threadIdx.x == 0) {
    unsigned* bar = b.bar;
    __builtin_amdgcn_s_waitcnt(0);
    unsigned nloc = b.st[0], nx = b.st[1];
    if (nloc == 0u) { xcd_barrier_complete(bar, b.x, nloc, nx); b.st[0] = nloc; b.st[1] = nx; }
    const unsigned old = xb_add(&bar[XB_XSUB(b.x)], 1u);
    const unsigned gen = old / nloc;
    if (old + 1u == (gen + 1u) * nloc) {
      __builtin_amdgcn_fence(__ATOMIC_RELEASE, "agent");
      asm volatile("s_waitcnt vmcnt(0)" ::: "memory");
      const unsigned og = xb_add(&bar[XB_TOP], 1u);
      const unsigned tg = og / nx;
      if (og + 1u == (tg + 1u) * nx) xb_add(&bar[XB_TOPGEN], 1u);
      else XB_SPIN(xb_ld(&bar[XB_TOPGEN]) == tg, bar);
      __builtin_amdgcn_fence(__ATOMIC_ACQUIRE, "agent");
      xb_add(&bar[XB_XGEN(b.x)], 1u);
      asm volatile("s_waitcnt vmcnt(0)" ::: "memory");
    } else {
      XB_SPIN(xb_ld(&bar[XB_XGEN(b.x)]) == gen, bar);
      __builtin_amdgcn_fence(__ATOMIC_ACQUIRE, "agent");
      asm volatile("s_waitcnt vmcnt(0)" ::: "memory");
    }
  }
  __syncthreads();
}

template <int PH>
__global__ void __launch_bounds__(512, 2) hybrid_kernel(Params p) {
  __shared__ __attribute__((aligned(16))) char smem[LDS_BYTES];
  if (PH == -1) {
    unsigned* bar = (unsigned*)(p.ws + WS_BAR);
    volatile LAS unsigned* xst = (volatile LAS unsigned*)(smem + LDS_IMG);
    if (threadIdx.x == 0) { xst[0] = 0u; xst[1] = 0u; }
    __syncthreads();
    XcdBarrier xb = xcd_barrier_post(bar, xst);
    phase_prep(p, smem); xcd_barrier(xb);
    phase_gemm1(p, smem); xcd_barrier(xb);
    phase_attn(p, smem, 0, ATTN_UNITS, 0); xcd_barrier(xb);
    phase_gemm2(p, smem); xcd_barrier(xb);
    phase_final(p);
  } else {
    if (PH == 0) phase_prep(p, smem);
    if (PH == 1) phase_gemm1(p, smem);
    if (PH == 3) phase_attn(p, smem, 0, ATTN_UNITS, 0);
    if (PH == 4) phase_gemm2(p, smem);
    if (PH == 5) phase_final(p);
  }
}

extern "C" void kernel_launch(void* const* d_in, const int* in_sizes, int n_in, void* d_out, int out_size, void* d_ws, size_t ws_size, hipStream_t stream) {
  if (ws_size < WS_END) { fprintf(stderr, "kernel_launch: workspace too small: %zu < %zu\n", ws_size, (size_t)WS_END); return; }
  Params p{};
  p.x = (const float*)d_in[0]; p.mem = (const float*)d_in[1]; p.pos = (const int*)d_in[2]; p.norm_pre = (const float*)d_in[3]; p.w_in = (const float*)d_in[4];
  p.cpk = (const float*)d_in[5]; p.w1k = (const float*)d_in[6]; p.w2k = (const float*)d_in[7]; p.cpv = (const float*)d_in[8]; p.w1v = (const float*)d_in[9]; p.w2v = (const float*)d_in[10];
  p.ret_gn = (const float*)d_in[11]; p.mem_norm = (const float*)d_in[12]; p.w_mem_kv = (const float*)d_in[13]; p.w_out = (const float*)d_in[14]; p.norm_post = (const float*)d_in[15];
  p.out = (float*)d_out; p.ws = (char*)d_ws;
#if MEGA
  static int grid_blocks = 0;
  if (!grid_blocks) {
    int dev = 0, cus = 0, per_cu = 0;
    hipGetDevice(&dev); hipDeviceGetAttribute(&cus, hipDeviceAttributeMultiprocessorCount, dev);
    hipOccupancyMaxActiveBlocksPerMultiprocessor(&per_cu, hybrid_kernel<-1>, 512, 0);
    if (per_cu < 1) { fprintf(stderr, "kernel_launch: occupancy query returned %d\n", per_cu); return; }
    grid_blocks = cus;
  }
  (void)hipMemsetAsync(p.ws + WS_CTR, 0, WS_Y - WS_CTR, stream);
  hipLaunchKernelGGL(hybrid_kernel<-1>, dim3(grid_blocks), dim3(512), 0, stream, p);
  hipError_t e = hipGetLastError();
  if (e != hipSuccess) fprintf(stderr, "launch failed: %s (grid %d)\n", hipGetErrorString(e), grid_blocks);
#else
  hipLaunchKernelGGL(hybrid_kernel<0>, dim3(256), dim3(512), 0, stream, p);
  if (PROBE_DUP == 0) hipLaunchKernelGGL(hybrid_kernel<0>, dim3(256), dim3(512), 0, stream, p);
  hipLaunchKernelGGL(hybrid_kernel<1>, dim3(256), dim3(512), 0, stream, p);
  if (PROBE_DUP == 1) hipLaunchKernelGGL(hybrid_kernel<1>, dim3(256), dim3(512), 0, stream, p);
  hipLaunchKernelGGL(hybrid_kernel<3>, dim3(256), dim3(512), 0, stream, p);
  if (PROBE_DUP == 3) { Params q = p; q.dry = PROBE_ATT; (void)hipMemsetAsync(p.ws + WS_CTR, 0, 4, stream); hipLaunchKernelGGL(hybrid_kernel<3>, dim3(256), dim3(512), 0, stream, q); }
  hipLaunchKernelGGL(hybrid_kernel<4>, dim3(256), dim3(512), 0, stream, p);
  if (PROBE_DUP == 4) hipLaunchKernelGGL(hybrid_kernel<4>, dim3(256), dim3(512), 0, stream, p);
  hipLaunchKernelGGL(hybrid_kernel<5>, dim3(256), dim3(512), 0, stream, p);
#endif
}
```

```cpp
#include <hip/hip_runtime.h>
#include <hip/hip_cooperative_groups.h>
#include <cstdio>
#include <cstdint>
namespace cg = cooperative_groups;

#ifndef MEGA
#define MEGA 1
#endif
#ifndef PROBE_DUP
#define PROBE_DUP -1
#endif
#ifndef PROBE_ATT
#define PROBE_ATT 1
#endif

typedef _Float16 f16;
typedef _Float16 f16x8 __attribute__((ext_vector_type(8)));
typedef _Float16 f16x4 __attribute__((ext_vector_type(4)));
typedef float f32x16 __attribute__((ext_vector_type(16)));
typedef float f32x4 __attribute__((ext_vector_type(4)));
#define DI __device__ __forceinline__
#define MFMA(a, b, c) __builtin_amdgcn_mfma_f32_32x32x16_f16((a), (b), (c), 0, 0, 0)
#define SBAR() __builtin_amdgcn_sched_barrier(0)
#define LAS __attribute__((address_space(3)))

constexpr int NB = 16, NT = 2048, DM = 1024, NTOK = NB * NT, ZW = 6144;
constexpr int ZC_QN = 0, ZC_KV = 1024, ZC_QR = 2560, ZC_KR = 2816, ZC_VR = 3072, ZC_QM = 3584, ZC_GATE = 4096;
constexpr float QSCALE = 0.08838834764831845f * 1.4426950408889634f;
constexpr float THR = 8.f;
constexpr float NEG = -1e30f;

constexpr size_t al256(size_t x) { return (x + 255) / 256 * 256; }
constexpr size_t WS_Z = 0;
constexpr size_t WS_GATES = WS_Z + (size_t)NTOK * ZW * 2;
constexpr size_t WS_WINT = WS_GATES + (size_t)NTOK * 24 * 4;
constexpr size_t WS_WOUTT = WS_WINT + al256((size_t)6168 * 1024 * 2);
constexpr size_t WS_WMEMT = WS_WOUTT + (size_t)1024 * 2048 * 2;
constexpr size_t WS_W1T = WS_WMEMT + (size_t)1024 * 1024 * 2;
constexpr size_t WS_W2T = WS_W1T + (size_t)2 * 256 * 4096 * 2;
constexpr size_t WS_MEMN = WS_W2T + (size_t)2 * 128 * 256 * 2;
constexpr size_t WS_KVM = WS_MEMN + (size_t)4096 * 1024 * 2;
constexpr size_t WS_ROT = WS_KVM + (size_t)4096 * 1024 * 2;
constexpr size_t WS_PB1 = WS_ROT + (size_t)NTOK * 48 * 2 * 4;
constexpr size_t WS_HID = WS_PB1 + (size_t)2 * 16 * 256 * 4;
constexpr size_t WS_KC = WS_HID + (size_t)2 * 4096 * 256 * 2;
constexpr size_t WS_PSS = WS_KC + (size_t)2 * 4096 * 128 * 2;
constexpr size_t WS_CTR = WS_PSS + (size_t)NTOK * 16 * 4;
constexpr size_t WS_BAR = WS_CTR + 4096;
constexpr size_t WS_Y = WS_BAR + 16384;
constexpr size_t WS_END = WS_Y + (size_t)NTOK * 1024 * 2;

constexpr int LDS_IMG = 8 * 128 * 144;
constexpr int LDS_BYTES = LDS_IMG + 64;

struct Params {
  const float* x; const float* mem; const int* pos; const float* norm_pre; const float* w_in;
  const float* cpk; const float* w1k; const float* w2k; const float* cpv; const float* w1v; const float* w2v;
  const float* ret_gn; const float* mem_norm; const float* w_mem_kv; const float* w_out; const float* norm_post;
  float* out; char* ws;
  int dry;
  int pad_;
};

DI int crow(int r, int h) { return (r & 3) + 8 * (r >> 2) + 4 * h; }
DI unsigned swz128(int r, int c) { return (unsigned)(r * 128 + ((c ^ ((r >> 1) & 7)) << 4)); }
DI unsigned off_a(int row, int ch) { return (unsigned)(2048 * (row >> 3) + 512 * (ch >> 2) + 64 * (row & 7) + 16 * ((ch & 3) ^ ((row >> 2) & 3))); }
DI float xhalf_max(float v) { auto rr = __builtin_amdgcn_permlane32_swap(__float_as_uint(v), __float_as_uint(v), false, false); return fmaxf(__uint_as_float(rr[0]), __uint_as_float(rr[1])); }
DI float xhalf_sum(float v) { auto rr = __builtin_amdgcn_permlane32_swap(__float_as_uint(v), __float_as_uint(v), false, false); return __uint_as_float(rr[0]) + __uint_as_float(rr[1]); }
DI float fexp2(float x) { return __builtin_amdgcn_exp2f(x); }
DI float sigmoidf_(float x) { return __builtin_amdgcn_rcpf(1.f + __expf(-x)); }
DI float siluf_(float x) { return x * __builtin_amdgcn_rcpf(1.f + __expf(-x)); }
DI float gelu_tanh(float x) { float u = 0.7978845608028654f * (x + 0.044715f * x * x * x); float e = __expf(2.f * u); float t = 1.f - 2.f / (e + 1.f); return 0.5f * x * (1.f + t); }
template <int OFF> DI f16x4 tr_read(unsigned addr) { f16x4 r; asm volatile("ds_read_b64_tr_b16 %0, %1 offset:%2" : "=&v"(r) : "v"(addr), "i"(OFF) : "memory"); return r; }

struct TrU { const float* src; f16* dst; int N, ldd, k0, n0, remap; };
DI void tr_decode(const Params& p, int u, TrU& t) {
  char* ws = p.ws;
  int kt, nt; t.remap = 0;
  if (u < 1552) { t.src = p.w_in; t.N = 6168; t.dst = (f16*)(ws + WS_WINT); t.ldd = 1024; kt = u / 97; nt = u - kt * 97; t.remap = 1; }
  else if (u < 2064) { u -= 1552; t.src = p.w_out; t.N = 1024; t.dst = (f16*)(ws + WS_WOUTT); t.ldd = 2048; kt = u >> 4; nt = u & 15; }
  else if (u < 2320) { u -= 2064; t.src = p.w_mem_kv; t.N = 1024; t.dst = (f16*)(ws + WS_WMEMT); t.ldd = 1024; kt = u >> 4; nt = u & 15; }
  else if (u < 2832) { u -= 2320; const int kv = u >> 8, v = u & 255; t.src = kv ? p.w1v : p.w1k; t.N = 256; t.dst = (f16*)(ws + WS_W1T) + (size_t)kv * 256 * 4096; t.ldd = 4096; kt = v >> 2; nt = v & 3; }
  else { u -= 2832; const int kv = u >> 3, v = u & 7; t.src = kv ? p.w2v : p.w2k; t.N = 128; t.dst = (f16*)(ws + WS_W2T) + (size_t)kv * 128 * 256; t.ldd = 256; kt = v >> 1; nt = v & 1; }
  t.k0 = kt * 64; t.n0 = nt * 64;
}
DI void tr_load(const TrU& t, float (&v)[8], int tid) {
#pragma unroll
  for (int i = 0; i < 8; ++i) { const int e = tid + 512 * i, kk = e >> 6, nn = e & 63; const int n = min(t.n0 + nn, t.N - 1); v[i] = t.src[(size_t)(t.k0 + kk) * t.N + n]; }
}
constexpr int N_TR_UNITS = 2848;

#define MFMA16(a, b, c) __builtin_amdgcn_mfma_f32_16x16x32_f16((a), (b), (c), 0, 0, 0)
DI void phase_prep(const Params& p, char* smem) {
  const int tid = threadIdx.x, lane = tid & 63, wid = tid >> 6;
  const int G = gridDim.x;
  char* ws = p.ws;
  if (blockIdx.x == 0 && tid < 128) ((unsigned*)(ws + WS_CTR))[tid] = 0u;
  {
    LAS unsigned char* lds_ = (LAS unsigned char*)smem;
    {
      float wv[48];
#pragma unroll
      for (int i = 0; i < 48; ++i) { const int e = tid + 512 * i, k = e / 24, n = e - 24 * k; wv[i] = p.w_in[(size_t)k * 6168 + 2560 + n]; }
#pragma unroll
      for (int i = 0; i < 48; ++i) { const int e = tid + 512 * i, k = e / 24, n = e - 24 * k; *(LAS f16*)(lds_ + 32768 + n * 2064 + k * 2) = (f16)wv[i]; }
    }
    for (int e = tid; e < 8 * 1032; e += 512) { const int n = 24 + e / 1032, k = e % 1032; *(LAS f16*)(lds_ + 32768 + n * 2064 + k * 2) = (f16)0.f; }
    __syncthreads();
  }
  {
    float* tile = (float*)smem;
    int u = blockIdx.x; TrU t; float v[8];
    if (u < N_TR_UNITS) { tr_decode(p, u, t); tr_load(t, v, tid); }
    while (u < N_TR_UNITS) {
#pragma unroll
      for (int i = 0; i < 8; ++i) { const int e = tid + 512 * i; tile[(e >> 6) * 65 + (e & 63)] = v[i]; }
      __syncthreads();
      TrU tn = t; const int un = u + G;
      if (un < N_TR_UNITS) { tr_decode(p, un, tn); tr_load(tn, v, tid); }
#pragma unroll
      for (int i = 0; i < 4; ++i) {
        const int e = tid + 512 * i, nn = e >> 5, kk = (e & 31) * 2; const int n = t.n0 + nn;
        if (n < t.N) {
          int nd = n;
          if (t.remap) nd = (n < 2560) ? n : ((n < 2584) ? (6144 + n - 2560) : (n - 24));
          typedef _Float16 h2 __attribute__((ext_vector_type(2)));
          h2 w; w[0] = (f16)tile[kk * 65 + nn]; w[1] = (f16)tile[(kk + 1) * 65 + nn];
          *(h2*)(t.dst + (size_t)nd * t.ldd + t.k0 + kk) = w;
        }
      }
      __syncthreads();
      t = tn; u = un;
    }
  }
  f16* H = (f16*)p.out; f16* MEMN = (f16*)(ws + WS_MEMN);
#define RMS_ROW(V, DST) do { float ss_ = 0.f; \
      _Pragma("unroll") for (int i = 0; i < 4; ++i) ss_ += V[i][0] * V[i][0] + V[i][1] * V[i][1] + V[i][2] * V[i][2] + V[i][3] * V[i][3]; \
      _Pragma("unroll") for (int o = 32; o >= 1; o >>= 1) ss_ += __shfl_xor(ss_, o); \
      const float rstd_ = rsqrtf(ss_ * (1.f / 1024.f) + 1e-6f); \
      _Pragma("unroll") for (int i = 0; i < 4; ++i) { f16x4 o4; o4[0] = (f16)(V[i][0] * rstd_ * gn[i][0]); o4[1] = (f16)(V[i][1] * rstd_ * gn[i][1]); o4[2] = (f16)(V[i][2] * rstd_ * gn[i][2]); o4[3] = (f16)(V[i][3] * rstd_ * gn[i][3]); \
        *(f16x4*)((DST) + i * 256 + lane * 4) = o4; } } while (0)
#define RMS_LOAD(V, SRC) do { _Pragma("unroll") for (int i = 0; i < 4; ++i) V[i] = *(const f32x4*)((SRC) + i * 256 + lane * 4); } while (0)
  {
    f32x4 gn[4];
#pragma unroll
    for (int i = 0; i < 4; ++i) gn[i] = *(const f32x4*)(p.norm_pre + i * 256 + lane * 4);
    f32x4 va[4], vb[4], na[4], nb[4];
    float* GATES = (float*)(ws + WS_GATES);
    LAS unsigned char* lds_ = (LAS unsigned char*)smem;
    const int fr = lane & 15, fq = lane >> 4;
    for (int gi = blockIdx.x; gi < NTOK / 128; gi += G) {
      const int rowbase = 128 * gi + 16 * wid;
      { const float* s0 = p.x + (size_t)rowbase * 1024; RMS_LOAD(va, s0); RMS_LOAD(vb, s0 + 1024); }
#define RMS_STEP(CA, CB, NA, NB, j_) do { \
        if ((j_) + 1 < 8) { const float* s0 = p.x + (size_t)(rowbase + 2 * ((j_) + 1)) * 1024; RMS_LOAD(NA, s0); RMS_LOAD(NB, s0 + 1024); } \
        f16* d0 = H + (size_t)(rowbase + 2 * (j_)) * 1024; \
        RMS_ROW(CA, d0); RMS_ROW(CB, d0 + 1024); } while (0)
#pragma unroll 1
      for (int j = 0; j < 8; j += 2) { RMS_STEP(va, vb, na, nb, j); RMS_STEP(na, nb, va, vb, j + 1); }
#undef RMS_STEP
      asm volatile("s_waitcnt vmcnt(0)" ::: "memory");
      const f16* hrow = H + (size_t)(rowbase + fr) * 1024 + 8 * fq;
      f32x4 g0 = {0.f, 0.f, 0.f, 0.f}, g1 = {0.f, 0.f, 0.f, 0.f};
#pragma unroll 1
      for (int k0 = 0; k0 < 32; k0 += 16) {
        f16x8 af[16];
#pragma unroll
        for (int k = 0; k < 16; ++k) af[k] = *(const f16x8*)(hrow + 32 * (k0 + k));
#pragma unroll
        for (int k = 0; k < 16; ++k) {
          const f16x8 b0 = *(const LAS f16x8*)(lds_ + 32768 + fr * 2064 + (32 * (k0 + k) + 8 * fq) * 2);
          const f16x8 b1 = *(const LAS f16x8*)(lds_ + 32768 + (16 + fr) * 2064 + (32 * (k0 + k) + 8 * fq) * 2);
          g0 = MFMA16(b0, af[k], g0); g1 = MFMA16(b1, af[k], g1);
        }
      }
      float* gp = GATES + (size_t)(rowbase + fr) * 24 + 4 * fq;
#pragma unroll
      for (int j = 0; j < 4; ++j) { g0[j] = sigmoidf_(g0[j]); g1[j] = sigmoidf_(g1[j]); }
      *(f32x4*)gp = g0;
      if (fq < 2) *(f32x4*)(gp + 16) = g1;
    }
  }
  {
    f32x4 gn[4];
#pragma unroll
    for (int i = 0; i < 4; ++i) gn[i] = *(const f32x4*)(p.mem_norm + i * 256 + lane * 4);
    for (int u = blockIdx.x; u < 4096 / 8; u += G) {
      f32x4 va[4]; const int row = u * 8 + wid;
      RMS_LOAD(va, p.mem + (size_t)row * 1024);
      RMS_ROW(va, MEMN + (size_t)row * 1024);
    }
  }
#undef RMS_ROW
#undef RMS_LOAD
  float* ROT = (float*)(ws + WS_ROT);
  for (int e = blockIdx.x * 512 + tid; e < NTOK * 48; e += G * 512) {
    int tok = e / 48, f = e - tok * 48;
    float invf;
    if (f < 16) invf = exp2f(-((float)f / 16.f) * 18.931568569324174f);
    else invf = exp2f(-((float)(f - 16) / 32.f) * 13.287712379549449f);
    const float ang = (float)p.pos[tok] * invf;
    float sn, cs; sincosf(ang, &sn, &cs);
    ROT[(size_t)e * 2] = cs; ROT[(size_t)e * 2 + 1] = sn;
  }
  float* PB1 = (float*)(ws + WS_PB1);
  for (int u = G - 1 - (int)blockIdx.x; u < 32; u += G) {
    const int kv = u >> 4, ch = u & 15; const float* w1 = kv ? p.w1v : p.w1k; const float* cp = kv ? p.cpv : p.cpk;
    const int i0 = ch * 256 + wid * 32;
    f32x4 acc = {0.f, 0.f, 0.f, 0.f};
#pragma unroll 16
    for (int i = 0; i < 32; ++i) { const float c = cp[i0 + i]; const f32x4 w = *(const f32x4*)(w1 + (size_t)(i0 + i) * 256 + lane * 4); acc[0] += c * w[0]; acc[1] += c * w[1]; acc[2] += c * w[2]; acc[3] += c * w[3]; }
    float* red = (float*)smem;
    *(f32x4*)(red + wid * 256 + lane * 4) = acc;
    __syncthreads();
    if (tid < 256) { float sacc = 0.f;
#pragma unroll
      for (int w = 0; w < 8; ++w) sacc += red[w * 256 + tid];
      PB1[(kv * 16 + ch) * 256 + tid] = sacc; }
    __syncthreads();
  }
}

template <class KA, class KB>
DI void gemm_core(f32x16 (&acc)[4][2], const char* baseA, long strideA, unsigned voffA, const char* baseB, long strideB, unsigned voffB,
                  KA koffA, KB koffB, int nk, char* smem) {
  int tid_ = threadIdx.x; asm volatile("" : "+v"(tid_)); const int tid = tid_, lane = tid & 63, wid = tid >> 6, wm = wid >> 2, wn = wid & 3;
  const int lr = tid >> 3, lc = tid & 7;
  const unsigned so = swz128(lr, lc);
  f16x8 ra[4], rb[4], sa[4], sb[4];
#define GLOAD(RA, RB, kt) do { const char* a_ = baseA + koffA(kt) * 2; const char* b_ = baseB + koffB(kt) * 2; \
    RA[0] = *(const f16x8*)(a_ + (size_t)voffA); RA[1] = *(const f16x8*)(a_ + strideA + (size_t)voffA); RA[2] = *(const f16x8*)(a_ + 2 * strideA + (size_t)voffA); RA[3] = *(const f16x8*)(a_ + 3 * strideA + (size_t)voffA); \
    RB[0] = *(const f16x8*)(b_ + (size_t)voffB); RB[1] = *(const f16x8*)(b_ + strideB + (size_t)voffB); RB[2] = *(const f16x8*)(b_ + 2 * strideB + (size_t)voffB); RB[3] = *(const f16x8*)(b_ + 3 * strideB + (size_t)voffB); } while (0)
#define LSTORE(RA, RB, st) do { char* b_ = smem + (st) * 65536 + so; \
    *(f16x8*)(b_) = RA[0]; *(f16x8*)(b_ + 8192) = RA[1]; *(f16x8*)(b_ + 16384) = RA[2]; *(f16x8*)(b_ + 24576) = RA[3]; \
    *(f16x8*)(b_ + 32768) = RB[0]; *(f16x8*)(b_ + 32768 + 8192) = RB[1]; *(f16x8*)(b_ + 32768 + 16384) = RB[2]; *(f16x8*)(b_ + 32768 + 24576) = RB[3]; } while (0)
  const int l31 = lane & 31, h = lane >> 5, xx = (l31 >> 1) & 7;
  const unsigned fbase = l31 * 128;
  unsigned cx[4];
#pragma unroll
  for (int s = 0; s < 4; ++s) cx[s] = (unsigned)(((2 * s + h) ^ xx) << 4);
#define COMPUTE(kt) do { \
      const char* A = smem + ((kt) & 1) * 65536 + (128 * wm) * 128 + fbase; \
      const char* Bm = smem + ((kt) & 1) * 65536 + 32768 + (64 * wn) * 128 + fbase; \
      _Pragma("unroll") for (int s = 0; s < 4; ++s) { \
        f16x8 hf[4], wf[2]; \
        _Pragma("unroll") for (int i = 0; i < 4; ++i) hf[i] = *(const f16x8*)(A + i * 4096 + cx[s]); \
        _Pragma("unroll") for (int j = 0; j < 2; ++j) wf[j] = *(const f16x8*)(Bm + j * 4096 + cx[s]); \
        _Pragma("unroll") for (int i = 0; i < 4; ++i) _Pragma("unroll") for (int j = 0; j < 2; ++j) acc[i][j] = MFMA(wf[j], hf[i], acc[i][j]); \
      } } while (0)
  GLOAD(ra, rb, 0); GLOAD(sa, sb, 1);
  LSTORE(ra, rb, 0); __syncthreads();
  for (int kt = 0; kt < nk; kt += 2) {
    if (kt + 2 < nk) GLOAD(ra, rb, kt + 2);
    COMPUTE(kt);
    LSTORE(sa, sb, 1);
    __syncthreads();
    if (kt + 3 < nk) GLOAD(sa, sb, kt + 3);
    COMPUTE(kt + 1);
    if (kt + 2 < nk) LSTORE(ra, rb, 0);
    __syncthreads();
  }
#undef GLOAD
#undef LSTORE
#undef COMPUTE
}

template <class XF>
DI void store_tile_f16(const f32x16 (&acc)[4][2], f16* dst, long ld, char* smem, bool active, XF xf) {
  int tid_ = threadIdx.x; asm volatile("" : "+v"(tid_)); const int tid = tid_, lane = tid & 63, wid = tid >> 6, wm = wid >> 2, wn = wid & 3, l31 = lane & 31, h = lane >> 5;
  char* img = smem + wid * (128 * 144);
#pragma unroll
  for (int i = 0; i < 4; ++i)
#pragma unroll
    for (int j = 0; j < 2; ++j)
#pragma unroll
      for (int g = 0; g < 4; ++g) {
        f16x4 v; v[0] = (f16)acc[i][j][4 * g]; v[1] = (f16)acc[i][j][4 * g + 1]; v[2] = (f16)acc[i][j][4 * g + 2]; v[3] = (f16)acc[i][j][4 * g + 3];
        *(f16x4*)(img + (32 * i + l31) * 144 + (32 * j + 8 * g + 4 * h) * 2) = v;
      }
  __syncthreads();
  if (active) {
    f16* d = dst + (long)(128 * wm) * ld + 64 * wn;
#pragma unroll 2
    for (int it = 0; it < 16; ++it) {
      const int row = it * 8 + (lane >> 3), ch = lane & 7;
      const char* rowp = img + row * 144;
      f16x8 v = *(const f16x8*)(rowp + ch * 16);
      v = xf(v, rowp, 128 * wm + row, wn, ch);
      *(f16x8*)(d + (long)row * ld + ch * 8) = v;
    }
  }
  __syncthreads();
}
struct XfNone { DI f16x8 operator()(f16x8 v, const char*, int, int, int) const { return v; } };
struct XfGelu { DI f16x8 operator()(f16x8 v, const char*, int, int, int) const { f16x8 r;
#pragma unroll
  for (int e = 0; e < 8; ++e) r[e] = (f16)gelu_tanh((float)v[e]);
  return r; } };
struct XfZ {
  int seg; const float* rot;
  DI f16x8 operator()(f16x8 v, const char* rowp, int trow, int wn, int ch) const {
    f16x8 r = v;
    if (seg == 6) {
#pragma unroll
      for (int e = 0; e < 8; ++e) r[e] = (f16)siluf_((float)v[e]);
    } else if (seg == 0 || seg == 1) {
      float sc = (seg == 0) ? QSCALE : 1.f;
      if (((wn & 1) == 0) && ch < 4) {
        const f16x8 pv = *(const f16x8*)(rowp + (ch ^ 2) * 16);
        const float* rp = rot + (size_t)trow * 96 + 16 * (ch & 1);
        const bool first = ch < 2;
#pragma unroll
        for (int e2 = 0; e2 < 4; ++e2) {
          const f32x4 cs = *(const f32x4*)(rp + 4 * e2);
#pragma unroll
          for (int q = 0; q < 2; ++q) {
            const int e = 2 * e2 + q; const float c = cs[2 * q], sn = cs[2 * q + 1];
            const float x1 = first ? (float)v[e] : (float)pv[e], x2 = first ? (float)pv[e] : (float)v[e];
            r[e] = (f16)((first ? (x1 * c - x2 * sn) : (x1 * sn + x2 * c)) * sc);
          }
        }
      } else {
#pragma unroll
        for (int e = 0; e < 8; ++e) r[e] = (f16)((float)v[e] * sc);
      }
    } else if (seg == 3 || seg == 4) {
      const float sc = (seg == 4) ? 0.125f : 1.f;
      const f16x8 pv = *(const f16x8*)(rowp + (ch ^ 4) * 16);
      const float* rp = rot + (size_t)trow * 96 + 32 + 16 * (ch & 3);
      const bool first = ch < 4;
#pragma unroll
      for (int e2 = 0; e2 < 4; ++e2) {
        const f32x4 cs = *(const f32x4*)(rp + 4 * e2);
#pragma unroll
        for (int q = 0; q < 2; ++q) {
          const int e = 2 * e2 + q; const float c = cs[2 * q], sn = cs[2 * q + 1];
          const float x1 = first ? (float)v[e] : (float)pv[e], x2 = first ? (float)pv[e] : (float)v[e];
          r[e] = (f16)((first ? (x1 * c - x2 * sn) : (x1 * sn + x2 * c)) * sc);
        }
      }
    } else if (seg == 5) {
#pragma unroll
      for (int e = 0; e < 8; ++e) r[e] = (f16)((float)v[e] * QSCALE);
    }
    return r;
  }
};

struct KStd { DI long operator()(int kt) const { return (long)kt * 64; } };
struct KCmp { DI long operator()(int kt) const { return (long)(kt >> 1) * ZW + (kt & 1) * 64; } };

DI void zero_acc(f32x16 (&acc)[4][2]) {
#pragma unroll
  for (int i = 0; i < 4; ++i)
#pragma unroll
    for (int j = 0; j < 2; ++j)
#pragma unroll
      for (int r = 0; r < 16; ++r) acc[i][j][r] = 0.f;
}


constexpr int HTB = 128 * 64 * 2;
DI int lds_byte(int r, int c) { const int st = (r >> 4) * 2 + (c >> 5), rr = r & 15, cc = c & 31, ob = rr * 64 + cc * 2; return st * 1024 + (ob ^ (((ob >> 9) & 1) << 5)); }
DI void stage_rc(int b, int& R, int& C) { const int st = b / 1024, sb = b % 1024, swz = sb ^ (((sb >> 9) & 1) << 5); R = (st >> 1) * 16 + swz / 64; C = (st & 1) * 32 + (swz % 64) / 2; }
DI int perm32(int rho) { const int n = rho >> 4, i = rho & 15; return 8 * (i >> 2) + 4 * n + (i & 3); }
DI int brow_of(int bmode, int h, int R) {
  return bmode == 0 ? 128 * h + R : (bmode == 1 ? 128 * h + (R & ~31) + perm32(R & 31) : 64 * (R >> 5) + 32 * h + perm32(R & 31));
}
struct GUnit { const char* A; const char* B; int bmode, seg, pm, pn; };

template <class Sched, class Epi>
DI void gemm_stream(LAS unsigned char* lds, int K, long lda, long ldb, const Sched& S, const Epi& E) {
  int tid_ = threadIdx.x; asm volatile("" : "+v"(tid_));
  const int tid = tid_ & 511, wid = __builtin_amdgcn_readfirstlane(tid >> 6), lane = tid & 63, wr = wid >> 2, wc = wid & 3, fr = lane & 15, fq = lane >> 4;
  const int nt = K / 64;
  unsigned voffA[2], voffB0[2], voffB1[2];
#pragma unroll
  for (int i = 0; i < 2; ++i) { int R_, C_; stage_rc(tid * 16 + i * 8192, R_, C_); voffA[i] = (unsigned)(R_ * lda + C_ * 2); }
  const size_t kstep = 128, hstepA = (size_t)128 * lda;
  const unsigned ldsw = (unsigned)wid * 1024u;
  const int aoff = lds_byte(wr * 64 + fr, fq * 8), boff = lds_byte(wc * 32 + fr, fq * 8);
#define GS_SA(b, h) (((b) * 2 + (h)) * HTB)
#define GS_SB(b, h) ((4 + (b) * 2 + (h)) * HTB)
#define GS_STAGE(bufoff, gbase, voff) do { _Pragma("unroll") for (int _i = 0; _i < 2; ++_i) \
    __builtin_amdgcn_global_load_lds((const unsigned*)((const char*)(gbase) + (voff)[_i]), (LAS unsigned*)(lds + (bufoff) + ldsw + _i * 8192), 16, 0, 0); } while (0)
#define GS_LDA(dst, b, h) do { _Pragma("unroll") for (int m = 0; m < 4; ++m) _Pragma("unroll") for (int k = 0; k < 2; ++k) dst[m][k] = *(const LAS f16x8*)(lds + GS_SA(b, h) + aoff + m * 2048 + k * 1024); } while (0)
#define GS_LDB(dst, b, h) do { _Pragma("unroll") for (int n = 0; n < 2; ++n) _Pragma("unroll") for (int k = 0; k < 2; ++k) dst[n][k] = *(const LAS f16x8*)(lds + GS_SB(b, h) + boff + n * 2048 + k * 1024); } while (0)
#define GS_MMA(ai, bj, At, Bt) do { __builtin_amdgcn_s_setprio(1); _Pragma("unroll") for (int m = 0; m < 4; ++m) _Pragma("unroll") for (int n = 0; n < 2; ++n) _Pragma("unroll") for (int k = 0; k < 2; ++k) \
    acc[ai][bj][m][n] = MFMA16(Bt[n][k], At[m][k], acc[ai][bj][m][n]); __builtin_amdgcn_s_setprio(0); } while (0)
#define GS_WAIT_V(n) asm volatile("s_waitcnt vmcnt(" #n ")" ::: "memory")
#define GS_WAIT_L(n) asm volatile("s_waitcnt lgkmcnt(" #n ")" ::: "memory")
#define GS_BAR __builtin_amdgcn_s_barrier()
#define GS_SCHED __builtin_amdgcn_sched_barrier(0)
#define GS_SETB(mode) do { int tq_ = threadIdx.x; asm volatile("" : "+v"(tq_)); _Pragma("unroll") for (int _i = 0; _i < 2; ++_i) { int R_, C_; stage_rc(tq_ * 16 + _i * 8192, R_, C_); \
    voffB0[_i] = (unsigned)(brow_of(mode, 0, R_) * ldb + C_ * 2); voffB1[_i] = (unsigned)(brow_of(mode, 1, R_) * ldb + C_ * 2); } } while (0)
  GUnit cur, nxt; int ui = 0;
  if (!S.next(0, cur)) return;
  f32x4 acc[2][2][4][2];
#pragma unroll
  for (int a = 0; a < 2; ++a)
#pragma unroll
    for (int b = 0; b < 2; ++b)
#pragma unroll
      for (int m = 0; m < 4; ++m)
#pragma unroll
        for (int n = 0; n < 2; ++n) acc[a][b][m][n] = (f32x4){0.f, 0.f, 0.f, 0.f};
  f16x8 At[4][2], B0[2][2], B1[2][2];
  const char* cA = cur.A; const char* cB = cur.B;
  GS_SETB(cur.bmode);
  GS_STAGE(GS_SB(0, 0), cB, voffB0); GS_STAGE(GS_SA(0, 0), cA, voffA); GS_STAGE(GS_SB(0, 1), cB, voffB1); GS_STAGE(GS_SA(0, 1), cA + hstepA, voffA);
  if (wr == 1) GS_BAR;
  GS_WAIT_V(4); GS_BAR;
  GS_STAGE(GS_SB(1, 0), cB + kstep, voffB0); GS_STAGE(GS_SA(1, 0), cA + kstep, voffA); GS_STAGE(GS_SB(1, 1), cB + kstep, voffB1);
  GS_WAIT_V(6); GS_BAR;
  for (;;) {
    const bool has_next = S.next(ui + 1, nxt);
    const char* nA = has_next ? nxt.A : cA; const char* nB = has_next ? nxt.B : cB;
    for (int t = 0; t < nt; t += 2) {
      const bool last = (t == nt - 2);
      const char* a1 = cA + (size_t)(t + 1) * kstep;
      const char* a2 = last ? nA : cA + (size_t)(t + 2) * kstep; const char* b2 = last ? nB : cB + (size_t)(t + 2) * kstep;
      const char* a3 = a2 + kstep; const char* b3 = b2 + kstep;
      if (last && has_next) GS_SETB(nxt.bmode);
      GS_LDB(B0, 0, 0); GS_SCHED; GS_LDA(At, 0, 0); GS_STAGE(GS_SA(1, 1), a1 + hstepA, voffA);
      GS_WAIT_L(8); GS_BAR; GS_WAIT_L(0); GS_MMA(0, 0, At, B0); GS_BAR; GS_SCHED;
      GS_LDB(B1, 0, 1); GS_STAGE(GS_SB(0, 0), b2, voffB0);
      GS_BAR; GS_WAIT_L(0); GS_MMA(0, 1, At, B1); GS_BAR;
      GS_LDA(At, 0, 1); GS_STAGE(GS_SA(0, 0), a2, voffA);
      GS_BAR; GS_WAIT_L(0); GS_MMA(1, 0, At, B0); GS_BAR; GS_SCHED;
      GS_STAGE(GS_SB(0, 1), b2, voffB1);
      GS_WAIT_V(6); GS_BAR; GS_MMA(1, 1, At, B1); GS_BAR;
      GS_LDB(B0, 1, 0); GS_SCHED; GS_LDA(At, 1, 0); GS_STAGE(GS_SA(0, 1), a2 + hstepA, voffA);
      GS_WAIT_L(8); GS_BAR; GS_WAIT_L(0); GS_MMA(0, 0, At, B0); GS_BAR; GS_SCHED;
      GS_LDB(B1, 1, 1); GS_STAGE(GS_SB(1, 0), b3, voffB0);
      GS_BAR; GS_WAIT_L(0); GS_MMA(0, 1, At, B1); GS_BAR;
      GS_LDA(At, 1, 1); GS_STAGE(GS_SA(1, 0), a3, voffA);
      GS_BAR; GS_WAIT_L(0); GS_MMA(1, 0, At, B0); GS_BAR; GS_SCHED;
      GS_STAGE(GS_SB(1, 1), b3, voffB1);
      GS_WAIT_V(6); GS_BAR; GS_MMA(1, 1, At, B1); GS_BAR;
    }
    E(acc, cur, wr, wc, fr, fq);
    if (!has_next) break;
#pragma unroll
    for (int a = 0; a < 2; ++a)
#pragma unroll
      for (int b = 0; b < 2; ++b)
#pragma unroll
        for (int m = 0; m < 4; ++m)
#pragma unroll
          for (int n = 0; n < 2; ++n) acc[a][b][m][n] = (f32x4){0.f, 0.f, 0.f, 0.f};
    cur = nxt; cA = nA; cB = nB; ++ui;
  }
  GS_WAIT_V(0);
  if (wr == 0) GS_BAR;
  GS_BAR;
#undef GS_SA
#undef GS_SB
#undef GS_STAGE
#undef GS_LDA
#undef GS_LDB
#undef GS_MMA
#undef GS_WAIT_V
#undef GS_WAIT_L
#undef GS_BAR
#undef GS_SCHED
#undef GS_SETB
}

struct Sched1 {
  const char* H; const char* W; const char* MEMN; const char* WMEM; int b, G;
  DI bool next(int i, GUnit& u) const {
    int kind, mt, nt;
    if (G == 256) {
      if (i < 12) { const int xcd = b & 7, l = b >> 3; const int st = i * 8 + xcd; const int mg = st / 3, ng = st % 3; kind = 0; mt = mg * 4 + (l & 3); nt = ng * 8 + (l >> 2); }
      else return false;
    } else {
      const int L = i * G + b;
      if (L < 3072) { kind = 0; mt = L / 24; nt = L % 24; }
      else return false;
    }
    u.pm = mt; u.pn = nt;
    if (kind == 1) { u.A = MEMN + (size_t)mt * 256 * 2048; u.B = WMEM + (size_t)nt * 256 * 2048; u.seg = 8; u.bmode = 1; return true; }
    int seg = 2;
    if (nt == 4 || nt == 6 || nt == 8) seg = 1;     else if (nt == 10) seg = 3; else if (nt == 11) seg = 4;
    else if (nt == 14 || nt == 15) seg = 5; else if (nt >= 16 && nt < 24) seg = 6; else if (nt == 24) seg = 7;
    u.seg = seg; u.bmode = (seg == 3 || seg == 4) ? 2 : 1;
    u.A = H + (size_t)mt * 256 * 2048; u.B = W + (size_t)(nt < 24 ? nt * 256 : 6144) * 2048;
    return true;
  }
};
DI unsigned pk2(float a, float b) { typedef _Float16 h2 __attribute__((ext_vector_type(2))); h2 v; v[0] = (f16)a; v[1] = (f16)b; return __builtin_bit_cast(unsigned, v); }
struct Epi1 {
  f16* Z; f16* KVM; float* GATES; const float* ROT;
  DI void operator()(const f32x4 (&acc)[2][2][4][2], const GUnit& u, int wr, int wc, int fr, int fq) const {
    typedef unsigned u32x4_ __attribute__((ext_vector_type(4)));
    typedef unsigned u32x2_ __attribute__((ext_vector_type(2)));
    const int seg = u.seg;
    const int row0 = u.pm * 256 + wr * 64 + fr;
    if (seg == 7) {
      if (wc == 0 && fq < 3) {
#pragma unroll
        for (int ai = 0; ai < 2; ++ai)
#pragma unroll
          for (int m = 0; m < 4; ++m) {
            float* gp = GATES + (size_t)(row0 + ai * 128 + m * 16) * 24 + 8 * fq;
            f32x4 v0 = acc[ai][0][m][0], v1 = acc[ai][0][m][1];
#pragma unroll
            for (int j = 0; j < 4; ++j) { v0[j] = sigmoidf_(v0[j]); v1[j] = sigmoidf_(v1[j]); }
            *(f32x4*)gp = v0; *(f32x4*)(gp + 4) = v1;
          }
      }
      return;
    }
    if (seg == 1) {
      typedef unsigned u32x2s_ __attribute__((ext_vector_type(2)));
      if (wc == 0) {
        const int hh = fq >> 1;
#pragma unroll
        for (int ai = 0; ai < 2; ++ai) {
          f32x4 rt[4][4];
#pragma unroll
          for (int m = 0; m < 4; ++m) { const float* rp = ROT + (size_t)(row0 + ai * 128 + m * 16) * 96 + 16 * (fq & 1);
#pragma unroll
            for (int i = 0; i < 4; ++i) rt[m][i] = *(const f32x4*)(rp + 4 * i); }
#pragma unroll
          for (int m = 0; m < 4; ++m) {
            f16* zp = Z + (size_t)(row0 + ai * 128 + m * 16) * ZW + u.pn * 256 + 8 * fq;
#pragma unroll
            for (int bj = 0; bj < 2; ++bj) {
              float ov[8];
#pragma unroll
              for (int i = 0; i < 8; ++i) {
                const float x = (i < 4) ? acc[ai][bj][m][0][i & 3] : acc[ai][bj][m][1][i & 3];
                auto rr = __builtin_amdgcn_permlane32_swap(__float_as_uint(x), __float_as_uint(x), false, false);
                const float part = hh ? __uint_as_float(rr[0]) : __uint_as_float(rr[1]);
                const float cs = rt[m][i >> 1][2 * (i & 1)], sn = rt[m][i >> 1][2 * (i & 1) + 1];
                ov[i] = x * cs + part * (hh ? sn : -sn);
              }
              u32x4_ w; w.x = pk2(ov[0], ov[1]); w.y = pk2(ov[2], ov[3]); w.z = pk2(ov[4], ov[5]); w.w = pk2(ov[6], ov[7]);
              *(u32x4_*)(zp + bj * 128) = w;
            }
          }
        }
      } else {
#pragma unroll
        for (int ai = 0; ai < 2; ++ai)
#pragma unroll
          for (int m = 0; m < 4; ++m) {
            f16* zp = Z + (size_t)(row0 + ai * 128 + m * 16) * ZW + u.pn * 256 + 32 * wc + 8 * fq;
#pragma unroll
            for (int bj = 0; bj < 2; ++bj) {
              const f32x4 v0 = acc[ai][bj][m][0], v1 = acc[ai][bj][m][1];
              u32x4_ w; w.x = pk2(v0[0], v0[1]); w.y = pk2(v0[2], v0[3]); w.z = pk2(v1[0], v1[1]); w.w = pk2(v1[2], v1[3]);
              *(u32x4_*)(zp + bj * 128) = w;
            }
          }
      }
      return;
    }
    if (seg == 0) {
      const float sc = (seg == 0) ? QSCALE : 1.f;
      if (wc == 0) {
#pragma unroll
        for (int ai = 0; ai < 2; ++ai) {
          f32x4 ca[4], cb[4];
#pragma unroll
          for (int m = 0; m < 4; ++m) { const float* rp = ROT + (size_t)(row0 + ai * 128 + m * 16) * 96 + 8 * fq; ca[m] = *(const f32x4*)rp; cb[m] = *(const f32x4*)(rp + 4); }
#pragma unroll
          for (int m = 0; m < 4; ++m) {
            f16* zp = Z + (size_t)(row0 + ai * 128 + m * 16) * ZW + u.pn * 256 + 4 * fq;
            const float cs[4] = {ca[m][0], ca[m][2], cb[m][0], cb[m][2]}, sn[4] = {ca[m][1], ca[m][3], cb[m][1], cb[m][3]};
#pragma unroll
            for (int bj = 0; bj < 2; ++bj) {
              const f32x4 x1 = acc[ai][bj][m][0], x2 = acc[ai][bj][m][1];
              f32x4 o1, o2;
#pragma unroll
              for (int j = 0; j < 4; ++j) { o1[j] = (x1[j] * cs[j] - x2[j] * sn[j]) * sc; o2[j] = (x1[j] * sn[j] + x2[j] * cs[j]) * sc; }
              u32x2_ w1, w2; w1.x = pk2(o1[0], o1[1]); w1.y = pk2(o1[2], o1[3]); w2.x = pk2(o2[0], o2[1]); w2.y = pk2(o2[2], o2[3]);
              *(u32x2_*)(zp + bj * 128) = w1; *(u32x2_*)(zp + bj * 128 + 16) = w2;
            }
          }
        }
      } else {
#pragma unroll
        for (int ai = 0; ai < 2; ++ai)
#pragma unroll
          for (int m = 0; m < 4; ++m) {
            f16* zp = Z + (size_t)(row0 + ai * 128 + m * 16) * ZW + u.pn * 256 + 32 * wc + 4 * fq;
#pragma unroll
            for (int bj = 0; bj < 2; ++bj) {
              const f32x4 x1 = acc[ai][bj][m][0] * sc, x2 = acc[ai][bj][m][1] * sc;
              u32x2_ w1, w2; w1.x = pk2(x1[0], x1[1]); w1.y = pk2(x1[2], x1[3]); w2.x = pk2(x2[0], x2[1]); w2.y = pk2(x2[2], x2[3]);
              *(u32x2_*)(zp + bj * 128) = w1; *(u32x2_*)(zp + bj * 128 + 16) = w2;
            }
          }
      }
      return;
    }
    if (seg == 3 || seg == 4) {
      const float sc = (seg == 4) ? 0.125f : 1.f;
#pragma unroll
      for (int ai = 0; ai < 2; ++ai) {
        f32x4 tt[4][4];
#pragma unroll
        for (int m = 0; m < 4; ++m) {
          const float* rp = ROT + (size_t)(row0 + ai * 128 + m * 16) * 96 + 32 + 16 * fq;
          tt[m][0] = *(const f32x4*)rp; tt[m][1] = *(const f32x4*)(rp + 4); tt[m][2] = *(const f32x4*)(rp + 8); tt[m][3] = *(const f32x4*)(rp + 12);
        }
#pragma unroll
        for (int m = 0; m < 4; ++m) {
          f16* zp = Z + (size_t)(row0 + ai * 128 + m * 16) * ZW + u.pn * 256 + 64 * wc + 8 * fq;
          const f32x4 t0 = tt[m][0], t1 = tt[m][1], t2 = tt[m][2], t3 = tt[m][3];
          const float cs[8] = {t0[0], t0[2], t1[0], t1[2], t2[0], t2[2], t3[0], t3[2]}, sn[8] = {t0[1], t0[3], t1[1], t1[3], t2[1], t2[3], t3[1], t3[3]};
          float lo[8], hi[8];
#pragma unroll
          for (int n = 0; n < 2; ++n)
#pragma unroll
            for (int j = 0; j < 4; ++j) { const int e = 4 * n + j; const float x1 = acc[ai][0][m][n][j], x2 = acc[ai][1][m][n][j]; lo[e] = (x1 * cs[e] - x2 * sn[e]) * sc; hi[e] = (x1 * sn[e] + x2 * cs[e]) * sc; }
          u32x4_ wl, wh; wl.x = pk2(lo[0], lo[1]); wl.y = pk2(lo[2], lo[3]); wl.z = pk2(lo[4], lo[5]); wl.w = pk2(lo[6], lo[7]);
          wh.x = pk2(hi[0], hi[1]); wh.y = pk2(hi[2], hi[3]); wh.z = pk2(hi[4], hi[5]); wh.w = pk2(hi[6], hi[7]);
          *(u32x4_*)zp = wl; *(u32x4_*)(zp + 32) = wh;
        }
      }
      return;
    }
    f16* base = (seg == 8) ? KVM : Z; const long ld = (seg == 8) ? 1024 : ZW;
#pragma unroll
    for (int ai = 0; ai < 2; ++ai)
#pragma unroll
      for (int m = 0; m < 4; ++m) {
        f16* zp = base + (size_t)(row0 + ai * 128 + m * 16) * ld + u.pn * 256 + 32 * wc + 8 * fq;
#pragma unroll
        for (int bj = 0; bj < 2; ++bj) {
          f32x4 v0 = acc[ai][bj][m][0], v1 = acc[ai][bj][m][1];
          if (seg == 5) { v0 *= QSCALE; v1 *= QSCALE; }
          u32x4_ w; w.x = pk2(v0[0], v0[1]); w.y = pk2(v0[2], v0[3]); w.z = pk2(v1[0], v1[1]); w.w = pk2(v1[2], v1[3]);
          *(u32x4_*)(zp + bj * 128) = w;
        }
      }
  }
};
DI void phase_gemm1(const Params& p, char* smem) {
  Sched1 S; S.H = (const char*)p.out; S.W = p.ws + WS_WINT; S.MEMN = p.ws + WS_MEMN; S.WMEM = p.ws + WS_WMEMT; S.b = blockIdx.x; S.G = gridDim.x;
  Epi1 E; E.Z = (f16*)(p.ws + WS_Z); E.KVM = (f16*)(p.ws + WS_KVM); E.GATES = (float*)(p.ws + WS_GATES); E.ROT = (const float*)(p.ws + WS_ROT);
  gemm_stream((LAS unsigned char*)smem, 1024, 2048, 2048, S, E);
}

struct SchedOne {
  const char* A; const char* B; int pm, pn;
  DI bool next(int i, GUnit& u) const { if (i != 0) return false; u.A = A; u.B = B; u.pm = pm; u.pn = pn; u.seg = 8; u.bmode = 1; return true; }
};
DI void memkv_unit(const Params& p, int mt, int nt, char* smem) {
  SchedOne S; S.A = p.ws + WS_MEMN + (size_t)mt * 256 * 2048; S.B = p.ws + WS_WMEMT + (size_t)nt * 256 * 2048; S.pm = mt; S.pn = nt;
  Epi1 E; E.Z = (f16*)(p.ws + WS_Z); E.KVM = (f16*)(p.ws + WS_KVM); E.GATES = (float*)(p.ws + WS_GATES); E.ROT = (const float*)(p.ws + WS_ROT);
  gemm_stream((LAS unsigned char*)smem, 1024, 2048, 2048, S, E);
}

struct Sched2 {
  const char* A; const char* W; int b, G;
  DI bool next(int i, GUnit& u) const {
    int mt, nt;
    if (G == 256) { if (i >= 2) return false; const int xcd = b & 7, l = b >> 3; const int st = i * 8 + xcd; mt = st * 8 + (l & 7); nt = l >> 3; }
    else { const int L = i * G + b; if (L >= 512) return false; mt = L >> 2; nt = L & 3; }
    u.pm = mt; u.pn = nt; u.seg = 0; u.bmode = 1;
    u.A = A + (size_t)mt * 256 * ZW * 2; u.B = W + (size_t)nt * 256 * 4096;
    return true;
  }
};
struct Epi2 {
  f16* Y; float* PSS;
  DI void operator()(const f32x4 (&acc)[2][2][4][2], const GUnit& u, int wr, int wc, int fr, int fq) const {
    typedef unsigned u32x4_ __attribute__((ext_vector_type(4)));
    const int row0 = u.pm * 256 + wr * 64 + fr, col0 = u.pn * 256 + wc * 32 + 8 * fq;
#pragma unroll
    for (int ai = 0; ai < 2; ++ai)
#pragma unroll
      for (int m = 0; m < 4; ++m) {
        const int r = row0 + ai * 128 + m * 16;
        f16* yp = Y + (size_t)r * 1024 + col0; float ss = 0.f;
#pragma unroll
        for (int bj = 0; bj < 2; ++bj) {
          const f32x4 v0 = acc[ai][bj][m][0], v1 = acc[ai][bj][m][1];
          ss += (v0[0] * v0[0] + v0[1] * v0[1]) + (v0[2] * v0[2] + v0[3] * v0[3]) + (v1[0] * v1[0] + v1[1] * v1[1]) + (v1[2] * v1[2] + v1[3] * v1[3]);
          u32x4_ w; w.x = pk2(v0[0], v0[1]); w.y = pk2(v0[2], v0[3]); w.z = pk2(v1[0], v1[1]); w.w = pk2(v1[2], v1[3]);
          *(u32x4_*)(yp + bj * 128) = w;
        }
        ss += __shfl_xor(ss, 16); ss += __shfl_xor(ss, 32);
        if (fq == 0) PSS[(size_t)r * 16 + u.pn * 4 + wc] = ss;
      }
  }
};
DI void phase_gemm2(const Params& p, char* smem) {
  Sched2 S; S.A = p.ws + WS_Z + (size_t)ZC_GATE * 2; S.W = p.ws + WS_WOUTT; S.b = blockIdx.x; S.G = gridDim.x;
  Epi2 E; E.Y = (f16*)(p.ws + WS_Y); E.PSS = (float*)(p.ws + WS_PSS);
  gemm_stream((LAS unsigned char*)smem, 2048, (long)ZW * 2, 4096, S, E);
}

struct KCmpS { int k0; DI long operator()(int kt) const { const int k = kt + k0; return (long)(k >> 1) * ZW + (k & 1) * 64; } };
struct KStdS { int k0; DI long operator()(int kt) const { return (long)(kt + k0) * 64; } };
DI void unit_drain() { asm volatile("s_waitcnt vmcnt(0)" ::: "memory"); __syncthreads(); }
DI void publish_arrive(unsigned* ctr) {
  __builtin_amdgcn_fence(__ATOMIC_RELEASE, "agent");
  asm volatile("s_waitcnt vmcnt(0)" ::: "memory");
  __hip_atomic_fetch_add(ctr, 1u, __ATOMIC_RELAXED, __HIP_MEMORY_SCOPE_AGENT);
}
DI void wait_count(unsigned* ctr, unsigned target) {
  if (threadIdx.x == 0) {
    unsigned sp = 0;
    while (__hip_atomic_load(ctr, __ATOMIC_RELAXED, __HIP_MEMORY_SCOPE_AGENT) < target) { __builtin_amdgcn_s_sleep(2); if (++sp > (1u << 24)) break; }
    __builtin_amdgcn_fence(__ATOMIC_ACQUIRE, "agent");
    asm volatile("s_waitcnt vmcnt(0)" ::: "memory");
  }
  __syncthreads();
}
DI void csplit_unit(const Params& p, int kv, int b, int ks, char* smem) {
  int tid_ = threadIdx.x; asm volatile("" : "+v"(tid_)); const int tid = tid_, lane = tid & 63, wid = tid >> 6;
  const int lr = tid >> 3, lc = tid & 7;
  const char* Z = (const char*)(p.ws + WS_Z);
  const char* W1 = (const char*)(p.ws + WS_W1T) + (size_t)kv * 256 * 4096 * 2;
  const unsigned voffA = (unsigned)((lr & 31) * 16 * ZW * 2 + (lr >> 5) * 256 + lc * 16);
  const unsigned voffB = (unsigned)(lr * 8192 + lc * 16);
  f32x16 acc[4][2]; zero_acc(acc);
  KCmpS ka; ka.k0 = ks * 8; KStdS kb; kb.k0 = ks * 8;
  gemm_core(acc, Z + ((size_t)(b * NT) * ZW + ZC_KV + kv * 256) * 2, (long)32 * 16 * ZW * 2, voffA, W1, 64 * 8192, voffB, ka, kb, 8, smem);
  float* slab = p.out + (size_t)(((kv * 16 + b) * 8 + ks)) * 65536;
#pragma unroll
  for (int i = 0; i < 4; ++i)
#pragma unroll
    for (int j = 0; j < 2; ++j)
#pragma unroll
      for (int g = 0; g < 4; ++g) {
        f32x4 v; v[0] = acc[i][j][4 * g]; v[1] = acc[i][j][4 * g + 1]; v[2] = acc[i][j][4 * g + 2]; v[3] = acc[i][j][4 * g + 3];
        *(f32x4*)(slab + (size_t)((((wid * 4 + i) * 2 + j) * 4 + g) * 64 + lane) * 4) = v;
      }
  unit_drain();
}
DI void cfin_unit(const Params& p, int kv, int b, char* smem) {
  int tid_ = threadIdx.x; asm volatile("" : "+v"(tid_)); const int tid = tid_, lane = tid & 63, wid = tid >> 6, wn = wid & 3, l31 = lane & 31, h = lane >> 5;
  const int lr = tid >> 3, lc = tid & 7;
  f16* HID = (f16*)(p.ws + WS_HID) + (size_t)kv * 4096 * 256;
  wait_count((unsigned*)(p.ws + WS_CTR) + 16 + kv * 16 + b, 8u);
  {
    float* bias = (float*)(smem + 131072);
    if (tid < 256) { const float* PB1 = (const float*)(p.ws + WS_PB1) + kv * 16 * 256; float sacc = 0.f; for (int c = 0; c < 16; ++c) sacc += PB1[c * 256 + tid]; bias[tid] = sacc; }
    __syncthreads();
    f32x16 acc[4][2];
#pragma unroll
    for (int j = 0; j < 2; ++j)
#pragma unroll
      for (int r = 0; r < 16; ++r) { const float bv = bias[64 * wn + 32 * j + crow(r, h)]; acc[0][j][r] = bv; acc[1][j][r] = bv; acc[2][j][r] = bv; acc[3][j][r] = bv; }
    const float* slab0 = p.out + (size_t)((kv * 16 + b) * 8) * 65536;
#pragma unroll 1
    for (int ks = 0; ks < 8; ks += 2) {
      const float* slab = slab0 + (size_t)ks * 65536;
#pragma unroll
      for (int i = 0; i < 4; ++i) {
#pragma unroll
        for (int qh = 0; qh < 2; ++qh) {
          f32x4 tv[4], tw[4];
#pragma unroll
          for (int q = 0; q < 4; ++q) {
            const size_t o_ = (size_t)(((wid * 4 + i) * 8 + 4 * qh + q) * 64 + lane) * 4;
            tv[q] = *(const f32x4*)(slab + o_); tw[q] = *(const f32x4*)(slab + 65536 + o_);
          }
#pragma unroll
          for (int g = 0; g < 4; ++g) {
            acc[i][qh][4 * g] += tv[g][0] + tw[g][0]; acc[i][qh][4 * g + 1] += tv[g][1] + tw[g][1]; acc[i][qh][4 * g + 2] += tv[g][2] + tw[g][2]; acc[i][qh][4 * g + 3] += tv[g][3] + tw[g][3];
          }
        }
      }
    }
    __syncthreads();
    {
      const int wm = wid >> 2;
      char* img = smem + wid * (128 * 144);
#pragma unroll
      for (int i = 0; i < 4; ++i)
#pragma unroll
        for (int j = 0; j < 2; ++j)
#pragma unroll
          for (int g = 0; g < 4; ++g) {
            f16x4 v; v[0] = (f16)acc[i][j][4 * g]; v[1] = (f16)acc[i][j][4 * g + 1]; v[2] = (f16)acc[i][j][4 * g + 2]; v[3] = (f16)acc[i][j][4 * g + 3];
            *(f16x4*)(img + (32 * i + l31) * 144 + (32 * j + 8 * g + 4 * h) * 2) = v;
          }
      __syncthreads();
#pragma unroll 2
      for (int it = 0; it < 16; ++it) {
        const int row = it * 8 + (lane >> 3), ch = lane & 7;
        const int slot = 128 * wm + row; const int lrr = slot & 63, ii = slot >> 6;
        const int n = (lrr & 31) + 32 * ii, g = lrr >> 5;
        f16x8 v = *(const f16x8*)(img + row * 144 + ch * 16);
        v = XfGelu()(v, nullptr, 0, 0, 0);
        *(f16x8*)(HID + (size_t)(b * 256 + g * 128 + n) * 256 + 64 * wn + ch * 8) = v;
      }
      __syncthreads();
    }
  }
  __threadfence_block();
  __syncthreads();
  {
    const char* W2 = (const char*)(p.ws + WS_W2T) + (size_t)kv * 128 * 256 * 2;
    const unsigned voff = (unsigned)(lr * 512 + lc * 16);
    f32x16 acc[4][2]; zero_acc(acc);
    gemm_core(acc, (const char*)HID + (size_t)(b * 256) * 512, 64 * 512, voff, W2, 64 * 512, voff, KStd(), KStd(), 4, smem);
    if (l31 == 31) {
#pragma unroll
      for (int j = 0; j < 2; ++j)
#pragma unroll
        for (int r = 0; r < 16; ++r) acc[3][j][r] = 0.f;
    }
    f16* KC = (f16*)(p.ws + WS_KC) + (size_t)kv * 4096 * 128;
    store_tile_f16(acc, KC + (size_t)(b * 256) * 128, 128, smem, wn < 2, XfNone());
  }
  unit_drain();
}

struct KV128 { f16x8 k[2], v[2]; };
DI void kv_gload(KV128& r, const char* K, const char* V, unsigned voff, long ldb) {
  r.k[0] = *(const f16x8*)(K + (size_t)voff); r.k[1] = *(const f16x8*)(K + 32 * ldb + (size_t)voff);
  r.v[0] = *(const f16x8*)(V + (size_t)voff); r.v[1] = *(const f16x8*)(V + 32 * ldb + (size_t)voff);
}
DI void kv_lstore(const KV128& r, char* stage, unsigned so) {
  *(f16x8*)(stage + so) = r.k[0]; *(f16x8*)(stage + so + 8192) = r.k[1];
  *(f16x8*)(stage + 16384 + so) = r.v[0]; *(f16x8*)(stage + 16384 + so + 8192) = r.v[1];
}
DI void qk128(f32x16& p0, f32x16& p1, const char* Kst, const f16x8 (&qf)[8], unsigned kbe, unsigned kbo) {
  const f32x16 zero = {0.f, 0.f, 0.f, 0.f, 0.f, 0.f, 0.f, 0.f, 0.f, 0.f, 0.f, 0.f, 0.f, 0.f, 0.f, 0.f};
  f16x8 ka[4], kb[4];
#define QK_LD(dst, s0) do { dst[0] = *(const f16x8*)(Kst + kbe + 512 * ((s0) >> 1)); dst[1] = *(const f16x8*)(Kst + kbe + 512 * ((s0) >> 1) + 8192); \
    dst[2] = *(const f16x8*)(Kst + kbo + 512 * ((s0) >> 1)); dst[3] = *(const f16x8*)(Kst + kbo + 512 * ((s0) >> 1) + 8192); } while (0)
  QK_LD(ka, 0);
  QK_LD(kb, 2);
  p0 = MFMA(ka[0], qf[0], zero); p1 = MFMA(ka[1], qf[0], zero); p0 = MFMA(ka[2], qf[1], p0); p1 = MFMA(ka[3], qf[1], p1);
  QK_LD(ka, 4);
  p0 = MFMA(kb[0], qf[2], p0); p1 = MFMA(kb[1], qf[2], p1); p0 = MFMA(kb[2], qf[3], p0); p1 = MFMA(kb[3], qf[3], p1);
  QK_LD(kb, 6);
  p0 = MFMA(ka[0], qf[4], p0); p1 = MFMA(ka[1], qf[4], p1); p0 = MFMA(ka[2], qf[5], p0); p1 = MFMA(ka[3], qf[5], p1);
  p0 = MFMA(kb[0], qf[6], p0); p1 = MFMA(kb[1], qf[6], p1); p0 = MFMA(kb[2], qf[7], p0); p1 = MFMA(kb[3], qf[7], p1);
#undef QK_LD
  __builtin_amdgcn_sched_group_barrier(0x100, 8, 0);
  __builtin_amdgcn_sched_group_barrier(0x008, 4, 0);
  __builtin_amdgcn_sched_group_barrier(0x100, 4, 0);
  __builtin_amdgcn_sched_group_barrier(0x008, 4, 0);
  __builtin_amdgcn_sched_group_barrier(0x100, 4, 0);
  __builtin_amdgcn_sched_group_barrier(0x008, 8, 0);
}
DI f16x8 pack8(const f32x16& x, int s) {
  f16x8 r;
#pragma unroll
  for (int j = 0; j < 8; ++j) r[j] = (f16)x[8 * s + j];
  return r;
}
struct VFrag { f16x4 l0, h0, l1, h1, l2, h2, l3, h3; };
template <int DT> DI void pv_rd(VFrag& f, unsigned vb0, unsigned vb1) {
  f.l0 = tr_read<512 * DT>(vb0); f.h0 = tr_read<512 * DT + 2048>(vb1);
  f.l1 = tr_read<512 * DT + 4096>(vb0); f.h1 = tr_read<512 * DT + 4096 + 2048>(vb1);
  f.l2 = tr_read<512 * DT + 8192>(vb0); f.h2 = tr_read<512 * DT + 8192 + 2048>(vb1);
  f.l3 = tr_read<512 * DT + 12288>(vb0); f.h3 = tr_read<512 * DT + 12288 + 2048>(vb1);
}
DI void pv_mm(f32x16& od, const VFrag& f, const f16x8 (&pb)[4]) {
#define PK(L, H) (f16x8){L[0], L[1], L[2], L[3], H[0], H[1], H[2], H[3]}
  od = MFMA(PK(f.l0, f.h0), pb[0], od);
  od = MFMA(PK(f.l1, f.h1), pb[1], od);
  od = MFMA(PK(f.l2, f.h2), pb[2], od);
  od = MFMA(PK(f.l3, f.h3), pb[3], od);
#undef PK
}
DI void pv_tile(f32x16 (&o)[4], unsigned vb0, unsigned vb1, const f32x16& p0, const f32x16& p1) {
  f16x8 pb[4]; pb[0] = pack8(p0, 0); pb[1] = pack8(p0, 1); pb[2] = pack8(p1, 0); pb[3] = pack8(p1, 1);
  VFrag fa, fb;
  pv_rd<0>(fa, vb0, vb1);
  pv_rd<1>(fb, vb0, vb1);
  asm volatile("s_waitcnt lgkmcnt(8)" ::: "memory"); SBAR();
  pv_mm(o[0], fa, pb);
  pv_rd<2>(fa, vb0, vb1);
  asm volatile("s_waitcnt lgkmcnt(8)" ::: "memory"); SBAR();
  pv_mm(o[1], fb, pb);
  pv_rd<3>(fb, vb0, vb1);
  asm volatile("s_waitcnt lgkmcnt(8)" ::: "memory"); SBAR();
  pv_mm(o[2], fa, pb);
  asm volatile("s_waitcnt lgkmcnt(0)" ::: "memory"); SBAR();
  pv_mm(o[3], fb, pb);
}
DI void qk_exp(f32x16& n0, f32x16& n1, const char* Kst, const f16x8 (&qf)[8], unsigned kbe, unsigned kbo, f32x16& c0, f32x16& c1, float me, float& ps) {
  const f32x16 zero = {0.f, 0.f, 0.f, 0.f, 0.f, 0.f, 0.f, 0.f, 0.f, 0.f, 0.f, 0.f, 0.f, 0.f, 0.f, 0.f};
  f16x8 ka[4], kb[4];
#define QK_LD(dst, s0) do { dst[0] = *(const f16x8*)(Kst + kbe + 512 * ((s0) >> 1)); dst[1] = *(const f16x8*)(Kst + kbe + 512 * ((s0) >> 1) + 8192); \
    dst[2] = *(const f16x8*)(Kst + kbo + 512 * ((s0) >> 1)); dst[3] = *(const f16x8*)(Kst + kbo + 512 * ((s0) >> 1) + 8192); } while (0)
#define EXP8(c, b0) do { _Pragma("unroll") for (int j_ = 0; j_ < 8; ++j_) { c[(b0) + j_] = fexp2(c[(b0) + j_] - me); s_ += c[(b0) + j_]; } } while (0)
  float s_ = 0.f;
  QK_LD(ka, 0);
  n0 = MFMA(ka[0], qf[0], zero); n1 = MFMA(ka[1], qf[0], zero); n0 = MFMA(ka[2], qf[1], n0); n1 = MFMA(ka[3], qf[1], n1);
  QK_LD(kb, 2);
  EXP8(c0, 0);
  n0 = MFMA(kb[0], qf[2], n0); n1 = MFMA(kb[1], qf[2], n1); n0 = MFMA(kb[2], qf[3], n0); n1 = MFMA(kb[3], qf[3], n1);
  QK_LD(ka, 4);
  EXP8(c0, 8);
  n0 = MFMA(ka[0], qf[4], n0); n1 = MFMA(ka[1], qf[4], n1); n0 = MFMA(ka[2], qf[5], n0); n1 = MFMA(ka[3], qf[5], n1);
  QK_LD(kb, 6);
  EXP8(c1, 0);
  n0 = MFMA(kb[0], qf[6], n0); n1 = MFMA(kb[1], qf[6], n1); n0 = MFMA(kb[2], qf[7], n0); n1 = MFMA(kb[3], qf[7], n1);
  EXP8(c1, 8);
  ps = s_;
#undef QK_LD
}
DI void exp_only(f32x16& c0, f32x16& c1, float me, float& ps) {
  float s_ = 0.f;
  EXP8(c0, 0); EXP8(c0, 8); EXP8(c1, 0); EXP8(c1, 8);
  ps = s_;
#undef EXP8
}
DI void pv_max(f32x16 (&o)[4], unsigned vb0, unsigned vb1, const f32x16& p0, const f32x16& p1, const f32x16& n0, const f32x16& n1, float& pm) {
  f16x8 pb[4]; pb[0] = pack8(p0, 0); pb[1] = pack8(p0, 1); pb[2] = pack8(p1, 0); pb[3] = pack8(p1, 1);
  VFrag fa;
  float mx = n0[0];
  pv_rd<0>(fa, vb0, vb1);
  asm volatile("s_waitcnt lgkmcnt(0)" ::: "memory"); SBAR();
  pv_mm(o[0], fa, pb);
  pv_rd<1>(fa, vb0, vb1);
#pragma unroll
  for (int r = 1; r < 8; ++r) mx = fmaxf(mx, n0[r]);
  asm volatile("s_waitcnt lgkmcnt(0)" ::: "memory"); SBAR();
  pv_mm(o[1], fa, pb);
  pv_rd<2>(fa, vb0, vb1);
#pragma unroll
  for (int r = 8; r < 16; ++r) mx = fmaxf(mx, n0[r]);
  asm volatile("s_waitcnt lgkmcnt(0)" ::: "memory"); SBAR();
  pv_mm(o[2], fa, pb);
  pv_rd<3>(fa, vb0, vb1);
#pragma unroll
  for (int r = 0; r < 8; ++r) mx = fmaxf(mx, n1[r]);
  asm volatile("s_waitcnt lgkmcnt(0)" ::: "memory"); SBAR();
  pv_mm(o[3], fa, pb);
#pragma unroll
  for (int r = 8; r < 16; ++r) mx = fmaxf(mx, n1[r]);
  pm = mx;
}
DI float rowmax32(const f32x16& c0, const f32x16& c1) {
  float pm = c0[0];
#pragma unroll
  for (int r = 1; r < 16; ++r) pm = fmaxf(pm, c0[r]);
#pragma unroll
  for (int r = 0; r < 16; ++r) pm = fmaxf(pm, c1[r]);
  return xhalf_max(pm);
}
DI void osm_decide(float pmn, float& m, float& l, f32x16 (&o)[4]) {
  if (!__all(pmn - m <= THR)) {
    float mn = fmaxf(m, pmn); float alpha = fexp2(m - mn); m = mn; l *= alpha;
#pragma unroll
    for (int d = 0; d < 4; ++d)
#pragma unroll
      for (int r = 0; r < 16; ++r) o[d][r] *= alpha;
  }
}
DI void osm_step(f32x16& p0, f32x16& p1, float& m, float& l, f32x16 (&o)[4], bool sel = true) {
  float pm = p0[0];
#pragma unroll
  for (int r = 1; r < 16; ++r) pm = fmaxf(pm, p0[r]);
#pragma unroll
  for (int r = 0; r < 16; ++r) pm = fmaxf(pm, p1[r]);
  pm = xhalf_max(pm);
  pm = sel ? pm : NEG;
  if (!__all(pm - m <= THR)) {
    float mn = fmaxf(m, pm); float alpha = fexp2(m - mn); m = mn; l *= alpha;
#pragma unroll
    for (int d = 0; d < 4; ++d)
#pragma unroll
      for (int r = 0; r < 16; ++r) o[d][r] *= alpha;
  }
  const float me = sel ? m : 1e30f;
  float ps = 0.f;
#pragma unroll
  for (int r = 0; r < 16; ++r) { p0[r] = fexp2(p0[r] - me); ps += p0[r]; }
#pragma unroll
  for (int r = 0; r < 16; ++r) { p1[r] = fexp2(p1[r] - me); ps += p1[r]; }
  l += ps;
}
DI void zero_o(f32x16 (&o)[4]) {
#pragma unroll
  for (int d = 0; d < 4; ++d)
#pragma unroll
    for (int r = 0; r < 16; ++r) o[d][r] = 0.f;
}


DI void glds16(const char* g, LAS unsigned char* l) { __builtin_amdgcn_global_load_lds((const unsigned*)g, (LAS unsigned*)l, 16, 0, 0); }
DI unsigned dma_voff128(int wid, int lane, long ldb) {
  const int r3 = wid >> 1, c2 = ((wid & 1) << 1) | (lane >> 5), r7 = (lane >> 2) & 7, x = lane & 3;
  const int row = 8 * r3 + r7, rr = ((r7 >> 2) | ((r3 & 1) << 1)) & 3, ch = 4 * c2 + (x ^ rr);
  return (unsigned)(row * ldb + ch * 16);
}
DI unsigned dma_voff64(int wid, int lane, long ldb) {
  const int row = 8 * wid + (lane >> 3), c = (lane & 7) ^ ((row >> 1) & 7);
  return (unsigned)(row * ldb + c * 16);
}
DI void dma_kv128(LAS unsigned char* stage, unsigned ldsw, const char* K, const char* V, unsigned voff, long ldb) {
  glds16(K + (size_t)voff, stage + ldsw); glds16(K + 32 * ldb + (size_t)voff, stage + ldsw + 8192);
  glds16(V + (size_t)voff, stage + 16384 + ldsw); glds16(V + 32 * ldb + (size_t)voff, stage + 16384 + ldsw + 8192);
}
#define VWAIT(n) asm volatile("s_waitcnt vmcnt(" #n ")" ::: "memory")
DI void ring_wait4(int rem) {
  if (rem >= 3) VWAIT(12); else if (rem == 2) VWAIT(8); else if (rem == 1) VWAIT(4); else VWAIT(0);
}
DI void ring_wait3(int rem) {
  if (rem >= 3) VWAIT(9); else if (rem == 2) VWAIT(6); else if (rem == 1) VWAIT(3); else VWAIT(0);
}
DI void ring_bar() { asm volatile("s_waitcnt lgkmcnt(0)" ::: "memory"); __builtin_amdgcn_s_barrier(); asm volatile("" ::: "memory"); }

DI void nsa_unit(const Params& p, int b, int g, int qt, char* smem) {
  const int wid = __builtin_amdgcn_readfirstlane(threadIdx.x >> 6);
  int tid_ = threadIdx.x; asm volatile("" : "+v"(tid_)); const int tid = tid_, lane = tid & 63, l31 = lane & 31, h = lane >> 5;
  const int tl = 8 * wid + (l31 >> 2), rr = l31 & 3, head = 4 * g + rr;
  const int t = 64 * qt + tl;
  const unsigned row = (unsigned)(b * NT + t);
  char* Zc = p.ws + WS_Z;
  LAS unsigned char* lds = (LAS unsigned char*)smem;
  const unsigned ldsw = (unsigned)wid * 1024u;
  const char* KC = p.ws + WS_KC + (size_t)((b * 2 + g) * 128) * 256;
  const char* VC = KC + (size_t)4096 * 256;
  const unsigned cvo = dma_voff128(wid, lane, 256), zvo = dma_voff128(wid, lane, ZW * 2);
  const char* Zb = Zc + (size_t)b * NT * ZW * 2;
  const int cKs = ZC_KV + 512 + g * 128, cVs = ZC_KV + 768 + g * 128, cKw = ZC_KV + 1024 + g * 128, cVw = ZC_KV + 1280 + g * 128;
  const int nwin = (qt >= 8) ? 9 : (qt + 1);
  const int NTILE = 3 + qt + nwin;
#define NSA_ISSUE(n_) do { const int n__ = (n_); LAS unsigned char* st__ = lds + (n__ & 3) * 32768; \
    if (n__ < 2) dma_kv128(st__, ldsw, KC + n__ * 64 * 256, VC + n__ * 64 * 256, cvo, 256); \
    else if (n__ < 3 + qt) { const size_t ko__ = (size_t)(64 * (qt - (n__ - 2))) * ZW * 2; dma_kv128(st__, ldsw, Zb + ko__ + cKs * 2, Zb + ko__ + cVs * 2, zvo, ZW * 2); } \
    else { const size_t ko__ = (size_t)(64 * (qt - (n__ - 3 - qt))) * ZW * 2; dma_kv128(st__, ldsw, Zb + ko__ + cKw * 2, Zb + ko__ + cVw * 2, zvo, ZW * 2); } } while (0)
  f16x8 qf[8];
  {
    const char* qrow = Zc + (size_t)((row * ZW + ZC_QN + head * 128 + 8 * h) * 2u);
#pragma unroll
    for (int s = 0; s < 8; ++s) qf[s] = *(const f16x8*)(qrow + 32 * s);
  }
  f32x4 rt[4];
  { const float* rp = (const float*)(p.ws + WS_ROT) + (size_t)row * 96 + 16 * h;
#pragma unroll
    for (int i = 0; i < 4; ++i) rt[i] = *(const f32x4*)(rp + 4 * i); }
  float g0, g1, g2;
  { const float* gp = (const float*)(p.ws + WS_GATES) + (size_t)(row * 24u + head); g0 = gp[0]; g1 = gp[8]; g2 = gp[16]; }
  NSA_ISSUE(2);
  wait_count((unsigned*)(p.ws + WS_CTR) + 64 + b, 2u);
  NSA_ISSUE(0); NSA_ISSUE(1);
  int issued = 3;
  const unsigned kbe = 2048 * (l31 >> 3) + 64 * (l31 & 7) + 16 * ((h) ^ ((l31 >> 2) & 3));
  const unsigned kbo = 2048 * (l31 >> 3) + 64 * (l31 & 7) + 16 * ((2 + h) ^ ((l31 >> 2) & 3));
  const int q4 = (lane & 15) >> 2, p4 = lane & 3, blk = (lane >> 4) & 1;
  const unsigned sbase = (unsigned)(uintptr_t)smem;
  const unsigned vr0 = sbase + 16384 + 64 * (4 * h + q4) + 16 * ((2 * blk + (p4 >> 1)) ^ (h)) + 8 * (p4 & 1);
  const unsigned vr1 = sbase + 16384 + 64 * (4 * h + q4) + 16 * ((2 * blk + (p4 >> 1)) ^ (2 + h)) + 8 * (p4 & 1);
  char* otg = (char*)p.out + (size_t)(64u << 20) + (size_t)(((b * 2 + g) * 32 + qt)) * 65536 + tid * 16;
  f32x16 o[4];
  unsigned selmask;
  {
    ring_wait4(0); ring_bar();
    {
#pragma unroll
      for (int e = 0; e < 8; ++e) {
        const float cs = rt[e >> 1][2 * (e & 1)], sn = rt[e >> 1][2 * (e & 1) + 1];
        const float x1 = (float)qf[0][e], x2 = (float)qf[1][e];
        qf[0][e] = (f16)((x1 * cs - x2 * sn) * QSCALE); qf[1][e] = (f16)((x1 * sn + x2 * cs) * QSCALE);
      }
#pragma unroll
      for (int s = 2; s < 8; ++s)
#pragma unroll
        for (int e = 0; e < 8; ++e) qf[s][e] = (f16)((float)qf[s][e] * QSCALE);
    }
    f32x16 c0, c1, c2, c3;
    qk128(c0, c1, smem, qf, kbe, kbo);
    qk128(c2, c3, smem + 32768, qf, kbe, kbo);
    const int nmax = (t - 31) >> 4;
    float mx = NEG;
#pragma unroll
    for (int r = 0; r < 16; ++r) {
      const int n = crow(r, h);
      c0[r] = (n <= nmax) ? c0[r] : NEG; c1[r] = (n + 32 <= nmax) ? c1[r] : NEG; c2[r] = (n + 64 <= nmax) ? c2[r] : NEG; c3[r] = (n + 96 <= nmax) ? c3[r] : NEG;
      mx = fmaxf(mx, fmaxf(fmaxf(c0[r], c1[r]), fmaxf(c2[r], c3[r])));
    }
    mx = xhalf_max(mx);
    float ls = 0.f;
#pragma unroll
    for (int r = 0; r < 16; ++r) {
      c0[r] = (c0[r] > -1e29f) ? fexp2(c0[r] - mx) : 0.f; c1[r] = (c1[r] > -1e29f) ? fexp2(c1[r] - mx) : 0.f;
      c2[r] = (c2[r] > -1e29f) ? fexp2(c2[r] - mx) : 0.f; c3[r] = (c3[r] > -1e29f) ? fexp2(c3[r] - mx) : 0.f;
      ls += (c0[r] + c1[r]) + (c2[r] + c3[r]);
    }
    ls = xhalf_sum(ls);
    const float inv = (ls > 0.f) ? 1.f / ls : 0.f;
#pragma unroll
    for (int r = 0; r < 16; ++r) { c0[r] *= inv; c1[r] *= inv; c2[r] *= inv; c3[r] *= inv; }
    if (qt <= 15) {
      selmask = (1u << (qt + 1)) - 1u;
    } else {
      float av[16], cv[16];
#pragma unroll
      for (int k = 0; k < 4; ++k)
#pragma unroll
        for (int gg = 0; gg < 4; ++gg) {
          const f32x16& c = (k == 0) ? c0 : (k == 1) ? c1 : (k == 2) ? c2 : c3;
          float half3 = 0.5f * c[4 * gg + 3];
          av[4 * k + gg] = c[4 * gg] + c[4 * gg + 1] + c[4 * gg + 2] + half3; cv[4 * k + gg] = half3;
        }
      float imp[16];
#pragma unroll
      for (int i = 0; i < 16; ++i) {
        auto x2 = __builtin_amdgcn_permlane32_swap(__float_as_uint(cv[i]), __float_as_uint(cv[i]), false, false);
        float oc = h ? __uint_as_float(x2[0]) : __uint_as_float(x2[1]);
        cv[i] = oc;
      }
#pragma unroll
      for (int i = 0; i < 16; ++i) {
        float carry = h ? cv[i] : (i > 0 ? cv[i - 1] : 0.f);
        float v = av[i] + carry;
        v += __shfl_xor(v, 1); v += __shfl_xor(v, 2);
        imp[i] = v;
      }
      float* impL = (float*)(smem + 131072) + wid * 256;
      if (rr == 0) {
#pragma unroll
        for (int i = 0; i < 16; ++i) impL[(l31 >> 2) * 32 + 2 * i + h] = imp[i];
      }
      asm volatile("s_waitcnt lgkmcnt(0)" ::: "memory");
      __builtin_amdgcn_wave_barrier();
      const int sub = rr + 4 * h;
      const float* vrow = impL + (l31 >> 2) * 32;
      f32x4 mine = *(const f32x4*)(vrow + 4 * sub);
      int cnt[4] = {0, 0, 0, 0};
#pragma unroll 4
      for (int j2 = 1; j2 <= qt - 2; ++j2) {
        float w = vrow[j2];
#pragma unroll
        for (int e = 0; e < 4; ++e) { int j = 4 * sub + e; cnt[e] += (w > mine[e] || (w == mine[e] && j2 < j)) ? 1 : 0; }
      }
      unsigned nib = 0;
#pragma unroll
      for (int e = 0; e < 4; ++e) { int j = 4 * sub + e; if (j >= 1 && j <= qt - 2 && cnt[e] < 13) nib |= 1u << j; }
      nib |= (unsigned)__shfl_xor((int)nib, 1); nib |= (unsigned)__shfl_xor((int)nib, 2); nib |= (unsigned)__shfl_xor((int)nib, 32);
      selmask = nib | 1u | (1u << qt) | (1u << (qt - 1));
    }
    zero_o(o);
    pv_tile(o, vr0, vr1, c0, c1);
    pv_tile(o, vr0 + 32768, vr1 + 32768, c2, c3);
#pragma unroll
    for (int d = 0; d < 4; ++d)
#pragma unroll
      for (int g2_ = 0; g2_ < 2; ++g2_) {
        f16x8 v;
#pragma unroll
        for (int e = 0; e < 8; ++e) v[e] = (f16)(g0 * o[d][8 * g2_ + e]);
        *(f16x8*)(otg + (2 * d + g2_) * 8192) = v;
      }
  }
  f16x8 rv[8];
#define NSA_STEP(n_) do { ring_wait4(issued - 1 - (n_)); ring_bar(); while (issued <= (n_) + 2 && issued < NTILE) { NSA_ISSUE(issued); ++issued; } } while (0)
  float m, l = 0.f;
  zero_o(o);
  {
    const int na = 2, nb = 2 + qt;
    f32x16 c0, c1;
    NSA_STEP(na);
    qk128(c0, c1, smem + (na & 3) * 32768, qf, kbe, kbo);
    {
      int tlx = tl - 4 * h; asm volatile("" : "+v"(tlx));
#pragma unroll
      for (int r = 0; r < 16; ++r) { const int key = crow(r, 0); c0[r] = (key <= tlx) ? c0[r] : NEG; c1[r] = (key + 32 <= tlx) ? c1[r] : NEG; }
    }
    m = rowmax32(c0, c1);
    bool selc = true;
    f32x16 x0, x1;
#define SLC_STEP(C0, C1, X0, X1) do { \
      NSA_STEP(n + 1); \
      const float me = selc ? m : 1e30f; float ps, pmn; \
      qk_exp(X0, X1, smem + ((n + 1) & 3) * 32768, qf, kbe, kbo, C0, C1, me, ps); \
      l += ps; \
      pv_max(o, vr0 + (n & 3) * 32768, vr1 + (n & 3) * 32768, C0, C1, X0, X1, pmn); \
      const bool seln = (selmask >> (qt - (n + 1 - 2))) & 1u; \
      pmn = xhalf_max(pmn); pmn = seln ? pmn : NEG; \
      osm_decide(pmn, m, l, o); \
      selc = seln; } while (0)
    int n = na;
    for (; n + 1 < nb; n += 2) { SLC_STEP(c0, c1, x0, x1); ++n; SLC_STEP(x0, x1, c0, c1); --n; }
    if (n < nb) { SLC_STEP(c0, c1, x0, x1); c0 = x0; c1 = x1; }
#undef SLC_STEP
#pragma unroll
    for (int k = 0; k < 8; ++k) rv[k] = *(const f16x8*)(otg + k * 8192);
    { const float me = selc ? m : 1e30f; float ps; exp_only(c0, c1, me, ps); l += ps; pv_tile(o, vr0 + (nb & 3) * 32768, vr1 + (nb & 3) * 32768, c0, c1); }
  }
  {
    float lt = xhalf_sum(l); float sc = g1 / lt;
#pragma unroll
    for (int d = 0; d < 4; ++d)
#pragma unroll
      for (int g2_ = 0; g2_ < 2; ++g2_) {
        f16x8 v = rv[2 * d + g2_];
#pragma unroll
        for (int e = 0; e < 8; ++e) v[e] = (f16)((float)v[e] + sc * o[d][8 * g2_ + e]);
        *(f16x8*)(otg + (2 * d + g2_) * 8192) = v;
      }
  }
  f16* mp = (f16*)(Zc + (size_t)((row * ZW + ZC_GATE + head * 128 + 4 * h) * 2u));
  f16x8 pvs[8]; f16x4 gts[16];
  l = 0.f; zero_o(o);
  {
    const int na = 3 + qt, nb = NTILE - 1;
    f32x16 c0, c1;
    NSA_STEP(na);
    qk128(c0, c1, smem + (na & 3) * 32768, qf, kbe, kbo);
    {
      int tlx = tl - 4 * h; asm volatile("" : "+v"(tlx));
#pragma unroll
      for (int r = 0; r < 16; ++r) { const int key = crow(r, 0); c0[r] = (key <= tlx) ? c0[r] : NEG; c1[r] = (key + 32 <= tlx) ? c1[r] : NEG; }
    }
    m = rowmax32(c0, c1);
    f32x16 x0, x1;
#define WIN_STEP(C0, C1, X0, X1) do { \
      NSA_STEP(n + 1); \
      float ps, pmn; \
      qk_exp(X0, X1, smem + ((n + 1) & 3) * 32768, qf, kbe, kbo, C0, C1, m, ps); \
      l += ps; \
      pv_max(o, vr0 + (n & 3) * 32768, vr1 + (n & 3) * 32768, C0, C1, X0, X1, pmn); \
      pmn = xhalf_max(pmn); \
      osm_decide(pmn, m, l, o); } while (0)
    int n = na;
    for (; n + 1 < nb; n += 2) { WIN_STEP(c0, c1, x0, x1); ++n; WIN_STEP(x0, x1, c0, c1); --n; }
    if (n < nb) { WIN_STEP(c0, c1, x0, x1); c0 = x0; c1 = x1; }
#undef WIN_STEP
    if (nwin == 9) {
      int tlx = tl - 4 * h; asm volatile("" : "+v"(tlx));
#pragma unroll
      for (int r = 0; r < 16; ++r) { const int key = crow(r, 0); c0[r] = (key > tlx) ? c0[r] : NEG; c1[r] = (key + 32 > tlx) ? c1[r] : NEG; }
    }
#pragma unroll
    for (int i = 0; i < 8; ++i) pvs[i] = *(const f16x8*)(otg + i * 8192);
#pragma unroll
    for (int i = 0; i < 16; ++i) gts[i] = *(const f16x4*)(mp + 32 * (i >> 2) + 8 * (i & 3));
    { float ps; exp_only(c0, c1, m, ps); l += ps; pv_tile(o, vr0 + (nb & 3) * 32768, vr1 + (nb & 3) * 32768, c0, c1); }
  }
#undef NSA_STEP
#undef NSA_ISSUE
  const float scw = g2 / xhalf_sum(l);
#pragma unroll
  for (int d = 0; d < 4; ++d)
#pragma unroll
    for (int g2_ = 0; g2_ < 2; ++g2_) {
      const f16x8 pv = pvs[2 * d + g2_];
#pragma unroll
      for (int q = 0; q < 2; ++q) {
        const int gg = 2 * g2_ + q;
        const f16x4 gt = gts[4 * d + gg]; f16x4 v;
#pragma unroll
        for (int e = 0; e < 4; ++e) v[e] = (f16)(((float)pv[4 * q + e] + scw * o[d][4 * gg + e]) * siluf_((float)gt[e]));
        *(f16x4*)(mp + 32 * d + 8 * gg) = v;
      }
    }
  ring_bar();
}

DI void mem_unit(const Params& p, int b, int hm, int half, char* smem) {
  const int wid = __builtin_amdgcn_readfirstlane(threadIdx.x >> 6);
  int tid_ = threadIdx.x; asm volatile("" : "+v"(tid_)); const int tid = tid_, lane = tid & 63, l31 = lane & 31, h = lane >> 5;
  f16* Z = (f16*)(p.ws + WS_Z);
  LAS unsigned char* lds = (LAS unsigned char*)smem;
  const unsigned ldsw = (unsigned)wid * 1024u;
  const char* Kb = p.ws + WS_KVM + ((size_t)(b * 256) * 1024 + hm * 128) * 2;
  const char* Vb = Kb + 1024;
  const unsigned kvo = dma_voff128(wid, lane, 2048);
  const size_t row0 = (size_t)b * NT + 1024 * half + 32 * wid + l31;
  wait_count((unsigned*)(p.ws + WS_CTR) + 80 + b, 4u);
  f16x8 qa[8], qb[8];
#define MEM_QLOAD(Q, i_) do { const f16* qrow = Z + (row0 + 256 * (i_)) * ZW + ZC_QM + hm * 128 + 8 * h; \
    _Pragma("unroll") for (int s = 0; s < 8; ++s) Q[s] = *(const f16x8*)(qrow + 16 * s); } while (0)
  MEM_QLOAD(qa, 0);
#pragma unroll
  for (int i = 0; i < 4; ++i) dma_kv128(lds + i * 32768, ldsw, Kb + (size_t)(64 * i) * 2048, Vb + (size_t)(64 * i) * 2048, kvo, 2048);
  const unsigned kbe = 2048 * (l31 >> 3) + 64 * (l31 & 7) + 16 * ((h) ^ ((l31 >> 2) & 3));
  const unsigned kbo = 2048 * (l31 >> 3) + 64 * (l31 & 7) + 16 * ((2 + h) ^ ((l31 >> 2) & 3));
  const int q4 = (lane & 15) >> 2, p4 = lane & 3, blk = (lane >> 4) & 1;
  const unsigned sbase = (unsigned)(uintptr_t)smem;
  const unsigned vr0 = sbase + 16384 + 64 * (4 * h + q4) + 16 * ((2 * blk + (p4 >> 1)) ^ (h)) + 8 * (p4 & 1);
  const unsigned vr1 = sbase + 16384 + 64 * (4 * h + q4) + 16 * ((2 * blk + (p4 >> 1)) ^ (2 + h)) + 8 * (p4 & 1);
  asm volatile("s_waitcnt vmcnt(0)" ::: "memory");
  ring_bar();
#define MEM_QTILE(Q, QN, i_) do { \
    f16* mp = Z + (row0 + 256 * (i_)) * ZW + ZC_GATE + 1536 + hm * 128 + 4 * h; \
    f16x4 gts[16]; \
    _Pragma("unroll") for (int i = 0; i < 16; ++i) gts[i] = *(const f16x4*)(mp + 32 * (i >> 2) + 8 * (i & 3)); \
    if ((i_) + 1 < 4) MEM_QLOAD(QN, (i_) + 1); \
    f32x16 o[4]; zero_o(o); \
    float m = NEG, l = 0.f; \
    _Pragma("unroll 1") for (int kt = 0; kt < 4; ++kt) { \
      f32x16 p0, p1; \
      qk128(p0, p1, smem + kt * 32768, Q, kbe, kbo); \
      osm_step(p0, p1, m, l, o); \
      pv_tile(o, vr0 + kt * 32768, vr1 + kt * 32768, p0, p1); \
    } \
    const float inv = 1.f / xhalf_sum(l); \
    _Pragma("unroll") for (int d = 0; d < 4; ++d) \
      _Pragma("unroll") for (int gg = 0; gg < 4; ++gg) { \
        const f16x4 gt = gts[4 * d + gg]; f16x4 v; \
        _Pragma("unroll") for (int e = 0; e < 4; ++e) v[e] = (f16)(o[d][4 * gg + e] * inv * siluf_((float)gt[e])); \
        *(f16x4*)(mp + 32 * d + 8 * gg) = v; \
      } } while (0)
#pragma unroll 1
  for (int i2 = 0; i2 < 4; i2 += 2) { MEM_QTILE(qa, qb, i2); MEM_QTILE(qb, qa, i2 + 1); }
#undef MEM_QTILE
#undef MEM_QLOAD
  ring_bar();
}

DI void ret_qk(f32x16& n0, f32x16& n1, const char* stg, const f16x8 (&qf)[4], int l31, int h, int xx) {
  const f32x16 zero = {0.f, 0.f, 0.f, 0.f, 0.f, 0.f, 0.f, 0.f, 0.f, 0.f, 0.f, 0.f, 0.f, 0.f, 0.f, 0.f};
#pragma unroll
  for (int s = 0; s < 4; ++s) {
    const unsigned cxs = (unsigned)(((2 * s + h) ^ xx) << 4);
    const f16x8 k0 = *(const f16x8*)(stg + l31 * 128 + cxs);
    const f16x8 k1 = *(const f16x8*)(stg + (l31 + 32) * 128 + cxs);
    n0 = MFMA(k0, qf[s], s == 0 ? zero : n0); n1 = MFMA(k1, qf[s], s == 0 ? zero : n1);
  }
}
DI void ret_qk_decay(f32x16& n0, f32x16& n1, const char* stg, const f16x8 (&qf)[4], int l31, int h, int xx, f32x16& c0, f32x16& c1, const float (&fac)[16], float base, float e32) {
  const f32x16 zero = {0.f, 0.f, 0.f, 0.f, 0.f, 0.f, 0.f, 0.f, 0.f, 0.f, 0.f, 0.f, 0.f, 0.f, 0.f, 0.f};
  const float base1 = base * e32;
#pragma unroll
  for (int s = 0; s < 4; ++s) {
    const unsigned cxs = (unsigned)(((2 * s + h) ^ xx) << 4);
    const f16x8 k0 = *(const f16x8*)(stg + l31 * 128 + cxs);
    const f16x8 k1 = *(const f16x8*)(stg + (l31 + 32) * 128 + cxs);
    n0 = MFMA(k0, qf[s], s == 0 ? zero : n0); n1 = MFMA(k1, qf[s], s == 0 ? zero : n1);
#pragma unroll
    for (int j = 0; j < 4; ++j) { const int r = 4 * s + j; c0[r] *= base * fac[r]; c1[r] *= base1 * fac[r]; }
  }
}
DI void ret_decay(f32x16& c0, f32x16& c1, const float (&fac)[16], float base, float e32) {
  const float base1 = base * e32;
#pragma unroll
  for (int r = 0; r < 16; ++r) { c0[r] *= base * fac[r]; c1[r] *= base1 * fac[r]; }
}
DI void ret_unit(const Params& p, int b, int hr, int tq, char* smem) {
  const int wid = __builtin_amdgcn_readfirstlane(threadIdx.x >> 6);
  int tid_ = threadIdx.x; asm volatile("" : "+v"(tid_)); const int tid = tid_, lane = tid & 63, l31 = lane & 31, h = lane >> 5;
  const int t = 256 * tq + 32 * wid + l31;
  const size_t row = (size_t)b * NT + t;
  f16* Z = (f16*)(p.ws + WS_Z);
  LAS unsigned char* lds = (LAS unsigned char*)smem;
  const unsigned ldsw = (unsigned)wid * 1024u;
  const char* Kb = p.ws + WS_Z + ((size_t)b * NT * ZW + ZC_KR + hr * 64) * 2;
  const char* Vb = p.ws + WS_Z + ((size_t)b * NT * ZW + ZC_VR + hr * 128) * 2;
  const unsigned kvo = dma_voff64(wid, lane, ZW * 2), vvo = dma_voff128(wid, lane, ZW * 2);
  const int ntile = 4 * (tq + 1);
#define RET_ISSUE(n_) do { const int n__ = (n_); LAS unsigned char* st__ = lds + (n__ & 3) * 32768; const size_t ko__ = (size_t)(64 * n__) * ZW * 2; \
    glds16(Kb + ko__ + (size_t)kvo, st__ + ldsw); glds16(Vb + ko__ + (size_t)vvo, st__ + 16384 + ldsw); glds16(Vb + ko__ + (size_t)32 * ZW * 2 + (size_t)vvo, st__ + 16384 + ldsw + 8192); } while (0)
#define RET_STEP(n_) do { ring_wait3(issued - 1 - (n_)); ring_bar(); while (issued <= (n_) + 2 && issued < ntile) { RET_ISSUE(issued); ++issued; } } while (0)
  RET_ISSUE(0); RET_ISSUE(1); RET_ISSUE(2);
  int issued = 3;
  f16x8 qf[4];
  {
    const f16* qrow = Z + row * ZW + ZC_QR + hr * 64 + 8 * h;
#pragma unroll
    for (int s = 0; s < 4; ++s) qf[s] = *(const f16x8*)(qrow + 16 * s);
  }
  const float lg = log2f(1.f - exp2f(-5.f - (float)hr));
  float fac[16];
#pragma unroll
  for (int r = 0; r < 16; ++r) fac[r] = fexp2(-lg * (float)crow(r, h));
  const float e32 = fexp2(-lg * 32.f);
  const int xx = (l31 >> 1) & 7;
  const int q4 = (lane & 15) >> 2, p4 = lane & 3, blk = (lane >> 4) & 1;
  const unsigned sbase = (unsigned)(uintptr_t)smem;
  const unsigned vr0 = sbase + 16384 + 64 * (4 * h + q4) + 16 * ((2 * blk + (p4 >> 1)) ^ (h)) + 8 * (p4 & 1);
  const unsigned vr1 = sbase + 16384 + 64 * (4 * h + q4) + 16 * ((2 * blk + (p4 >> 1)) ^ (2 + h)) + 8 * (p4 & 1);
  f32x16 o[4]; zero_o(o);
  const int mykt = 4 * tq + (wid >> 1);
  const int tlw = 32 * (wid & 1) + l31;
  f32x16 c0, c1, x0, x1;
  RET_STEP(0);
  ret_qk(c0, c1, smem, qf, l31, h, xx);
#define RET_BODY(C0, C1, X0, X1) do { \
    RET_STEP(kt + 1); \
    if (kt <= mykt) { \
      const float base = fexp2(lg * (float)(t - 64 * kt)); \
      if (kt < mykt) ret_qk_decay(X0, X1, smem + ((kt + 1) & 3) * 32768, qf, l31, h, xx, C0, C1, fac, base, e32); \
      else { \
        ret_decay(C0, C1, fac, base, e32); \
        int tlx = tlw - 4 * h; asm volatile("" : "+v"(tlx)); \
        _Pragma("unroll") for (int r = 0; r < 16; ++r) { const int key = crow(r, 0); C0[r] = (key <= tlx) ? C0[r] : 0.f; C1[r] = (key + 32 <= tlx) ? C1[r] : 0.f; } \
      } \
      pv_tile(o, vr0 + (kt & 3) * 32768, vr1 + (kt & 3) * 32768, C0, C1); \
    } } while (0)
  int kt = 0;
  for (; kt + 2 < ntile; kt += 2) { RET_BODY(c0, c1, x0, x1); ++kt; RET_BODY(x0, x1, c0, c1); --kt; }
  if (kt + 1 < ntile) { RET_BODY(c0, c1, x0, x1); c0 = x0; c1 = x1; ++kt; }
  if (kt <= mykt) {
    const float base = fexp2(lg * (float)(t - 64 * kt));
    ret_decay(c0, c1, fac, base, e32);
    int tlx = tlw - 4 * h; asm volatile("" : "+v"(tlx));
#pragma unroll
    for (int r = 0; r < 16; ++r) { const int key = crow(r, 0); c0[r] = (key <= tlx) ? c0[r] : 0.f; c1[r] = (key + 32 <= tlx) ? c1[r] : 0.f; }
    pv_tile(o, vr0 + (kt & 3) * 32768, vr1 + (kt & 3) * 32768, c0, c1);
  }
#undef RET_BODY
#undef RET_STEP
#undef RET_ISSUE
  f16* mp = Z + row * ZW + ZC_GATE + 1024 + hr * 128 + 4 * h;
  const float* gn = p.ret_gn + hr * 128 + 4 * h;
  f16x4 gts[16]; f32x4 gvs[16];
#pragma unroll
  for (int i = 0; i < 16; ++i) { gts[i] = *(const f16x4*)(mp + 32 * (i >> 2) + 8 * (i & 3)); gvs[i] = *(const f32x4*)(gn + 32 * (i >> 2) + 8 * (i & 3)); }
  float s1 = 0.f;
#pragma unroll
  for (int d = 0; d < 4; ++d)
#pragma unroll
    for (int r = 0; r < 16; ++r) s1 += o[d][r];
  s1 = xhalf_sum(s1);
  const float mu = s1 * (1.f / 128.f);
  float s2 = 0.f;
#pragma unroll
  for (int d = 0; d < 4; ++d)
#pragma unroll
    for (int r = 0; r < 16; ++r) { float c = o[d][r] - mu; s2 += c * c; }
  s2 = xhalf_sum(s2);
  const float rstd = rsqrtf(s2 * (1.f / 128.f) + 1e-6f);
#pragma unroll
  for (int d = 0; d < 4; ++d)
#pragma unroll
    for (int gg = 0; gg < 4; ++gg) {
      const f16x4 gt = gts[4 * d + gg]; const f32x4 gv = gvs[4 * d + gg]; f16x4 v;
#pragma unroll
      for (int e = 0; e < 4; ++e) v[e] = (f16)((o[d][4 * gg + e] - mu) * rstd * gv[e] * siluf_((float)gt[e]));
      *(f16x4*)(mp + 32 * d + 8 * gg) = v;
    }
  ring_bar();
}

constexpr int ATTN_UNITS = 288 + 64 + 512 + 128 + 1024;
DI unsigned* attn_dispatch(const Params& p, int u, char* smem) {
  int kind, a0, a1;
  if (u < 256) { kind = 3; a0 = u >> 5; a1 = u & 31; }
  else if (u < 288) { kind = 4; a0 = 0; a1 = u - 256; }
  else if (u < 352) { kind = 6; a0 = (u - 288) & 3; a1 = (u - 288) >> 2; }
  else {
    const int v = u - 352;
    if (v < 512) { kind = 1; a0 = 7 - (v >> 6); a1 = v & 63; }
    else if (v < 640) { const int w = v - 512; kind = 2; a0 = w >> 6; a1 = w & 63; }
    else { const int w = v - 640; kind = 0; a0 = 31 - (w >> 5); a1 = w & 31; }
  }
  unsigned* ctrs = (unsigned*)(p.ws + WS_CTR);
  unsigned* pend = nullptr;
  if (p.dry > 1) { const int kb = (kind == 0) ? 2 : (kind == 1) ? 4 : (kind == 2) ? 8 : 16; if (!(p.dry & kb)) return nullptr; }
  if (kind == 0) nsa_unit(p, a1 >> 1, a1 & 1, a0, smem);
  else if (kind == 1) ret_unit(p, a1 >> 2, a1 & 3, a0, smem);
  else if (kind == 2) mem_unit(p, a1 >> 2, a1 & 3, a0, smem);
  else if (kind == 6) { memkv_unit(p, a1, a0, smem); unit_drain(); pend = ctrs + 80 + a1; }
  else if (kind == 3) { csplit_unit(p, a1 >> 4, a1 & 15, a0, smem); pend = ctrs + 16 + a1; }
  else { cfin_unit(p, a1 >> 4, a1 & 15, smem); pend = ctrs + 64 + (a1 & 15); }
  return pend;
}

DI void phase_attn(const Params& p, char* smem, int ulo, int uhi, int cidx) {
  unsigned* ctr = (unsigned*)(p.ws + WS_CTR) + cidx;
  int* su = (int*)(smem + LDS_IMG + 16);
  unsigned* pend = nullptr;
  int nextu = 0;
  if (threadIdx.x == 0) nextu = ulo + (int)blockIdx.x;
  for (;;) {
    if (threadIdx.x == 0) {
      if (pend) publish_arrive(pend);
      *su = nextu;
    }
    __syncthreads();
    const int u = *su;
    __syncthreads();
    if (u >= uhi) { pend = nullptr; break; }
    if (threadIdx.x == 0) nextu = ulo + (int)gridDim.x + (int)atomicAdd(ctr, 1u);
    pend = attn_dispatch(p, u, smem);
  }
}

DI void phase_final(const Params& p) {
  int tid_ = threadIdx.x; asm volatile("" : "+v"(tid_));
  const int tid = tid_ & 511, lane = tid & 63, wid = __builtin_amdgcn_readfirstlane(tid >> 6);
  const float* PSS = (const float*)(p.ws + WS_PSS);
  const int G = gridDim.x;
  f32x4 g[4];
#pragma unroll
  for (int i = 0; i < 4; ++i) g[i] = *(const f32x4*)(p.norm_post + (i >> 1) * 512 + lane * 8 + 4 * (i & 1));
#define FIN_LOAD(Y, X, S, u_) do { const int row_ = (u_) * 8 + wid; \
    S = (lane < 16) ? PSS[(size_t)row_ * 16 + lane] : 0.f; \
    const f16* yi_ = (const f16*)(p.ws + WS_Y) + (size_t)row_ * 1024; const float* xi_ = p.x + (size_t)row_ * 1024; \
    Y[0] = *(const f16x8*)(yi_ + lane * 8); Y[1] = *(const f16x8*)(yi_ + 512 + lane * 8); \
    _Pragma("unroll") for (int i = 0; i < 4; ++i) X[i] = *(const f32x4*)(xi_ + (i >> 1) * 512 + lane * 8 + 4 * (i & 1)); } while (0)
#define FIN_ROW(Y, X, S, u_) do { float ss_ = S; \
    _Pragma("unroll") for (int o = 8; o >= 1; o >>= 1) ss_ += __shfl_xor(ss_, o); \
    ss_ = __shfl(ss_, 0); \
    const float rstd_ = rsqrtf(ss_ * (1.f / 1024.f) + 1e-6f); \
    float* yo_ = p.out + (size_t)((u_) * 8 + wid) * 1024; \
    _Pragma("unroll") for (int i = 0; i < 4; ++i) { const f16x8& y_ = Y[i >> 1]; const int q_ = i & 1; f32x4 r_; \
      r_[0] = X[i][0] + (float)y_[4 * q_] * rstd_ * g[i][0]; r_[1] = X[i][1] + (float)y_[4 * q_ + 1] * rstd_ * g[i][1]; \
      r_[2] = X[i][2] + (float)y_[4 * q_ + 2] * rstd_ * g[i][2]; r_[3] = X[i][3] + (float)y_[4 * q_ + 3] * rstd_ * g[i][3]; \
      *(f32x4*)(yo_ + (i >> 1) * 512 + lane * 8 + 4 * q_) = r_; } } while (0)
  f16x8 ya[2], yb[2]; f32x4 xa[4], xb[4]; float sa = 0.f, sb = 0.f;
  int u = blockIdx.x;
  if (u < NTOK / 8) FIN_LOAD(ya, xa, sa, u);
  while (u < NTOK / 8) {
    { const int un = u + G; if (un < NTOK / 8) FIN_LOAD(yb, xb, sb, un); FIN_ROW(ya, xa, sa, u); u = un; }
    if (u >= NTOK / 8) break;
    { const int un = u + G; if (un < NTOK / 8) FIN_LOAD(ya, xa, sa, un); FIN_ROW(yb, xb, sb, u); u = un; }
  }
#undef FIN_LOAD
#undef FIN_ROW
}

#define XB_TMO      128
#define XB_XCNT(j)  (256  + 64 * (j))
#define XB_XSUB(j)  (1280 + 64 * (j))
#define XB_XGEN(j)  (2304 + 64 * (j))
#define XB_TOP      3328
#define XB_TOPGEN   3392
#define XCD_BAR_WORDS 3456
#define XB_SPIN_CAP (1u << 22)
DI unsigned xb_ld(unsigned* p) { return __hip_atomic_load(p, __ATOMIC_RELAXED, __HIP_MEMORY_SCOPE_AGENT); }
DI unsigned xb_add(unsigned* p, unsigned v) { return __hip_atomic_fetch_add(p, v, __ATOMIC_RELAXED, __HIP_MEMORY_SCOPE_AGENT); }
DI unsigned xb_xcc_id() { return (unsigned)__builtin_amdgcn_s_getreg((3 << 11) | 20) & 0xFu; }
#define XB_SPIN(cond, bar) do { unsigned _sp = 0; while (cond) { __builtin_amdgcn_s_sleep(1); \
    if ((++_sp & 255u) == 0u) { if (xb_ld(&(bar)[XB_TMO])) break; if (_sp > XB_SPIN_CAP) { atomicAdd(&(bar)[XB_TMO], 1u); break; } } } } while (0)
struct XcdBarrier { unsigned* bar; unsigned x; volatile LAS unsigned* st; };
DI XcdBarrier xcd_barrier_post(unsigned* bar, volatile LAS unsigned* st) {
  XcdBarrier b; b.bar = bar; b.x = xb_xcc_id(); b.st = st;
  if (threadIdx.x == 0) (void)xb_add(&bar[XB_XCNT(b.x)], 1u);
  return b;
}
DI void xcd_barrier_complete(unsigned* bar, unsigned x, unsigned& nloc, unsigned& nx) {
  const unsigned G = gridDim.x * gridDim.y * gridDim.z;
  unsigned sum, cnt, mine, sp = 0u;
  for (;;) {
    sum = 0u; cnt = 0u; mine = 0u;
#pragma unroll
    for (unsigned j = 0; j < 16; ++j) { const unsigned c = xb_ld(&bar[XB_XCNT(j)]); sum += c; cnt += (c > 0u) ? 1u : 0u; mine = (j == x) ? c : mine; }
    if (sum == G) break;
    __builtin_amdgcn_s_sleep(1);
    if ((++sp & 255u) == 0u) { if (xb_ld(&bar[XB_TMO])) break; if (sp > XB_SPIN_CAP) { atomicAdd(&bar[XB_TMO], 1u); break; } }
  }
  nloc = mine > 0u ? mine : 1u; nx = cnt > 0u ? cnt : 1u;
}
DI void xcd_barrier(const XcdBarrier& b) {
  asm volatile("s_waitcnt vmcnt(0)" ::: "memory");
  __syncthreads();
  if (threadIdx.x == 0) {
    unsigned* bar = b.bar;
    __builtin_amdgcn_s_waitcnt(0);
    unsigned nloc = b.st[0], nx = b.st[1];
    if (nloc == 0u) { xcd_barrier_complete(bar, b.x, nloc, nx); b.st[0] = nloc; b.st[1] = nx; }
    const unsigned old = xb_add(&bar[XB_XSUB(b.x)], 1u);
    const unsigned gen = old / nloc;
    if (old + 1u == (gen + 1u) * nloc) {
      __builtin_amdgcn_fence(__ATOMIC_RELEASE, "agent");
      asm volatile("s_waitcnt vmcnt(0)" ::: "memory");
      const unsigned og = xb_add(&bar[XB_TOP], 1u);
      const unsigned tg = og / nx;
      if (og + 1u == (tg + 1u) * nx) xb_add(&bar[XB_TOPGEN], 1u);
      else XB_SPIN(xb_ld(&bar[XB_TOPGEN]) == tg, bar);
      __builtin_amdgcn_fence(__ATOMIC_ACQUIRE, "agent");
      xb_add(&bar[XB_XGEN(b.x)], 1u);
      asm volatile("s_waitcnt vmcnt(0)" ::: "memory");
    } else {
      XB_SPIN(xb_ld(&bar[XB_XGEN(b.x)]) == gen, bar);
      __builtin_amdgcn_fence(__ATOMIC_ACQUIRE, "agent");
      asm volatile("s_waitcnt vmcnt(0)" ::: "memory");
    }
  }
  __syncthreads();
}

template <int PH>
__global__ void __launch_bounds__(512, 2) hybrid_kernel(Params p) {
  __shared__ __attribute__((aligned(16))) char smem[LDS_BYTES];
  if (PH == -1) {
    unsigned* bar = (unsigned*)(p.ws + WS_BAR);
    volatile LAS unsigned* xst = (volatile LAS unsigned*)(smem + LDS_IMG);
    if (threadIdx.x == 0) { xst[0] = 0u; xst[1] = 0u; }
    __syncthreads();
    XcdBarrier xb = xcd_barrier_post(bar, xst);
    phase_prep(p, smem); xcd_barrier(xb);
    phase_gemm1(p, smem); xcd_barrier(xb);
    phase_attn(p, smem, 0, ATTN_UNITS, 0); xcd_barrier(xb);
    phase_gemm2(p, smem); xcd_barrier(xb);
    phase_final(p);
  } else {
    if (PH == 0) phase_prep(p, smem);
    if (PH == 1) phase_gemm1(p, smem);
    if (PH == 3) phase_attn(p, smem, 0, ATTN_UNITS, 0);
    if (PH == 4) phase_gemm2(p, smem);
    if (PH == 5) phase_final(p);
  }
}

extern "C" void kernel_launch(void* const* d_in, const int* in_sizes, int n_in, void* d_out, int out_size, void* d_ws, size_t ws_size, hipStream_t stream) {
  if (ws_size < WS_END) { fprintf(stderr, "kernel_launch: workspace too small: %zu < %zu\n", ws_size, (size_t)WS_END); return; }
  Params p{};
  p.x = (const float*)d_in[0]; p.mem = (const float*)d_in[1]; p.pos = (const int*)d_in[2]; p.norm_pre = (const float*)d_in[3]; p.w_in = (const float*)d_in[4];
  p.cpk = (const float*)d_in[5]; p.w1k = (const float*)d_in[6]; p.w2k = (const float*)d_in[7]; p.cpv = (const float*)d_in[8]; p.w1v = (const float*)d_in[9]; p.w2v = (const float*)d_in[10];
  p.ret_gn = (const float*)d_in[11]; p.mem_norm = (const float*)d_in[12]; p.w_mem_kv = (const float*)d_in[13]; p.w_out = (const float*)d_in[14]; p.norm_post = (const float*)d_in[15];
  p.out = (float*)d_out; p.ws = (char*)d_ws;
#if MEGA
  static int grid_blocks = 0;
  if (!grid_blocks) {
    int dev = 0, cus = 0, per_cu = 0;
    hipGetDevice(&dev); hipDeviceGetAttribute(&cus, hipDeviceAttributeMultiprocessorCount, dev);
    hipOccupancyMaxActiveBlocksPerMultiprocessor(&per_cu, hybrid_kernel<-1>, 512, 0);
    if (per_cu < 1) { fprintf(stderr, "kernel_launch: occupancy query returned %d\n", per_cu); return; }
    grid_blocks = cus;
  }
  (void)hipMemsetAsync(p.ws + WS_CTR, 0, WS_Y - WS_CTR, stream);
  hipLaunchKernelGGL(hybrid_kernel<-1>, dim3(grid_blocks), dim3(512), 0, stream, p);
  hipError_t e = hipGetLastError();
  if (e != hipSuccess) fprintf(stderr, "launch failed: %s (grid %d)\n", hipGetErrorString(e), grid_blocks);
#else
  hipLaunchKernelGGL(hybrid_kernel<0>, dim3(256), dim3(512), 0, stream, p);
  if (PROBE_DUP == 0) hipLaunchKernelGGL(hybrid_kernel<0>, dim3(256), dim3(512), 0, stream, p);
  hipLaunchKernelGGL(hybrid_kernel<1>, dim3(256), dim3(512), 0, stream, p);
  if (PROBE_DUP == 1) hipLaunchKernelGGL(hybrid_kernel<1>, dim3(256), dim3(512), 0, stream, p);
  hipLaunchKernelGGL(hybrid_kernel<3>, dim3(256), dim3(512), 0, stream, p);
  if (PROBE_DUP == 3) { Params q = p; q.dry = PROBE_ATT; (void)hipMemsetAsync(p.ws + WS_CTR, 0, 4, stream); hipLaunchKernelGGL(hybrid_kernel<3>, dim3(256), dim3(512), 0, stream, q); }
  hipLaunchKernelGGL(hybrid_kernel<4>, dim3(256), dim3(512), 0, stream, p);
  if (PROBE_DUP == 4) hipLaunchKernelGGL(hybrid_kernel<4>, dim3(256), dim3(512), 0, stream, p);
  hipLaunchKernelGGL(hybrid_kernel<5>, dim3(256), dim3(512), 0, stream, p);
#endif
}
```

```cpp
#include <hip/hip_runtime.h>
#include <hip/hip_cooperative_groups.h>
#include <cstdio>
#include <cstdint>
namespace cg = cooperative_groups;

#ifndef MEGA
#define MEGA 1
#endif
#ifndef PROBE_DUP
#define PROBE_DUP -1
#endif
#ifndef PROBE_ATT
#define PROBE_ATT 1
#endif

typedef _Float16 f16;
typedef _Float16 f16x8 __attribute__((ext_vector_type(8)));
typedef _Float16 f16x4 __attribute__((ext_vector_type(4)));
typedef float f32x16 __attribute__((ext_vector_type(16)));
typedef float f32x4 __attribute__((ext_vector_type(4)));
#define DI __device__ __forceinline__
#define MFMA(a, b, c) __builtin_amdgcn_mfma_f32_32x32x16_f16((a), (b), (c), 0, 0, 0)
#define SBAR() __builtin_amdgcn_sched_barrier(0)
#define LAS __attribute__((address_space(3)))

constexpr int NB = 16, NT = 2048, DM = 1024, NTOK = NB * NT, ZW = 6144;
constexpr int ZC_QN = 0, ZC_KV = 1024, ZC_QR = 2560, ZC_KR = 2816, ZC_VR = 3072, ZC_QM = 3584, ZC_GATE = 4096;
constexpr float QSCALE = 0.08838834764831845f * 1.4426950408889634f;
constexpr float THR = 8.f;
constexpr float NEG = -1e30f;

constexpr size_t al256(size_t x) { return (x + 255) / 256 * 256; }
constexpr size_t WS_Z = 0;
constexpr size_t WS_GATES = WS_Z + (size_t)NTOK * ZW * 2;
constexpr size_t WS_WINT = WS_GATES + (size_t)NTOK * 24 * 4;
constexpr size_t WS_WOUTT = WS_WINT + al256((size_t)6168 * 1024 * 2);
constexpr size_t WS_WMEMT = WS_WOUTT + (size_t)1024 * 2048 * 2;
constexpr size_t WS_W1T = WS_WMEMT + (size_t)1024 * 1024 * 2;
constexpr size_t WS_W2T = WS_W1T + (size_t)2 * 256 * 4096 * 2;
constexpr size_t WS_MEMN = WS_W2T + (size_t)2 * 128 * 256 * 2;
constexpr size_t WS_KVM = WS_MEMN + (size_t)4096 * 1024 * 2;
constexpr size_t WS_ROT = WS_KVM + (size_t)4096 * 1024 * 2;
constexpr size_t WS_PB1 = WS_ROT + (size_t)NTOK * 48 * 2 * 4;
constexpr size_t WS_HID = WS_PB1 + (size_t)2 * 16 * 256 * 4;
constexpr size_t WS_KC = WS_HID + (size_t)2 * 4096 * 256 * 2;
constexpr size_t WS_PSS = WS_KC + (size_t)2 * 4096 * 128 * 2;
constexpr size_t WS_CTR = WS_PSS + (size_t)NTOK * 16 * 4;
constexpr size_t WS_BAR = WS_CTR + 4096;
constexpr size_t WS_Y = WS_BAR + 16384;
constexpr size_t WS_END = WS_Y + (size_t)NTOK * 1024 * 2;

constexpr int LDS_IMG = 8 * 128 * 144;
constexpr int LDS_BYTES = LDS_IMG + 64;

struct Params {
  const float* x; const float* mem; const int* pos; const float* norm_pre; const float* w_in;
  const float* cpk; const float* w1k; const float* w2k; const float* cpv; const float* w1v; const float* w2v;
  const float* ret_gn; const float* mem_norm; const float* w_mem_kv; const float* w_out; const float* norm_post;
  float* out; char* ws;
  int dry;
  int pad_;
};

DI int crow(int r, int h) { return (r & 3) + 8 * (r >> 2) + 4 * h; }
DI unsigned swz128(int r, int c) { return (unsigned)(r * 128 + ((c ^ ((r >> 1) & 7)) << 4)); }
DI unsigned off_a(int row, int ch) { return (unsigned)(2048 * (row >> 3) + 512 * (ch >> 2) + 64 * (row & 7) + 16 * ((ch & 3) ^ ((row >> 2) & 3))); }
DI float xhalf_max(float v) { auto rr = __builtin_amdgcn_permlane32_swap(__float_as_uint(v), __float_as_uint(v), false, false); return fmaxf(__uint_as_float(rr[0]), __uint_as_float(rr[1])); }
DI float xhalf_sum(float v) { auto rr = __builtin_amdgcn_permlane32_swap(__float_as_uint(v), __float_as_uint(v), false, false); return __uint_as_float(rr[0]) + __uint_as_float(rr[1]); }
DI float fexp2(float x) { return __builtin_amdgcn_exp2f(x); }
DI float sigmoidf_(float x) { return __builtin_amdgcn_rcpf(1.f + __expf(-x)); }
DI float siluf_(float x) { return x * __builtin_amdgcn_rcpf(1.f + __expf(-x)); }
DI float gelu_tanh(float x) { float u = 0.7978845608028654f * (x + 0.044715f * x * x * x); float e = __expf(2.f * u); float t = 1.f - 2.f / (e + 1.f); return 0.5f * x * (1.f + t); }
template <int OFF> DI f16x4 tr_read(unsigned addr) { f16x4 r; asm volatile("ds_read_b64_tr_b16 %0, %1 offset:%2" : "=&v"(r) : "v"(addr), "i"(OFF) : "memory"); return r; }

struct TrU { const float* src; f16* dst; int N, ldd, k0, n0, remap; };
DI void tr_decode(const Params& p, int u, TrU& t) {
  char* ws = p.ws;
  int kt, nt; t.remap = 0;
  if (u < 1552) { t.src = p.w_in; t.N = 6168; t.dst = (f16*)(ws + WS_WINT); t.ldd = 1024; kt = u / 97; nt = u - kt * 97; t.remap = 1; }
  else if (u < 2064) { u -= 1552; t.src = p.w_out; t.N = 1024; t.dst = (f16*)(ws + WS_WOUTT); t.ldd = 2048; kt = u >> 4; nt = u & 15; }
  else if (u < 2320) { u -= 2064; t.src = p.w_mem_kv; t.N = 1024; t.dst = (f16*)(ws + WS_WMEMT); t.ldd = 1024; kt = u >> 4; nt = u & 15; }
  else if (u < 2832) { u -= 2320; const int kv = u >> 8, v = u & 255; t.src = kv ? p.w1v : p.w1k; t.N = 256; t.dst = (f16*)(ws + WS_W1T) + (size_t)kv * 256 * 4096; t.ldd = 4096; kt = v >> 2; nt = v & 3; }
  else { u -= 2832; const int kv = u >> 3, v = u & 7; t.src = kv ? p.w2v : p.w2k; t.N = 128; t.dst = (f16*)(ws + WS_W2T) + (size_t)kv * 128 * 256; t.ldd = 256; kt = v >> 1; nt = v & 1; }
  t.k0 = kt * 64; t.n0 = nt * 64;
}
DI void tr_load(const TrU& t, float (&v)[8], int tid) {
#pragma unroll
  for (int i = 0; i < 8; ++i) { const int e = tid + 512 * i, kk = e >> 6, nn = e & 63; const int n = min(t.n0 + nn, t.N - 1); v[i] = t.src[(size_t)(t.k0 + kk) * t.N + n]; }
}
constexpr int N_TR_UNITS = 2848;

#define MFMA16(a, b, c) __builtin_amdgcn_mfma_f32_16x16x32_f16((a), (b), (c), 0, 0, 0)
DI void phase_prep(const Params& p, char* smem) {
  const int tid = threadIdx.x, lane = tid & 63, wid = tid >> 6;
  const int G = gridDim.x;
  char* ws = p.ws;
  if (blockIdx.x == 0 && tid < 128) ((unsigned*)(ws + WS_CTR))[tid] = 0u;
  {
    LAS unsigned char* lds_ = (LAS unsigned char*)smem;
    {
      float wv[48];
#pragma unroll
      for (int i = 0; i < 48; ++i) { const int e = tid + 512 * i, k = e / 24, n = e - 24 * k; wv[i] = p.w_in[(size_t)k * 6168 + 2560 + n]; }
#pragma unroll
      for (int i = 0; i < 48; ++i) { const int e = tid + 512 * i, k = e / 24, n = e - 24 * k; *(LAS f16*)(lds_ + 32768 + n * 2064 + k * 2) = (f16)wv[i]; }
    }
    for (int e = tid; e < 8 * 1032; e += 512) { const int n = 24 + e / 1032, k = e % 1032; *(LAS f16*)(lds_ + 32768 + n * 2064 + k * 2) = (f16)0.f; }
    __syncthreads();
  }
  {
    float* tile = (float*)smem;
    int u = blockIdx.x; TrU t; float v[8];
    if (u < N_TR_UNITS) { tr_decode(p, u, t); tr_load(t, v, tid); }
    while (u < N_TR_UNITS) {
#pragma unroll
      for (int i = 0; i < 8; ++i) { const int e = tid + 512 * i; tile[(e >> 6) * 65 + (e & 63)] = v[i]; }
      __syncthreads();
      TrU tn = t; const int un = u + G;
      if (un < N_TR_UNITS) { tr_decode(p, un, tn); tr_load(tn, v, tid); }
#pragma unroll
      for (int i = 0; i < 4; ++i) {
        const int e = tid + 512 * i, nn = e >> 5, kk = (e & 31) * 2; const int n = t.n0 + nn;
        if (n < t.N) {
          int nd = n;
          if (t.remap) nd = (n < 2560) ? n : ((n < 2584) ? (6144 + n - 2560) : (n - 24));
          typedef _Float16 h2 __attribute__((ext_vector_type(2)));
          h2 w; w[0] = (f16)tile[kk * 65 + nn]; w[1] = (f16)tile[(kk + 1) * 65 + nn];
          *(h2*)(t.dst + (size_t)nd * t.ldd + t.k0 + kk) = w;
        }
      }
      __syncthreads();
      t = tn; u = un;
    }
  }
  f16* H = (f16*)p.out; f16* MEMN = (f16*)(ws + WS_MEMN);
#define RMS_ROW(V, DST) do { float ss_ = 0.f; \
      _Pragma("unroll") for (int i = 0; i < 4; ++i) ss_ += V[i][0] * V[i][0] + V[i][1] * V[i][1] + V[i][2] * V[i][2] + V[i][3] * V[i][3]; \
      _Pragma("unroll") for (int o = 32; o >= 1; o >>= 1) ss_ += __shfl_xor(ss_, o); \
      const float rstd_ = rsqrtf(ss_ * (1.f / 1024.f) + 1e-6f); \
      _Pragma("unroll") for (int i = 0; i < 4; ++i) { f16x4 o4; o4[0] = (f16)(V[i][0] * rstd_ * gn[i][0]); o4[1] = (f16)(V[i][1] * rstd_ * gn[i][1]); o4[2] = (f16)(V[i][2] * rstd_ * gn[i][2]); o4[3] = (f16)(V[i][3] * rstd_ * gn[i][3]); \
        *(f16x4*)((DST) + i * 256 + lane * 4) = o4; } } while (0)
#define RMS_LOAD(V, SRC) do { _Pragma("unroll") for (int i = 0; i < 4; ++i) V[i] = *(const f32x4*)((SRC) + i * 256 + lane * 4); } while (0)
  {
    f32x4 gn[4];
#pragma unroll
    for (int i = 0; i < 4; ++i) gn[i] = *(const f32x4*)(p.norm_pre + i * 256 + lane * 4);
    f32x4 va[4], vb[4], na[4], nb[4];
    float* GATES = (float*)(ws + WS_GATES);
    LAS unsigned char* lds_ = (LAS unsigned char*)smem;
    const int fr = lane & 15, fq = lane >> 4;
    for (int gi = blockIdx.x; gi < NTOK / 128; gi += G) {
      const int rowbase = 128 * gi + 16 * wid;
      { const float* s0 = p.x + (size_t)rowbase * 1024; RMS_LOAD(va, s0); RMS_LOAD(vb, s0 + 1024); }
#define RMS_STEP(CA, CB, NA, NB, j_) do { \
        if ((j_) + 1 < 8) { const float* s0 = p.x + (size_t)(rowbase + 2 * ((j_) + 1)) * 1024; RMS_LOAD(NA, s0); RMS_LOAD(NB, s0 + 1024); } \
        f16* d0 = H + (size_t)(rowbase + 2 * (j_)) * 1024; \
        RMS_ROW(CA, d0); RMS_ROW(CB, d0 + 1024); } while (0)
#pragma unroll 1
      for (int j = 0; j < 8; j += 2) { RMS_STEP(va, vb, na, nb, j); RMS_STEP(na, nb, va, vb, j + 1); }
#undef RMS_STEP
      asm volatile("s_waitcnt vmcnt(0)" ::: "memory");
      const f16* hrow = H + (size_t)(rowbase + fr) * 1024 + 8 * fq;
      f32x4 g0 = {0.f, 0.f, 0.f, 0.f}, g1 = {0.f, 0.f, 0.f, 0.f};
#pragma unroll 1
      for (int k0 = 0; k0 < 32; k0 += 16) {
        f16x8 af[16];
#pragma unroll
        for (int k = 0; k < 16; ++k) af[k] = *(const f16x8*)(hrow + 32 * (k0 + k));
#pragma unroll
        for (int k = 0; k < 16; ++k) {
          const f16x8 b0 = *(const LAS f16x8*)(lds_ + 32768 + fr * 2064 + (32 * (k0 + k) + 8 * fq) * 2);
          const f16x8 b1 = *(const LAS f16x8*)(lds_ + 32768 + (16 + fr) * 2064 + (32 * (k0 + k) + 8 * fq) * 2);
          g0 = MFMA16(b0, af[k], g0); g1 = MFMA16(b1, af[k], g1);
        }
      }
      float* gp = GATES + (size_t)(rowbase + fr) * 24 + 4 * fq;
#pragma unroll
      for (int j = 0; j < 4; ++j) { g0[j] = sigmoidf_(g0[j]); g1[j] = sigmoidf_(g1[j]); }
      *(f32x4*)gp = g0;
      if (fq < 2) *(f32x4*)(gp + 16) = g1;
    }
  }
  {
    f32x4 gn[4];
#pragma unroll
    for (int i = 0; i < 4; ++i) gn[i] = *(const f32x4*)(p.mem_norm + i * 256 + lane * 4);
    for (int u = blockIdx.x; u < 4096 / 8; u += G) {
      f32x4 va[4]; const int row = u * 8 + wid;
      RMS_LOAD(va, p.mem + (size_t)row * 1024);
      RMS_ROW(va, MEMN + (size_t)row * 1024);
    }
  }
#undef RMS_ROW
#undef RMS_LOAD
  float* ROT = (float*)(ws + WS_ROT);
  for (int e = blockIdx.x * 512 + tid; e < NTOK * 48; e += G * 512) {
    int tok = e / 48, f = e - tok * 48;
    float invf;
    if (f < 16) invf = exp2f(-((float)f / 16.f) * 18.931568569324174f);
    else invf = exp2f(-((float)(f - 16) / 32.f) * 13.287712379549449f);
    const float ang = (float)p.pos[tok] * invf;
    float sn, cs; sincosf(ang, &sn, &cs);
    ROT[(size_t)e * 2] = cs; ROT[(size_t)e * 2 + 1] = sn;
  }
  float* PB1 = (float*)(ws + WS_PB1);
  for (int u = G - 1 - (int)blockIdx.x; u < 32; u += G) {
    const int kv = u >> 4, ch = u & 15; const float* w1 = kv ? p.w1v : p.w1k; const float* cp = kv ? p.cpv : p.cpk;
    const int i0 = ch * 256 + wid * 32;
    f32x4 acc = {0.f, 0.f, 0.f, 0.f};
#pragma unroll 16
    for (int i = 0; i < 32; ++i) { const float c = cp[i0 + i]; const f32x4 w = *(const f32x4*)(w1 + (size_t)(i0 + i) * 256 + lane * 4); acc[0] += c * w[0]; acc[1] += c * w[1]; acc[2] += c * w[2]; acc[3] += c * w[3]; }
    float* red = (float*)smem;
    *(f32x4*)(red + wid * 256 + lane * 4) = acc;
    __syncthreads();
    if (tid < 256) { float sacc = 0.f;
#pragma unroll
      for (int w = 0; w < 8; ++w) sacc += red[w * 256 + tid];
      PB1[(kv * 16 + ch) * 256 + tid] = sacc; }
    __syncthreads();
  }
}

template <class KA, class KB>
DI void gemm_core(f32x16 (&acc)[4][2], const char* baseA, long strideA, unsigned voffA, const char* baseB, long strideB, unsigned voffB,
                  KA koffA, KB koffB, int nk, char* smem) {
  int tid_ = threadIdx.x; asm volatile("" : "+v"(tid_)); const int tid = tid_, lane = tid & 63, wid = tid >> 6, wm = wid >> 2, wn = wid & 3;
  const int lr = tid >> 3, lc = tid & 7;
  const unsigned so = swz128(lr, lc);
  f16x8 ra[4], rb[4], sa[4], sb[4];
#define GLOAD(RA, RB, kt) do { const char* a_ = baseA + koffA(kt) * 2; const char* b_ = baseB + koffB(kt) * 2; \
    RA[0] = *(const f16x8*)(a_ + (size_t)voffA); RA[1] = *(const f16x8*)(a_ + strideA + (size_t)voffA); RA[2] = *(const f16x8*)(a_ + 2 * strideA + (size_t)voffA); RA[3] = *(const f16x8*)(a_ + 3 * strideA + (size_t)voffA); \
    RB[0] = *(const f16x8*)(b_ + (size_t)voffB); RB[1] = *(const f16x8*)(b_ + strideB + (size_t)voffB); RB[2] = *(const f16x8*)(b_ + 2 * strideB + (size_t)voffB); RB[3] = *(const f16x8*)(b_ + 3 * strideB + (size_t)voffB); } while (0)
#define LSTORE(RA, RB, st) do { char* b_ = smem + (st) * 65536 + so; \
    *(f16x8*)(b_) = RA[0]; *(f16x8*)(b_ + 8192) = RA[1]; *(f16x8*)(b_ + 16384) = RA[2]; *(f16x8*)(b_ + 24576) = RA[3]; \
    *(f16x8*)(b_ + 32768) = RB[0]; *(f16x8*)(b_ + 32768 + 8192) = RB[1]; *(f16x8*)(b_ + 32768 + 16384) = RB[2]; *(f16x8*)(b_ + 32768 + 24576) = RB[3]; } while (0)
  const int l31 = lane & 31, h = lane >> 5, xx = (l31 >> 1) & 7;
  const unsigned fbase = l31 * 128;
  unsigned cx[4];
#pragma unroll
  for (int s = 0; s < 4; ++s) cx[s] = (unsigned)(((2 * s + h) ^ xx) << 4);
#define COMPUTE(kt) do { \
      const char* A = smem + ((kt) & 1) * 65536 + (128 * wm) * 128 + fbase; \
      const char* Bm = smem + ((kt) & 1) * 65536 + 32768 + (64 * wn) * 128 + fbase; \
      _Pragma("unroll") for (int s = 0; s < 4; ++s) { \
        f16x8 hf[4], wf[2]; \
        _Pragma("unroll") for (int i = 0; i < 4; ++i) hf[i] = *(const f16x8*)(A + i * 4096 + cx[s]); \
        _Pragma("unroll") for (int j = 0; j < 2; ++j) wf[j] = *(const f16x8*)(Bm + j * 4096 + cx[s]); \
        _Pragma("unroll") for (int i = 0; i < 4; ++i) _Pragma("unroll") for (int j = 0; j < 2; ++j) acc[i][j] = MFMA(wf[j], hf[i], acc[i][j]); \
      } } while (0)
  GLOAD(ra, rb, 0); GLOAD(sa, sb, 1);
  LSTORE(ra, rb, 0); __syncthreads();
  for (int kt = 0; kt < nk; kt += 2) {
    if (kt + 2 < nk) GLOAD(ra, rb, kt + 2);
    COMPUTE(kt);
    LSTORE(sa, sb, 1);
    __syncthreads();
    if (kt + 3 < nk) GLOAD(sa, sb, kt + 3);
    COMPUTE(kt + 1);
    if (kt + 2 < nk) LSTORE(ra, rb, 0);
    __syncthreads();
  }
#undef GLOAD
#undef LSTORE
#undef COMPUTE
}

template <class XF>
DI void store_tile_f16(const f32x16 (&acc)[4][2], f16* dst, long ld, char* smem, bool active, XF xf) {
  int tid_ = threadIdx.x; asm volatile("" : "+v"(tid_)); const int tid = tid_, lane = tid & 63, wid = tid >> 6, wm = wid >> 2, wn = wid & 3, l31 = lane & 31, h = lane >> 5;
  char* img = smem + wid * (128 * 144);
#pragma unroll
  for (int i = 0; i < 4; ++i)
#pragma unroll
    for (int j = 0; j < 2; ++j)
#pragma unroll
      for (int g = 0; g < 4; ++g) {
        f16x4 v; v[0] = (f16)acc[i][j][4 * g]; v[1] = (f16)acc[i][j][4 * g + 1]; v[2] = (f16)acc[i][j][4 * g + 2]; v[3] = (f16)acc[i][j][4 * g + 3];
        *(f16x4*)(img + (32 * i + l31) * 144 + (32 * j + 8 * g + 4 * h) * 2) = v;
      }
  __syncthreads();
  if (active) {
    f16* d = dst + (long)(128 * wm) * ld + 64 * wn;
#pragma unroll 2
    for (int it = 0; it < 16; ++it) {
      const int row = it * 8 + (lane >> 3), ch = lane & 7;
      const char* rowp = img + row * 144;
      f16x8 v = *(const f16x8*)(rowp + ch * 16);
      v = xf(v, rowp, 128 * wm + row, wn, ch);
      *(f16x8*)(d + (long)row * ld + ch * 8) = v;
    }
  }
  __syncthreads();
}
struct XfNone { DI f16x8 operator()(f16x8 v, const char*, int, int, int) const { return v; } };
struct XfGelu { DI f16x8 operator()(f16x8 v, const char*, int, int, int) const { f16x8 r;
#pragma unroll
  for (int e = 0; e < 8; ++e) r[e] = (f16)gelu_tanh((float)v[e]);
  return r; } };
struct XfZ {
  int seg; const float* rot;
  DI f16x8 operator()(f16x8 v, const char* rowp, int trow, int wn, int ch) const {
    f16x8 r = v;
    if (seg == 6) {
#pragma unroll
      for (int e = 0; e < 8; ++e) r[e] = (f16)siluf_((float)v[e]);
    } else if (seg == 0 || seg == 1) {
      float sc = (seg == 0) ? QSCALE : 1.f;
      if (((wn & 1) == 0) && ch < 4) {
        const f16x8 pv = *(const f16x8*)(rowp + (ch ^ 2) * 16);
        const float* rp = rot + (size_t)trow * 96 + 16 * (ch & 1);
        const bool first = ch < 2;
#pragma unroll
        for (int e2 = 0; e2 < 4; ++e2) {
          const f32x4 cs = *(const f32x4*)(rp + 4 * e2);
#pragma unroll
          for (int q = 0; q < 2; ++q) {
            const int e = 2 * e2 + q; const float c = cs[2 * q], sn = cs[2 * q + 1];
            const float x1 = first ? (float)v[e] : (float)pv[e], x2 = first ? (float)pv[e] : (float)v[e];
            r[e] = (f16)((first ? (x1 * c - x2 * sn) : (x1 * sn + x2 * c)) * sc);
          }
        }
      } else {
#pragma unroll
        for (int e = 0; e < 8; ++e) r[e] = (f16)((float)v[e] * sc);
      }
    } else if (seg == 3 || seg == 4) {
      const float sc = (seg == 4) ? 0.125f : 1.f;
      const f16x8 pv = *(const f16x8*)(rowp + (ch ^ 4) * 16);
      const float* rp = rot + (size_t)trow * 96 + 32 + 16 * (ch & 3);
      const bool first = ch < 4;
#pragma unroll
      for (int e2 = 0; e2 < 4; ++e2) {
        const f32x4 cs = *(const f32x4*)(rp + 4 * e2);
#pragma unroll
        for (int q = 0; q < 2; ++q) {
          const int e = 2 * e2 + q; const float c = cs[2 * q], sn = cs[2 * q + 1];
          const float x1 = first ? (float)v[e] : (float)pv[e], x2 = first ? (float)pv[e] : (float)v[e];
          r[e] = (f16)((first ? (x1 * c - x2 * sn) : (x1 * sn + x2 * c)) * sc);
        }
      }
    } else if (seg == 5) {
#pragma unroll
      for (int e = 0; e < 8; ++e) r[e] = (f16)((float)v[e] * QSCALE);
    }
    return r;
  }
};

struct KStd { DI long operator()(int kt) const { return (long)kt * 64; } };
struct KCmp { DI long operator()(int kt) const { return (long)(kt >> 1) * ZW + (kt & 1) * 64; } };

DI void zero_acc(f32x16 (&acc)[4][2]) {
#pragma unroll
  for (int i = 0; i < 4; ++i)
#pragma unroll
    for (int j = 0; j < 2; ++j)
#pragma unroll
      for (int r = 0; r < 16; ++r) acc[i][j][r] = 0.f;
}


constexpr int HTB = 128 * 64 * 2;
DI int lds_byte(int r, int c) { const int st = (r >> 4) * 2 + (c >> 5), rr = r & 15, cc = c & 31, ob = rr * 64 + cc * 2; return st * 1024 + (ob ^ (((ob >> 9) & 1) << 5)); }
DI void stage_rc(int b, int& R, int& C) { const int st = b / 1024, sb = b % 1024, swz = sb ^ (((sb >> 9) & 1) << 5); R = (st >> 1) * 16 + swz / 64; C = (st & 1) * 32 + (swz % 64) / 2; }
DI int perm32(int rho) { const int n = rho >> 4, i = rho & 15; return 8 * (i >> 2) + 4 * n + (i & 3); }
DI int brow_of(int bmode, int h, int R) {
  return bmode == 0 ? 128 * h + R : (bmode == 1 ? 128 * h + (R & ~31) + perm32(R & 31) : 64 * (R >> 5) + 32 * h + perm32(R & 31));
}
struct GUnit { const char* A; const char* B; int bmode, seg, pm, pn; };

template <class Sched, class Epi>
DI void gemm_stream(LAS unsigned char* lds, int K, long lda, long ldb, const Sched& S, const Epi& E) {
  int tid_ = threadIdx.x; asm volatile("" : "+v"(tid_));
  const int tid = tid_ & 511, wid = __builtin_amdgcn_readfirstlane(tid >> 6), lane = tid & 63, wr = wid >> 2, wc = wid & 3, fr = lane & 15, fq = lane >> 4;
  const int nt = K / 64;
  unsigned voffA[2], voffB0[2], voffB1[2];
#pragma unroll
  for (int i = 0; i < 2; ++i) { int R_, C_; stage_rc(tid * 16 + i * 8192, R_, C_); voffA[i] = (unsigned)(R_ * lda + C_ * 2); }
  const size_t kstep = 128, hstepA = (size_t)128 * lda;
  const unsigned ldsw = (unsigned)wid * 1024u;
  const int aoff = lds_byte(wr * 64 + fr, fq * 8), boff = lds_byte(wc * 32 + fr, fq * 8);
#define GS_SA(b, h) (((b) * 2 + (h)) * HTB)
#define GS_SB(b, h) ((4 + (b) * 2 + (h)) * HTB)
#define GS_STAGE(bufoff, gbase, voff) do { _Pragma("unroll") for (int _i = 0; _i < 2; ++_i) \
    __builtin_amdgcn_global_load_lds((const unsigned*)((const char*)(gbase) + (voff)[_i]), (LAS unsigned*)(lds + (bufoff) + ldsw + _i * 8192), 16, 0, 0); } while (0)
#define GS_LDA(dst, b, h) do { _Pragma("unroll") for (int m = 0; m < 4; ++m) _Pragma("unroll") for (int k = 0; k < 2; ++k) dst[m][k] = *(const LAS f16x8*)(lds + GS_SA(b, h) + aoff + m * 2048 + k * 1024); } while (0)
#define GS_LDB(dst, b, h) do { _Pragma("unroll") for (int n = 0; n < 2; ++n) _Pragma("unroll") for (int k = 0; k < 2; ++k) dst[n][k] = *(const LAS f16x8*)(lds + GS_SB(b, h) + boff + n * 2048 + k * 1024); } while (0)
#define GS_MMA(ai, bj, At, Bt) do { __builtin_amdgcn_s_setprio(1); _Pragma("unroll") for (int m = 0; m < 4; ++m) _Pragma("unroll") for (int n = 0; n < 2; ++n) _Pragma("unroll") for (int k = 0; k < 2; ++k) \
    acc[ai][bj][m][n] = MFMA16(Bt[n][k], At[m][k], acc[ai][bj][m][n]); __builtin_amdgcn_s_setprio(0); } while (0)
#define GS_WAIT_V(n) asm volatile("s_waitcnt vmcnt(" #n ")" ::: "memory")
#define GS_WAIT_L(n) asm volatile("s_waitcnt lgkmcnt(" #n ")" ::: "memory")
#define GS_BAR __builtin_amdgcn_s_barrier()
#define GS_SCHED __builtin_amdgcn_sched_barrier(0)
#define GS_SETB(mode) do { int tq_ = threadIdx.x; asm volatile("" : "+v"(tq_)); _Pragma("unroll") for (int _i = 0; _i < 2; ++_i) { int R_, C_; stage_rc(tq_ * 16 + _i * 8192, R_, C_); \
    voffB0[_i] = (unsigned)(brow_of(mode, 0, R_) * ldb + C_ * 2); voffB1[_i] = (unsigned)(brow_of(mode, 1, R_) * ldb + C_ * 2); } } while (0)
  GUnit cur, nxt; int ui = 0;
  if (!S.next(0, cur)) return;
  f32x4 acc[2][2][4][2];
#pragma unroll
  for (int a = 0; a < 2; ++a)
#pragma unroll
    for (int b = 0; b < 2; ++b)
#pragma unroll
      for (int m = 0; m < 4; ++m)
#pragma unroll
        for (int n = 0; n < 2; ++n) acc[a][b][m][n] = (f32x4){0.f, 0.f, 0.f, 0.f};
  f16x8 At[4][2], B0[2][2], B1[2][2];
  const char* cA = cur.A; const char* cB = cur.B;
  GS_SETB(cur.bmode);
  GS_STAGE(GS_SB(0, 0), cB, voffB0); GS_STAGE(GS_SA(0, 0), cA, voffA); GS_STAGE(GS_SB(0, 1), cB, voffB1); GS_STAGE(GS_SA(0, 1), cA + hstepA, voffA);
  if (wr == 1) GS_BAR;
  GS_WAIT_V(4); GS_BAR;
  GS_STAGE(GS_SB(1, 0), cB + kstep, voffB0); GS_STAGE(GS_SA(1, 0), cA + kstep, voffA); GS_STAGE(GS_SB(1, 1), cB + kstep, voffB1);
  GS_WAIT_V(6); GS_BAR;
  for (;;) {
    const bool has_next = S.next(ui + 1, nxt);
    const char* nA = has_next ? nxt.A : cA; const char* nB = has_next ? nxt.B : cB;
    for (int t = 0; t < nt; t += 2) {
      const bool last = (t == nt - 2);
      const char* a1 = cA + (size_t)(t + 1) * kstep;
      const char* a2 = last ? nA : cA + (size_t)(t + 2) * kstep; const char* b2 = last ? nB : cB + (size_t)(t + 2) * kstep;
      const char* a3 = a2 + kstep; const char* b3 = b2 + kstep;
      if (last && has_next) GS_SETB(nxt.bmode);
      GS_LDB(B0, 0, 0); GS_SCHED; GS_LDA(At, 0, 0); GS_STAGE(GS_SA(1, 1), a1 + hstepA, voffA);
      GS_WAIT_L(8); GS_BAR; GS_WAIT_L(0); GS_MMA(0, 0, At, B0); GS_BAR; GS_SCHED;
      GS_LDB(B1, 0, 1); GS_STAGE(GS_SB(0, 0), b2, voffB0);
      GS_BAR; GS_WAIT_L(0); GS_MMA(0, 1, At, B1); GS_BAR;
      GS_LDA(At, 0, 1); GS_STAGE(GS_SA(0, 0), a2, voffA);
      GS_BAR; GS_WAIT_L(0); GS_MMA(1, 0, At, B0); GS_BAR; GS_SCHED;
      GS_STAGE(GS_SB(0, 1), b2, voffB1);
      GS_WAIT_V(6); GS_BAR; GS_MMA(1, 1, At, B1); GS_BAR;
      GS_LDB(B0, 1, 0); GS_SCHED; GS_LDA(At, 1, 0); GS_STAGE(GS_SA(0, 1), a2 + hstepA, voffA);
      GS_WAIT_L(8); GS_BAR; GS_WAIT_L(0); GS_MMA(0, 0, At, B0); GS_BAR; GS_SCHED;
      GS_LDB(B1, 1, 1); GS_STAGE(GS_SB(1, 0), b3, voffB0);
      GS_BAR; GS_WAIT_L(0); GS_MMA(0, 1, At, B1); GS_BAR;
      GS_LDA(At, 1, 1); GS_STAGE(GS_SA(1, 0), a3, voffA);
      GS_BAR; GS_WAIT_L(0); GS_MMA(1, 0, At, B0); GS_BAR; GS_SCHED;
      GS_STAGE(GS_SB(1, 1), b3, voffB1);
      GS_WAIT_V(6); GS_BAR; GS_MMA(1, 1, At, B1); GS_BAR;
    }
    E(acc, cur, wr, wc, fr, fq);
    if (!has_next) break;
#pragma unroll
    for (int a = 0; a < 2; ++a)
#pragma unroll
      for (int b = 0; b < 2; ++b)
#pragma unroll
        for (int m = 0; m < 4; ++m)
#pragma unroll
          for (int n = 0; n < 2; ++n) acc[a][b][m][n] = (f32x4){0.f, 0.f, 0.f, 0.f};
    cur = nxt; cA = nA; cB = nB; ++ui;
  }
  GS_WAIT_V(0);
  if (wr == 0) GS_BAR;
  GS_BAR;
#undef GS_SA
#undef GS_SB
#undef GS_STAGE
#undef GS_LDA
#undef GS_LDB
#undef GS_MMA
#undef GS_WAIT_V
#undef GS_WAIT_L
#undef GS_BAR
#undef GS_SCHED
#undef GS_SETB
}

struct Sched1 {
  const char* H; const char* W; const char* MEMN; const char* WMEM; int b, G;
  DI bool next(int i, GUnit& u) const {
    int kind, mt, nt;
    if (G == 256) {
      if (i < 12) { const int xcd = b & 7, l = b >> 3; const int st = i * 8 + xcd; const int mg = st / 3, ng = st % 3; kind = 0; mt = mg * 4 + (l & 3); nt = ng * 8 + (l >> 2); }
      else return false;
    } else {
      const int L = i * G + b;
      if (L < 3072) { kind = 0; mt = L / 24; nt = L % 24; }
      else return false;
    }
    u.pm = mt; u.pn = nt;
    if (kind == 1) { u.A = MEMN + (size_t)mt * 256 * 2048; u.B = WMEM + (size_t)nt * 256 * 2048; u.seg = 8; u.bmode = 1; return true; }
    int seg = 2;
    if (nt == 4 || nt == 6 || nt == 8) seg = 1;     else if (nt == 10) seg = 3; else if (nt == 11) seg = 4;
    else if (nt == 14 || nt == 15) seg = 5; else if (nt >= 16 && nt < 24) seg = 6; else if (nt == 24) seg = 7;
    u.seg = seg; u.bmode = (seg <= 1) ? 0 : ((seg == 3 || seg == 4) ? 2 : 1);
    u.A = H + (size_t)mt * 256 * 2048; u.B = W + (size_t)(nt < 24 ? nt * 256 : 6144) * 2048;
    return true;
  }
};
DI unsigned pk2(float a, float b) { typedef _Float16 h2 __attribute__((ext_vector_type(2))); h2 v; v[0] = (f16)a; v[1] = (f16)b; return __builtin_bit_cast(unsigned, v); }
struct Epi1 {
  f16* Z; f16* KVM; float* GATES; const float* ROT;
  DI void operator()(const f32x4 (&acc)[2][2][4][2], const GUnit& u, int wr, int wc, int fr, int fq) const {
    typedef unsigned u32x4_ __attribute__((ext_vector_type(4)));
    typedef unsigned u32x2_ __attribute__((ext_vector_type(2)));
    const int seg = u.seg;
    const int row0 = u.pm * 256 + wr * 64 + fr;
    if (seg == 7) {
      if (wc == 0 && fq < 3) {
#pragma unroll
        for (int ai = 0; ai < 2; ++ai)
#pragma unroll
          for (int m = 0; m < 4; ++m) {
            float* gp = GATES + (size_t)(row0 + ai * 128 + m * 16) * 24 + 8 * fq;
            f32x4 v0 = acc[ai][0][m][0], v1 = acc[ai][0][m][1];
#pragma unroll
            for (int j = 0; j < 4; ++j) { v0[j] = sigmoidf_(v0[j]); v1[j] = sigmoidf_(v1[j]); }
            *(f32x4*)gp = v0; *(f32x4*)(gp + 4) = v1;
          }
      }
      return;
    }
    if (seg == 0 || seg == 1) {
      const float sc = (seg == 0) ? QSCALE : 1.f;
      if (wc == 0) {
#pragma unroll
        for (int ai = 0; ai < 2; ++ai) {
          f32x4 ca[4], cb[4];
#pragma unroll
          for (int m = 0; m < 4; ++m) { const float* rp = ROT + (size_t)(row0 + ai * 128 + m * 16) * 96 + 8 * fq; ca[m] = *(const f32x4*)rp; cb[m] = *(const f32x4*)(rp + 4); }
#pragma unroll
          for (int m = 0; m < 4; ++m) {
            f16* zp = Z + (size_t)(row0 + ai * 128 + m * 16) * ZW + u.pn * 256 + 4 * fq;
            const float cs[4] = {ca[m][0], ca[m][2], cb[m][0], cb[m][2]}, sn[4] = {ca[m][1], ca[m][3], cb[m][1], cb[m][3]};
#pragma unroll
            for (int bj = 0; bj < 2; ++bj) {
              const f32x4 x1 = acc[ai][bj][m][0], x2 = acc[ai][bj][m][1];
              f32x4 o1, o2;
#pragma unroll
              for (int j = 0; j < 4; ++j) { o1[j] = (x1[j] * cs[j] - x2[j] * sn[j]) * sc; o2[j] = (x1[j] * sn[j] + x2[j] * cs[j]) * sc; }
              u32x2_ w1, w2; w1.x = pk2(o1[0], o1[1]); w1.y = pk2(o1[2], o1[3]); w2.x = pk2(o2[0], o2[1]); w2.y = pk2(o2[2], o2[3]);
              *(u32x2_*)(zp + bj * 128) = w1; *(u32x2_*)(zp + bj * 128 + 16) = w2;
            }
          }
        }
      } else {
#pragma unroll
        for (int ai = 0; ai < 2; ++ai)
#pragma unroll
          for (int m = 0; m < 4; ++m) {
            f16* zp = Z + (size_t)(row0 + ai * 128 + m * 16) * ZW + u.pn * 256 + 32 * wc + 4 * fq;
#pragma unroll
            for (int bj = 0; bj < 2; ++bj) {
              const f32x4 x1 = acc[ai][bj][m][0] * sc, x2 = acc[ai][bj][m][1] * sc;
              u32x2_ w1, w2; w1.x = pk2(x1[0], x1[1]); w1.y = pk2(x1[2], x1[3]); w2.x = pk2(x2[0], x2[1]); w2.y = pk2(x2[2], x2[3]);
              *(u32x2_*)(zp + bj * 128) = w1; *(u32x2_*)(zp + bj * 128 + 16) = w2;
            }
          }
      }
      return;
    }
    if (seg == 3 || seg == 4) {
      const float sc = (seg == 4) ? 0.125f : 1.f;
#pragma unroll
      for (int ai = 0; ai < 2; ++ai) {
        f32x4 tt[4][4];
#pragma unroll
        for (int m = 0; m < 4; ++m) {
          const float* rp = ROT + (size_t)(row0 + ai * 128 + m * 16) * 96 + 32 + 16 * fq;
          tt[m][0] = *(const f32x4*)rp; tt[m][1] = *(const f32x4*)(rp + 4); tt[m][2] = *(const f32x4*)(rp + 8); tt[m][3] = *(const f32x4*)(rp + 12);
        }
#pragma unroll
        for (int m = 0; m < 4; ++m) {
          f16* zp = Z + (size_t)(row0 + ai * 128 + m * 16) * ZW + u.pn * 256 + 64 * wc + 8 * fq;
          const f32x4 t0 = tt[m][0], t1 = tt[m][1], t2 = tt[m][2], t3 = tt[m][3];
          const float cs[8] = {t0[0], t0[2], t1[0], t1[2], t2[0], t2[2], t3[0], t3[2]}, sn[8] = {t0[1], t0[3], t1[1], t1[3], t2[1], t2[3], t3[1], t3[3]};
          float lo[8], hi[8];
#pragma unroll
          for (int n = 0; n < 2; ++n)
#pragma unroll
            for (int j = 0; j < 4; ++j) { const int e = 4 * n + j; const float x1 = acc[ai][0][m][n][j], x2 = acc[ai][1][m][n][j]; lo[e] = (x1 * cs[e] - x2 * sn[e]) * sc; hi[e] = (x1 * sn[e] + x2 * cs[e]) * sc; }
          u32x4_ wl, wh; wl.x = pk2(lo[0], lo[1]); wl.y = pk2(lo[2], lo[3]); wl.z = pk2(lo[4], lo[5]); wl.w = pk2(lo[6], lo[7]);
          wh.x = pk2(hi[0], hi[1]); wh.y = pk2(hi[2], hi[3]); wh.z = pk2(hi[4], hi[5]); wh.w = pk2(hi[6], hi[7]);
          *(u32x4_*)zp = wl; *(u32x4_*)(zp + 32) = wh;
        }
      }
      return;
    }
    f16* base = (seg == 8) ? KVM : Z; const long ld = (seg == 8) ? 1024 : ZW;
#pragma unroll
    for (int ai = 0; ai < 2; ++ai)
#pragma unroll
      for (int m = 0; m < 4; ++m) {
        f16* zp = base + (size_t)(row0 + ai * 128 + m * 16) * ld + u.pn * 256 + 32 * wc + 8 * fq;
#pragma unroll
        for (int bj = 0; bj < 2; ++bj) {
          f32x4 v0 = acc[ai][bj][m][0], v1 = acc[ai][bj][m][1];
          if (seg == 5) { v0 *= QSCALE; v1 *= QSCALE; }
          u32x4_ w; w.x = pk2(v0[0], v0[1]); w.y = pk2(v0[2], v0[3]); w.z = pk2(v1[0], v1[1]); w.w = pk2(v1[2], v1[3]);
          *(u32x4_*)(zp + bj * 128) = w;
        }
      }
  }
};
DI void phase_gemm1(const Params& p, char* smem) {
  Sched1 S; S.H = (const char*)p.out; S.W = p.ws + WS_WINT; S.MEMN = p.ws + WS_MEMN; S.WMEM = p.ws + WS_WMEMT; S.b = blockIdx.x; S.G = gridDim.x;
  Epi1 E; E.Z = (f16*)(p.ws + WS_Z); E.KVM = (f16*)(p.ws + WS_KVM); E.GATES = (float*)(p.ws + WS_GATES); E.ROT = (const float*)(p.ws + WS_ROT);
  gemm_stream((LAS unsigned char*)smem, 1024, 2048, 2048, S, E);
}

struct SchedOne {
  const char* A; const char* B; int pm, pn;
  DI bool next(int i, GUnit& u) const { if (i != 0) return false; u.A = A; u.B = B; u.pm = pm; u.pn = pn; u.seg = 8; u.bmode = 1; return true; }
};
DI void memkv_unit(const Params& p, int mt, int nt, char* smem) {
  SchedOne S; S.A = p.ws + WS_MEMN + (size_t)mt * 256 * 2048; S.B = p.ws + WS_WMEMT + (size_t)nt * 256 * 2048; S.pm = mt; S.pn = nt;
  Epi1 E; E.Z = (f16*)(p.ws + WS_Z); E.KVM = (f16*)(p.ws + WS_KVM); E.GATES = (float*)(p.ws + WS_GATES); E.ROT = (const float*)(p.ws + WS_ROT);
  gemm_stream((LAS unsigned char*)smem, 1024, 2048, 2048, S, E);
}

struct Sched2 {
  const char* A; const char* W; int b, G;
  DI bool next(int i, GUnit& u) const {
    int mt, nt;
    if (G == 256) { if (i >= 2) return false; const int xcd = b & 7, l = b >> 3; const int st = i * 8 + xcd; mt = st * 8 + (l & 7); nt = l >> 3; }
    else { const int L = i * G + b; if (L >= 512) return false; mt = L >> 2; nt = L & 3; }
    u.pm = mt; u.pn = nt; u.seg = 0; u.bmode = 1;
    u.A = A + (size_t)mt * 256 * ZW * 2; u.B = W + (size_t)nt * 256 * 4096;
    return true;
  }
};
struct Epi2 {
  f16* Y; float* PSS;
  DI void operator()(const f32x4 (&acc)[2][2][4][2], const GUnit& u, int wr, int wc, int fr, int fq) const {
    typedef unsigned u32x4_ __attribute__((ext_vector_type(4)));
    const int row0 = u.pm * 256 + wr * 64 + fr, col0 = u.pn * 256 + wc * 32 + 8 * fq;
#pragma unroll
    for (int ai = 0; ai < 2; ++ai)
#pragma unroll
      for (int m = 0; m < 4; ++m) {
        const int r = row0 + ai * 128 + m * 16;
        f16* yp = Y + (size_t)r * 1024 + col0; float ss = 0.f;
#pragma unroll
        for (int bj = 0; bj < 2; ++bj) {
          const f32x4 v0 = acc[ai][bj][m][0], v1 = acc[ai][bj][m][1];
          ss += (v0[0] * v0[0] + v0[1] * v0[1]) + (v0[2] * v0[2] + v0[3] * v0[3]) + (v1[0] * v1[0] + v1[1] * v1[1]) + (v1[2] * v1[2] + v1[3] * v1[3]);
          u32x4_ w; w.x = pk2(v0[0], v0[1]); w.y = pk2(v0[2], v0[3]); w.z = pk2(v1[0], v1[1]); w.w = pk2(v1[2], v1[3]);
          *(u32x4_*)(yp + bj * 128) = w;
        }
        ss += __shfl_xor(ss, 16); ss += __shfl_xor(ss, 32);
        if (fq == 0) PSS[(size_t)r * 16 + u.pn * 4 + wc] = ss;
      }
  }
};
DI void phase_gemm2(const Params& p, char* smem) {
  Sched2 S; S.A = p.ws + WS_Z + (size_t)ZC_GATE * 2; S.W = p.ws + WS_WOUTT; S.b = blockIdx.x; S.G = gridDim.x;
  Epi2 E; E.Y = (f16*)(p.ws + WS_Y); E.PSS = (float*)(p.ws + WS_PSS);
  gemm_stream((LAS unsigned char*)smem, 2048, (long)ZW * 2, 4096, S, E);
}

struct KCmpS { int k0; DI long operator()(int kt) const { const int k = kt + k0; return (long)(k >> 1) * ZW + (k & 1) * 64; } };
struct KStdS { int k0; DI long operator()(int kt) const { return (long)(kt + k0) * 64; } };
DI void unit_drain() { asm volatile("s_waitcnt vmcnt(0)" ::: "memory"); __syncthreads(); }
DI void publish_arrive(unsigned* ctr) {
  __builtin_amdgcn_fence(__ATOMIC_RELEASE, "agent");
  asm volatile("s_waitcnt vmcnt(0)" ::: "memory");
  __hip_atomic_fetch_add(ctr, 1u, __ATOMIC_RELAXED, __HIP_MEMORY_SCOPE_AGENT);
}
DI void wait_count(unsigned* ctr, unsigned target) {
  if (threadIdx.x == 0) {
    unsigned sp = 0;
    while (__hip_atomic_load(ctr, __ATOMIC_RELAXED, __HIP_MEMORY_SCOPE_AGENT) < target) { __builtin_amdgcn_s_sleep(2); if (++sp > (1u << 24)) break; }
    __builtin_amdgcn_fence(__ATOMIC_ACQUIRE, "agent");
    asm volatile("s_waitcnt vmcnt(0)" ::: "memory");
  }
  __syncthreads();
}
DI void csplit_unit(const Params& p, int kv, int b, int ks, char* smem) {
  int tid_ = threadIdx.x; asm volatile("" : "+v"(tid_)); const int tid = tid_, lane = tid & 63, wid = tid >> 6;
  const int lr = tid >> 3, lc = tid & 7;
  const char* Z = (const char*)(p.ws + WS_Z);
  const char* W1 = (const char*)(p.ws + WS_W1T) + (size_t)kv * 256 * 4096 * 2;
  const unsigned voffA = (unsigned)((lr & 31) * 16 * ZW * 2 + (lr >> 5) * 256 + lc * 16);
  const unsigned voffB = (unsigned)(lr * 8192 + lc * 16);
  f32x16 acc[4][2]; zero_acc(acc);
  KCmpS ka; ka.k0 = ks * 8; KStdS kb; kb.k0 = ks * 8;
  gemm_core(acc, Z + ((size_t)(b * NT) * ZW + ZC_KV + kv * 256) * 2, (long)32 * 16 * ZW * 2, voffA, W1, 64 * 8192, voffB, ka, kb, 8, smem);
  float* slab = p.out + (size_t)(((kv * 16 + b) * 8 + ks)) * 65536;
#pragma unroll
  for (int i = 0; i < 4; ++i)
#pragma unroll
    for (int j = 0; j < 2; ++j)
#pragma unroll
      for (int g = 0; g < 4; ++g) {
        f32x4 v; v[0] = acc[i][j][4 * g]; v[1] = acc[i][j][4 * g + 1]; v[2] = acc[i][j][4 * g + 2]; v[3] = acc[i][j][4 * g + 3];
        *(f32x4*)(slab + (size_t)((((wid * 4 + i) * 2 + j) * 4 + g) * 64 + lane) * 4) = v;
      }
  unit_drain();
}
DI void cfin_unit(const Params& p, int kv, int b, char* smem) {
  int tid_ = threadIdx.x; asm volatile("" : "+v"(tid_)); const int tid = tid_, lane = tid & 63, wid = tid >> 6, wn = wid & 3, l31 = lane & 31, h = lane >> 5;
  const int lr = tid >> 3, lc = tid & 7;
  f16* HID = (f16*)(p.ws + WS_HID) + (size_t)kv * 4096 * 256;
  wait_count((unsigned*)(p.ws + WS_CTR) + 16 + kv * 16 + b, 8u);
  {
    float* bias = (float*)(smem + 131072);
    if (tid < 256) { const float* PB1 = (const float*)(p.ws + WS_PB1) + kv * 16 * 256; float sacc = 0.f; for (int c = 0; c < 16; ++c) sacc += PB1[c * 256 + tid]; bias[tid] = sacc; }
    __syncthreads();
    f32x16 acc[4][2];
#pragma unroll
    for (int j = 0; j < 2; ++j)
#pragma unroll
      for (int r = 0; r < 16; ++r) { const float bv = bias[64 * wn + 32 * j + crow(r, h)]; acc[0][j][r] = bv; acc[1][j][r] = bv; acc[2][j][r] = bv; acc[3][j][r] = bv; }
    const float* slab0 = p.out + (size_t)((kv * 16 + b) * 8) * 65536;
#pragma unroll 1
    for (int ks = 0; ks < 8; ks += 2) {
      const float* slab = slab0 + (size_t)ks * 65536;
#pragma unroll
      for (int i = 0; i < 4; ++i) {
#pragma unroll
        for (int qh = 0; qh < 2; ++qh) {
          f32x4 tv[4], tw[4];
#pragma unroll
          for (int q = 0; q < 4; ++q) {
            const size_t o_ = (size_t)(((wid * 4 + i) * 8 + 4 * qh + q) * 64 + lane) * 4;
            tv[q] = *(const f32x4*)(slab + o_); tw[q] = *(const f32x4*)(slab + 65536 + o_);
          }
#pragma unroll
          for (int g = 0; g < 4; ++g) {
            acc[i][qh][4 * g] += tv[g][0] + tw[g][0]; acc[i][qh][4 * g + 1] += tv[g][1] + tw[g][1]; acc[i][qh][4 * g + 2] += tv[g][2] + tw[g][2]; acc[i][qh][4 * g + 3] += tv[g][3] + tw[g][3];
          }
        }
      }
    }
    __syncthreads();
    {
      const int wm = wid >> 2;
      char* img = smem + wid * (128 * 144);
#pragma unroll
      for (int i = 0; i < 4; ++i)
#pragma unroll
        for (int j = 0; j < 2; ++j)
#pragma unroll
          for (int g = 0; g < 4; ++g) {
            f16x4 v; v[0] = (f16)acc[i][j][4 * g]; v[1] = (f16)acc[i][j][4 * g + 1]; v[2] = (f16)acc[i][j][4 * g + 2]; v[3] = (f16)acc[i][j][4 * g + 3];
            *(f16x4*)(img + (32 * i + l31) * 144 + (32 * j + 8 * g + 4 * h) * 2) = v;
          }
      __syncthreads();
#pragma unroll 2
      for (int it = 0; it < 16; ++it) {
        const int row = it * 8 + (lane >> 3), ch = lane & 7;
        const int slot = 128 * wm + row; const int lrr = slot & 63, ii = slot >> 6;
        const int n = (lrr & 31) + 32 * ii, g = lrr >> 5;
        f16x8 v = *(const f16x8*)(img + row * 144 + ch * 16);
        v = XfGelu()(v, nullptr, 0, 0, 0);
        *(f16x8*)(HID + (size_t)(b * 256 + g * 128 + n) * 256 + 64 * wn + ch * 8) = v;
      }
      __syncthreads();
    }
  }
  __threadfence_block();
  __syncthreads();
  {
    const char* W2 = (const char*)(p.ws + WS_W2T) + (size_t)kv * 128 * 256 * 2;
    const unsigned voff = (unsigned)(lr * 512 + lc * 16);
    f32x16 acc[4][2]; zero_acc(acc);
    gemm_core(acc, (const char*)HID + (size_t)(b * 256) * 512, 64 * 512, voff, W2, 64 * 512, voff, KStd(), KStd(), 4, smem);
    if (l31 == 31) {
#pragma unroll
      for (int j = 0; j < 2; ++j)
#pragma unroll
        for (int r = 0; r < 16; ++r) acc[3][j][r] = 0.f;
    }
    f16* KC = (f16*)(p.ws + WS_KC) + (size_t)kv * 4096 * 128;
    store_tile_f16(acc, KC + (size_t)(b * 256) * 128, 128, smem, wn < 2, XfNone());
  }
  unit_drain();
}

struct KV128 { f16x8 k[2], v[2]; };
DI void kv_gload(KV128& r, const char* K, const char* V, unsigned voff, long ldb) {
  r.k[0] = *(const f16x8*)(K + (size_t)voff); r.k[1] = *(const f16x8*)(K + 32 * ldb + (size_t)voff);
  r.v[0] = *(const f16x8*)(V + (size_t)voff); r.v[1] = *(const f16x8*)(V + 32 * ldb + (size_t)voff);
}
DI void kv_lstore(const KV128& r, char* stage, unsigned so) {
  *(f16x8*)(stage + so) = r.k[0]; *(f16x8*)(stage + so + 8192) = r.k[1];
  *(f16x8*)(stage + 16384 + so) = r.v[0]; *(f16x8*)(stage + 16384 + so + 8192) = r.v[1];
}
DI void qk128(f32x16& p0, f32x16& p1, const char* Kst, const f16x8 (&qf)[8], unsigned kbe, unsigned kbo) {
  const f32x16 zero = {0.f, 0.f, 0.f, 0.f, 0.f, 0.f, 0.f, 0.f, 0.f, 0.f, 0.f, 0.f, 0.f, 0.f, 0.f, 0.f};
  f16x8 ka[4], kb[4];
#define QK_LD(dst, s0) do { dst[0] = *(const f16x8*)(Kst + kbe + 512 * ((s0) >> 1)); dst[1] = *(const f16x8*)(Kst + kbe + 512 * ((s0) >> 1) + 8192); \
    dst[2] = *(const f16x8*)(Kst + kbo + 512 * ((s0) >> 1)); dst[3] = *(const f16x8*)(Kst + kbo + 512 * ((s0) >> 1) + 8192); } while (0)
  QK_LD(ka, 0);
  QK_LD(kb, 2);
  p0 = MFMA(ka[0], qf[0], zero); p1 = MFMA(ka[1], qf[0], zero); p0 = MFMA(ka[2], qf[1], p0); p1 = MFMA(ka[3], qf[1], p1);
  QK_LD(ka, 4);
  p0 = MFMA(kb[0], qf[2], p0); p1 = MFMA(kb[1], qf[2], p1); p0 = MFMA(kb[2], qf[3], p0); p1 = MFMA(kb[3], qf[3], p1);
  QK_LD(kb, 6);
  p0 = MFMA(ka[0], qf[4], p0); p1 = MFMA(ka[1], qf[4], p1); p0 = MFMA(ka[2], qf[5], p0); p1 = MFMA(ka[3], qf[5], p1);
  p0 = MFMA(kb[0], qf[6], p0); p1 = MFMA(kb[1], qf[6], p1); p0 = MFMA(kb[2], qf[7], p0); p1 = MFMA(kb[3], qf[7], p1);
#undef QK_LD
  __builtin_amdgcn_sched_group_barrier(0x100, 8, 0);
  __builtin_amdgcn_sched_group_barrier(0x008, 4, 0);
  __builtin_amdgcn_sched_group_barrier(0x100, 4, 0);
  __builtin_amdgcn_sched_group_barrier(0x008, 4, 0);
  __builtin_amdgcn_sched_group_barrier(0x100, 4, 0);
  __builtin_amdgcn_sched_group_barrier(0x008, 8, 0);
}
DI f16x8 pack8(const f32x16& x, int s) {
  f16x8 r;
#pragma unroll
  for (int j = 0; j < 8; ++j) r[j] = (f16)x[8 * s + j];
  return r;
}
struct VFrag { f16x4 l0, h0, l1, h1, l2, h2, l3, h3; };
template <int DT> DI void pv_rd(VFrag& f, unsigned vb0, unsigned vb1) {
  f.l0 = tr_read<512 * DT>(vb0); f.h0 = tr_read<512 * DT + 2048>(vb1);
  f.l1 = tr_read<512 * DT + 4096>(vb0); f.h1 = tr_read<512 * DT + 4096 + 2048>(vb1);
  f.l2 = tr_read<512 * DT + 8192>(vb0); f.h2 = tr_read<512 * DT + 8192 + 2048>(vb1);
  f.l3 = tr_read<512 * DT + 12288>(vb0); f.h3 = tr_read<512 * DT + 12288 + 2048>(vb1);
}
DI void pv_mm(f32x16& od, const VFrag& f, const f16x8 (&pb)[4]) {
#define PK(L, H) (f16x8){L[0], L[1], L[2], L[3], H[0], H[1], H[2], H[3]}
  od = MFMA(PK(f.l0, f.h0), pb[0], od);
  od = MFMA(PK(f.l1, f.h1), pb[1], od);
  od = MFMA(PK(f.l2, f.h2), pb[2], od);
  od = MFMA(PK(f.l3, f.h3), pb[3], od);
#undef PK
}
DI void pv_tile(f32x16 (&o)[4], unsigned vb0, unsigned vb1, const f32x16& p0, const f32x16& p1) {
  f16x8 pb[4]; pb[0] = pack8(p0, 0); pb[1] = pack8(p0, 1); pb[2] = pack8(p1, 0); pb[3] = pack8(p1, 1);
  VFrag fa, fb;
  pv_rd<0>(fa, vb0, vb1);
  pv_rd<1>(fb, vb0, vb1);
  asm volatile("s_waitcnt lgkmcnt(8)" ::: "memory"); SBAR();
  pv_mm(o[0], fa, pb);
  pv_rd<2>(fa, vb0, vb1);
  asm volatile("s_waitcnt lgkmcnt(8)" ::: "memory"); SBAR();
  pv_mm(o[1], fb, pb);
  pv_rd<3>(fb, vb0, vb1);
  asm volatile("s_waitcnt lgkmcnt(8)" ::: "memory"); SBAR();
  pv_mm(o[2], fa, pb);
  asm volatile("s_waitcnt lgkmcnt(0)" ::: "memory"); SBAR();
  pv_mm(o[3], fb, pb);
}
DI void qk_exp(f32x16& n0, f32x16& n1, const char* Kst, const f16x8 (&qf)[8], unsigned kbe, unsigned kbo, f32x16& c0, f32x16& c1, float me, float& ps) {
  const f32x16 zero = {0.f, 0.f, 0.f, 0.f, 0.f, 0.f, 0.f, 0.f, 0.f, 0.f, 0.f, 0.f, 0.f, 0.f, 0.f, 0.f};
  f16x8 ka[4], kb[4];
#define QK_LD(dst, s0) do { dst[0] = *(const f16x8*)(Kst + kbe + 512 * ((s0) >> 1)); dst[1] = *(const f16x8*)(Kst + kbe + 512 * ((s0) >> 1) + 8192); \
    dst[2] = *(const f16x8*)(Kst + kbo + 512 * ((s0) >> 1)); dst[3] = *(const f16x8*)(Kst + kbo + 512 * ((s0) >> 1) + 8192); } while (0)
#define EXP8(c, b0) do { _Pragma("unroll") for (int j_ = 0; j_ < 8; ++j_) { c[(b0) + j_] = fexp2(c[(b0) + j_] - me); s_ += c[(b0) + j_]; } } while (0)
  float s_ = 0.f;
  QK_LD(ka, 0);
  n0 = MFMA(ka[0], qf[0], zero); n1 = MFMA(ka[1], qf[0], zero); n0 = MFMA(ka[2], qf[1], n0); n1 = MFMA(ka[3], qf[1], n1);
  QK_LD(kb, 2);
  EXP8(c0, 0);
  n0 = MFMA(kb[0], qf[2], n0); n1 = MFMA(kb[1], qf[2], n1); n0 = MFMA(kb[2], qf[3], n0); n1 = MFMA(kb[3], qf[3], n1);
  QK_LD(ka, 4);
  EXP8(c0, 8);
  n0 = MFMA(ka[0], qf[4], n0); n1 = MFMA(ka[1], qf[4], n1); n0 = MFMA(ka[2], qf[5], n0); n1 = MFMA(ka[3], qf[5], n1);
  QK_LD(kb, 6);
  EXP8(c1, 0);
  n0 = MFMA(kb[0], qf[6], n0); n1 = MFMA(kb[1], qf[6], n1); n0 = MFMA(kb[2], qf[7], n0); n1 = MFMA(kb[3], qf[7], n1);
  EXP8(c1, 8);
  ps = s_;
#undef QK_LD
}
DI void exp_only(f32x16& c0, f32x16& c1, float me, float& ps) {
  float s_ = 0.f;
  EXP8(c0, 0); EXP8(c0, 8); EXP8(c1, 0); EXP8(c1, 8);
  ps = s_;
#undef EXP8
}
DI void pv_max(f32x16 (&o)[4], unsigned vb0, unsigned vb1, const f32x16& p0, const f32x16& p1, const f32x16& n0, const f32x16& n1, float& pm) {
  f16x8 pb[4]; pb[0] = pack8(p0, 0); pb[1] = pack8(p0, 1); pb[2] = pack8(p1, 0); pb[3] = pack8(p1, 1);
  VFrag fa;
  float mx = n0[0];
  pv_rd<0>(fa, vb0, vb1);
  asm volatile("s_waitcnt lgkmcnt(0)" ::: "memory"); SBAR();
  pv_mm(o[0], fa, pb);
  pv_rd<1>(fa, vb0, vb1);
#pragma unroll
  for (int r = 1; r < 8; ++r) mx = fmaxf(mx, n0[r]);
  asm volatile("s_waitcnt lgkmcnt(0)" ::: "memory"); SBAR();
  pv_mm(o[1], fa, pb);
  pv_rd<2>(fa, vb0, vb1);
#pragma unroll
  for (int r = 8; r < 16; ++r) mx = fmaxf(mx, n0[r]);
  asm volatile("s_waitcnt lgkmcnt(0)" ::: "memory"); SBAR();
  pv_mm(o[2], fa, pb);
  pv_rd<3>(fa, vb0, vb1);
#pragma unroll
  for (int r = 0; r < 8; ++r) mx = fmaxf(mx, n1[r]);
  asm volatile("s_waitcnt lgkmcnt(0)" ::: "memory"); SBAR();
  pv_mm(o[3], fa, pb);
#pragma unroll
  for (int r = 8; r < 16; ++r) mx = fmaxf(mx, n1[r]);
  pm = mx;
}
DI float rowmax32(const f32x16& c0, const f32x16& c1) {
  float pm = c0[0];
#pragma unroll
  for (int r = 1; r < 16; ++r) pm = fmaxf(pm, c0[r]);
#pragma unroll
  for (int r = 0; r < 16; ++r) pm = fmaxf(pm, c1[r]);
  return xhalf_max(pm);
}
DI void osm_decide(float pmn, float& m, float& l, f32x16 (&o)[4]) {
  if (!__all(pmn - m <= THR)) {
    float mn = fmaxf(m, pmn); float alpha = fexp2(m - mn); m = mn; l *= alpha;
#pragma unroll
    for (int d = 0; d < 4; ++d)
#pragma unroll
      for (int r = 0; r < 16; ++r) o[d][r] *= alpha;
  }
}
DI void osm_step(f32x16& p0, f32x16& p1, float& m, float& l, f32x16 (&o)[4], bool sel = true) {
  float pm = p0[0];
#pragma unroll
  for (int r = 1; r < 16; ++r) pm = fmaxf(pm, p0[r]);
#pragma unroll
  for (int r = 0; r < 16; ++r) pm = fmaxf(pm, p1[r]);
  pm = xhalf_max(pm);
  pm = sel ? pm : NEG;
  if (!__all(pm - m <= THR)) {
    float mn = fmaxf(m, pm); float alpha = fexp2(m - mn); m = mn; l *= alpha;
#pragma unroll
    for (int d = 0; d < 4; ++d)
#pragma unroll
      for (int r = 0; r < 16; ++r) o[d][r] *= alpha;
  }
  const float me = sel ? m : 1e30f;
  float ps = 0.f;
#pragma unroll
  for (int r = 0; r < 16; ++r) { p0[r] = fexp2(p0[r] - me); ps += p0[r]; }
#pragma unroll
  for (int r = 0; r < 16; ++r) { p1[r] = fexp2(p1[r] - me); ps += p1[r]; }
  l += ps;
}
DI void zero_o(f32x16 (&o)[4]) {
#pragma unroll
  for (int d = 0; d < 4; ++d)
#pragma unroll
    for (int r = 0; r < 16; ++r) o[d][r] = 0.f;
}


DI void glds16(const char* g, LAS unsigned char* l) { __builtin_amdgcn_global_load_lds((const unsigned*)g, (LAS unsigned*)l, 16, 0, 0); }
DI unsigned dma_voff128(int wid, int lane, long ldb) {
  const int r3 = wid >> 1, c2 = ((wid & 1) << 1) | (lane >> 5), r7 = (lane >> 2) & 7, x = lane & 3;
  const int row = 8 * r3 + r7, rr = ((r7 >> 2) | ((r3 & 1) << 1)) & 3, ch = 4 * c2 + (x ^ rr);
  return (unsigned)(row * ldb + ch * 16);
}
DI unsigned dma_voff64(int wid, int lane, long ldb) {
  const int row = 8 * wid + (lane >> 3), c = (lane & 7) ^ ((row >> 1) & 7);
  return (unsigned)(row * ldb + c * 16);
}
DI void dma_kv128(LAS unsigned char* stage, unsigned ldsw, const char* K, const char* V, unsigned voff, long ldb) {
  glds16(K + (size_t)voff, stage + ldsw); glds16(K + 32 * ldb + (size_t)voff, stage + ldsw + 8192);
  glds16(V + (size_t)voff, stage + 16384 + ldsw); glds16(V + 32 * ldb + (size_t)voff, stage + 16384 + ldsw + 8192);
}
#define VWAIT(n) asm volatile("s_waitcnt vmcnt(" #n ")" ::: "memory")
DI void ring_wait4(int rem) {
  if (rem >= 3) VWAIT(12); else if (rem == 2) VWAIT(8); else if (rem == 1) VWAIT(4); else VWAIT(0);
}
DI void ring_wait3(int rem) {
  if (rem >= 3) VWAIT(9); else if (rem == 2) VWAIT(6); else if (rem == 1) VWAIT(3); else VWAIT(0);
}
DI void ring_bar() { asm volatile("s_waitcnt lgkmcnt(0)" ::: "memory"); __builtin_amdgcn_s_barrier(); asm volatile("" ::: "memory"); }

DI void nsa_unit(const Params& p, int b, int g, int qt, char* smem) {
  const int wid = __builtin_amdgcn_readfirstlane(threadIdx.x >> 6);
  int tid_ = threadIdx.x; asm volatile("" : "+v"(tid_)); const int tid = tid_, lane = tid & 63, l31 = lane & 31, h = lane >> 5;
  const int tl = 8 * wid + (l31 >> 2), rr = l31 & 3, head = 4 * g + rr;
  const int t = 64 * qt + tl;
  const unsigned row = (unsigned)(b * NT + t);
  char* Zc = p.ws + WS_Z;
  LAS unsigned char* lds = (LAS unsigned char*)smem;
  const unsigned ldsw = (unsigned)wid * 1024u;
  const char* KC = p.ws + WS_KC + (size_t)((b * 2 + g) * 128) * 256;
  const char* VC = KC + (size_t)4096 * 256;
  const unsigned cvo = dma_voff128(wid, lane, 256), zvo = dma_voff128(wid, lane, ZW * 2);
  const char* Zb = Zc + (size_t)b * NT * ZW * 2;
  const int cKs = ZC_KV + 512 + g * 128, cVs = ZC_KV + 768 + g * 128, cKw = ZC_KV + 1024 + g * 128, cVw = ZC_KV + 1280 + g * 128;
  const int nwin = (qt >= 8) ? 9 : (qt + 1);
  const int NTILE = 3 + qt + nwin;
#define NSA_ISSUE(n_) do { const int n__ = (n_); LAS unsigned char* st__ = lds + (n__ & 3) * 32768; \
    if (n__ < 2) dma_kv128(st__, ldsw, KC + n__ * 64 * 256, VC + n__ * 64 * 256, cvo, 256); \
    else if (n__ < 3 + qt) { const size_t ko__ = (size_t)(64 * (qt - (n__ - 2))) * ZW * 2; dma_kv128(st__, ldsw, Zb + ko__ + cKs * 2, Zb + ko__ + cVs * 2, zvo, ZW * 2); } \
    else { const size_t ko__ = (size_t)(64 * (qt - (n__ - 3 - qt))) * ZW * 2; dma_kv128(st__, ldsw, Zb + ko__ + cKw * 2, Zb + ko__ + cVw * 2, zvo, ZW * 2); } } while (0)
  f16x8 qf[8];
  {
    const char* qrow = Zc + (size_t)((row * ZW + ZC_QN + head * 128 + 8 * h) * 2u);
#pragma unroll
    for (int s = 0; s < 8; ++s) qf[s] = *(const f16x8*)(qrow + 32 * s);
  }
  f32x4 rt[4];
  { const float* rp = (const float*)(p.ws + WS_ROT) + (size_t)row * 96 + 16 * h;
#pragma unroll
    for (int i = 0; i < 4; ++i) rt[i] = *(const f32x4*)(rp + 4 * i); }
  float g0, g1, g2;
  { const float* gp = (const float*)(p.ws + WS_GATES) + (size_t)(row * 24u + head); g0 = gp[0]; g1 = gp[8]; g2 = gp[16]; }
  NSA_ISSUE(2);
  wait_count((unsigned*)(p.ws + WS_CTR) + 64 + b, 2u);
  NSA_ISSUE(0); NSA_ISSUE(1);
  int issued = 3;
  const unsigned kbe = 2048 * (l31 >> 3) + 64 * (l31 & 7) + 16 * ((h) ^ ((l31 >> 2) & 3));
  const unsigned kbo = 2048 * (l31 >> 3) + 64 * (l31 & 7) + 16 * ((2 + h) ^ ((l31 >> 2) & 3));
  const int q4 = (lane & 15) >> 2, p4 = lane & 3, blk = (lane >> 4) & 1;
  const unsigned sbase = (unsigned)(uintptr_t)smem;
  const unsigned vr0 = sbase + 16384 + 64 * (4 * h + q4) + 16 * ((2 * blk + (p4 >> 1)) ^ (h)) + 8 * (p4 & 1);
  const unsigned vr1 = sbase + 16384 + 64 * (4 * h + q4) + 16 * ((2 * blk + (p4 >> 1)) ^ (2 + h)) + 8 * (p4 & 1);
  char* otg = (char*)p.out + (size_t)(64u << 20) + (size_t)(((b * 2 + g) * 32 + qt)) * 65536 + tid * 16;
  f32x16 o[4];
  unsigned selmask;
  {
    ring_wait4(0); ring_bar();
    {
#pragma unroll
      for (int e = 0; e < 8; ++e) {
        const float cs = rt[e >> 1][2 * (e & 1)], sn = rt[e >> 1][2 * (e & 1) + 1];
        const float x1 = (float)qf[0][e], x2 = (float)qf[1][e];
        qf[0][e] = (f16)((x1 * cs - x2 * sn) * QSCALE); qf[1][e] = (f16)((x1 * sn + x2 * cs) * QSCALE);
      }
#pragma unroll
      for (int s = 2; s < 8; ++s)
#pragma unroll
        for (int e = 0; e < 8; ++e) qf[s][e] = (f16)((float)qf[s][e] * QSCALE);
    }
    f32x16 c0, c1, c2, c3;
    qk128(c0, c1, smem, qf, kbe, kbo);
    qk128(c2, c3, smem + 32768, qf, kbe, kbo);
    const int nmax = (t - 31) >> 4;
    float mx = NEG;
#pragma unroll
    for (int r = 0; r < 16; ++r) {
      const int n = crow(r, h);
      c0[r] = (n <= nmax) ? c0[r] : NEG; c1[r] = (n + 32 <= nmax) ? c1[r] : NEG; c2[r] = (n + 64 <= nmax) ? c2[r] : NEG; c3[r] = (n + 96 <= nmax) ? c3[r] : NEG;
      mx = fmaxf(mx, fmaxf(fmaxf(c0[r], c1[r]), fmaxf(c2[r], c3[r])));
    }
    mx = xhalf_max(mx);
    float ls = 0.f;
#pragma unroll
    for (int r = 0; r < 16; ++r) {
      c0[r] = (c0[r] > -1e29f) ? fexp2(c0[r] - mx) : 0.f; c1[r] = (c1[r] > -1e29f) ? fexp2(c1[r] - mx) : 0.f;
      c2[r] = (c2[r] > -1e29f) ? fexp2(c2[r] - mx) : 0.f; c3[r] = (c3[r] > -1e29f) ? fexp2(c3[r] - mx) : 0.f;
      ls += (c0[r] + c1[r]) + (c2[r] + c3[r]);
    }
    ls = xhalf_sum(ls);
    const float inv = (ls > 0.f) ? 1.f / ls : 0.f;
#pragma unroll
    for (int r = 0; r < 16; ++r) { c0[r] *= inv; c1[r] *= inv; c2[r] *= inv; c3[r] *= inv; }
    if (qt <= 15) {
      selmask = (1u << (qt + 1)) - 1u;
    } else {
      float av[16], cv[16];
#pragma unroll
      for (int k = 0; k < 4; ++k)
#pragma unroll
        for (int gg = 0; gg < 4; ++gg) {
          const f32x16& c = (k == 0) ? c0 : (k == 1) ? c1 : (k == 2) ? c2 : c3;
          float half3 = 0.5f * c[4 * gg + 3];
          av[4 * k + gg] = c[4 * gg] + c[4 * gg + 1] + c[4 * gg + 2] + half3; cv[4 * k + gg] = half3;
        }
      float imp[16];
#pragma unroll
      for (int i = 0; i < 16; ++i) {
        auto x2 = __builtin_amdgcn_permlane32_swap(__float_as_uint(cv[i]), __float_as_uint(cv[i]), false, false);
        float oc = h ? __uint_as_float(x2[0]) : __uint_as_float(x2[1]);
        cv[i] = oc;
      }
#pragma unroll
      for (int i = 0; i < 16; ++i) {
        float carry = h ? cv[i] : (i > 0 ? cv[i - 1] : 0.f);
        float v = av[i] + carry;
        v += __shfl_xor(v, 1); v += __shfl_xor(v, 2);
        imp[i] = v;
      }
      float* impL = (float*)(smem + 131072) + wid * 256;
      if (rr == 0) {
#pragma unroll
        for (int i = 0; i < 16; ++i) impL[(l31 >> 2) * 32 + 2 * i + h] = imp[i];
      }
      asm volatile("s_waitcnt lgkmcnt(0)" ::: "memory");
      __builtin_amdgcn_wave_barrier();
      const int sub = rr + 4 * h;
      const float* vrow = impL + (l31 >> 2) * 32;
      f32x4 mine = *(const f32x4*)(vrow + 4 * sub);
      int cnt[4] = {0, 0, 0, 0};
#pragma unroll 4
      for (int j2 = 1; j2 <= qt - 2; ++j2) {
        float w = vrow[j2];
#pragma unroll
        for (int e = 0; e < 4; ++e) { int j = 4 * sub + e; cnt[e] += (w > mine[e] || (w == mine[e] && j2 < j)) ? 1 : 0; }
      }
      unsigned nib = 0;
#pragma unroll
      for (int e = 0; e < 4; ++e) { int j = 4 * sub + e; if (j >= 1 && j <= qt - 2 && cnt[e] < 13) nib |= 1u << j; }
      nib |= (unsigned)__shfl_xor((int)nib, 1); nib |= (unsigned)__shfl_xor((int)nib, 2); nib |= (unsigned)__shfl_xor((int)nib, 32);
      selmask = nib | 1u | (1u << qt) | (1u << (qt - 1));
    }
    zero_o(o);
    pv_tile(o, vr0, vr1, c0, c1);
    pv_tile(o, vr0 + 32768, vr1 + 32768, c2, c3);
#pragma unroll
    for (int d = 0; d < 4; ++d)
#pragma unroll
      for (int g2_ = 0; g2_ < 2; ++g2_) {
        f16x8 v;
#pragma unroll
        for (int e = 0; e < 8; ++e) v[e] = (f16)(g0 * o[d][8 * g2_ + e]);
        *(f16x8*)(otg + (2 * d + g2_) * 8192) = v;
      }
  }
  f16x8 rv[8];
#define NSA_STEP(n_) do { ring_wait4(issued - 1 - (n_)); ring_bar(); while (issued <= (n_) + 2 && issued < NTILE) { NSA_ISSUE(issued); ++issued; } } while (0)
  float m, l = 0.f;
  zero_o(o);
  {
    const int na = 2, nb = 2 + qt;
    f32x16 c0, c1;
    NSA_STEP(na);
    qk128(c0, c1, smem + (na & 3) * 32768, qf, kbe, kbo);
    {
      int tlx = tl - 4 * h; asm volatile("" : "+v"(tlx));
#pragma unroll
      for (int r = 0; r < 16; ++r) { const int key = crow(r, 0); c0[r] = (key <= tlx) ? c0[r] : NEG; c1[r] = (key + 32 <= tlx) ? c1[r] : NEG; }
    }
    m = rowmax32(c0, c1);
    bool selc = true;
    f32x16 x0, x1;
#define SLC_STEP(C0, C1, X0, X1) do { \
      NSA_STEP(n + 1); \
      const float me = selc ? m : 1e30f; float ps, pmn; \
      qk_exp(X0, X1, smem + ((n + 1) & 3) * 32768, qf, kbe, kbo, C0, C1, me, ps); \
      l += ps; \
      pv_max(o, vr0 + (n & 3) * 32768, vr1 + (n & 3) * 32768, C0, C1, X0, X1, pmn); \
      const bool seln = (selmask >> (qt - (n + 1 - 2))) & 1u; \
      pmn = xhalf_max(pmn); pmn = seln ? pmn : NEG; \
      osm_decide(pmn, m, l, o); \
      selc = seln; } while (0)
    int n = na;
    for (; n + 1 < nb; n += 2) { SLC_STEP(c0, c1, x0, x1); ++n; SLC_STEP(x0, x1, c0, c1); --n; }
    if (n < nb) { SLC_STEP(c0, c1, x0, x1); c0 = x0; c1 = x1; }
#undef SLC_STEP
#pragma unroll
    for (int k = 0; k < 8; ++k) rv[k] = *(const f16x8*)(otg + k * 8192);
    { const float me = selc ? m : 1e30f; float ps; exp_only(c0, c1, me, ps); l += ps; pv_tile(o, vr0 + (nb & 3) * 32768, vr1 + (nb & 3) * 32768, c0, c1); }
  }
  {
    float lt = xhalf_sum(l); float sc = g1 / lt;
#pragma unroll
    for (int d = 0; d < 4; ++d)
#pragma unroll
      for (int g2_ = 0; g2_ < 2; ++g2_) {
        f16x8 v = rv[2 * d + g2_];
#pragma unroll
        for (int e = 0; e < 8; ++e) v[e] = (f16)((float)v[e] + sc * o[d][8 * g2_ + e]);
        *(f16x8*)(otg + (2 * d + g2_) * 8192) = v;
      }
  }
  f16* mp = (f16*)(Zc + (size_t)((row * ZW + ZC_GATE + head * 128 + 4 * h) * 2u));
  f16x8 pvs[8]; f16x4 gts[16];
  l = 0.f; zero_o(o);
  {
    const int na = 3 + qt, nb = NTILE - 1;
    f32x16 c0, c1;
    NSA_STEP(na);
    qk128(c0, c1, smem + (na & 3) * 32768, qf, kbe, kbo);
    {
      int tlx = tl - 4 * h; asm volatile("" : "+v"(tlx));
#pragma unroll
      for (int r = 0; r < 16; ++r) { const int key = crow(r, 0); c0[r] = (key <= tlx) ? c0[r] : NEG; c1[r] = (key + 32 <= tlx) ? c1[r] : NEG; }
    }
    m = rowmax32(c0, c1);
    f32x16 x0, x1;
#define WIN_STEP(C0, C1, X0, X1) do { \
      NSA_STEP(n + 1); \
      float ps, pmn; \
      qk_exp(X0, X1, smem + ((n + 1) & 3) * 32768, qf, kbe, kbo, C0, C1, m, ps); \
      l += ps; \
      pv_max(o, vr0 + (n & 3) * 32768, vr1 + (n & 3) * 32768, C0, C1, X0, X1, pmn); \
      pmn = xhalf_max(pmn); \
      osm_decide(pmn, m, l, o); } while (0)
    int n = na;
    for (; n + 1 < nb; n += 2) { WIN_STEP(c0, c1, x0, x1); ++n; WIN_STEP(x0, x1, c0, c1); --n; }
    if (n < nb) { WIN_STEP(c0, c1, x0, x1); c0 = x0; c1 = x1; }
#undef WIN_STEP
    if (nwin == 9) {
      int tlx = tl - 4 * h; asm volatile("" : "+v"(tlx));
#pragma unroll
      for (int r = 0; r < 16; ++r) { const int key = crow(r, 0); c0[r] = (key > tlx) ? c0[r] : NEG; c1[r] = (key + 32 > tlx) ? c1[r] : NEG; }
    }
#pragma unroll
    for (int i = 0; i < 8; ++i) pvs[i] = *(const f16x8*)(otg + i * 8192);
#pragma unroll
    for (int i = 0; i < 16; ++i) gts[i] = *(const f16x4*)(mp + 32 * (i >> 2) + 8 * (i & 3));
    { float ps; exp_only(c0, c1, m, ps); l += ps; pv_tile(o, vr0 + (nb & 3) * 32768, vr1 + (nb & 3) * 32768, c0, c1); }
  }
#undef NSA_STEP
#undef NSA_ISSUE
  const float scw = g2 / xhalf_sum(l);
#pragma unroll
  for (int d = 0; d < 4; ++d)
#pragma unroll
    for (int g2_ = 0; g2_ < 2; ++g2_) {
      const f16x8 pv = pvs[2 * d + g2_];
#pragma unroll
      for (int q = 0; q < 2; ++q) {
        const int gg = 2 * g2_ + q;
        const f16x4 gt = gts[4 * d + gg]; f16x4 v;
#pragma unroll
        for (int e = 0; e < 4; ++e) v[e] = (f16)(((float)pv[4 * q + e] + scw * o[d][4 * gg + e]) * siluf_((float)gt[e]));
        *(f16x4*)(mp + 32 * d + 8 * gg) = v;
      }
    }
  ring_bar();
}

DI void mem_unit(const Params& p, int b, int hm, int half, char* smem) {
  const int wid = __builtin_amdgcn_readfirstlane(threadIdx.x >> 6);
  int tid_ = threadIdx.x; asm volatile("" : "+v"(tid_)); const int tid = tid_, lane = tid & 63, l31 = lane & 31, h = lane >> 5;
  f16* Z = (f16*)(p.ws + WS_Z);
  LAS unsigned char* lds = (LAS unsigned char*)smem;
  const unsigned ldsw = (unsigned)wid * 1024u;
  const char* Kb = p.ws + WS_KVM + ((size_t)(b * 256) * 1024 + hm * 128) * 2;
  const char* Vb = Kb + 1024;
  const unsigned kvo = dma_voff128(wid, lane, 2048);
  const size_t row0 = (size_t)b * NT + 1024 * half + 32 * wid + l31;
  wait_count((unsigned*)(p.ws + WS_CTR) + 80 + b, 4u);
  f16x8 qa[8], qb[8];
#define MEM_QLOAD(Q, i_) do { const f16* qrow = Z + (row0 + 256 * (i_)) * ZW + ZC_QM + hm * 128 + 8 * h; \
    _Pragma("unroll") for (int s = 0; s < 8; ++s) Q[s] = *(const f16x8*)(qrow + 16 * s); } while (0)
  MEM_QLOAD(qa, 0);
#pragma unroll
  for (int i = 0; i < 4; ++i) dma_kv128(lds + i * 32768, ldsw, Kb + (size_t)(64 * i) * 2048, Vb + (size_t)(64 * i) * 2048, kvo, 2048);
  const unsigned kbe = 2048 * (l31 >> 3) + 64 * (l31 & 7) + 16 * ((h) ^ ((l31 >> 2) & 3));
  const unsigned kbo = 2048 * (l31 >> 3) + 64 * (l31 & 7) + 16 * ((2 + h) ^ ((l31 >> 2) & 3));
  const int q4 = (lane & 15) >> 2, p4 = lane & 3, blk = (lane >> 4) & 1;
  const unsigned sbase = (unsigned)(uintptr_t)smem;
  const unsigned vr0 = sbase + 16384 + 64 * (4 * h + q4) + 16 * ((2 * blk + (p4 >> 1)) ^ (h)) + 8 * (p4 & 1);
  const unsigned vr1 = sbase + 16384 + 64 * (4 * h + q4) + 16 * ((2 * blk + (p4 >> 1)) ^ (2 + h)) + 8 * (p4 & 1);
  asm volatile("s_waitcnt vmcnt(0)" ::: "memory");
  ring_bar();
#define MEM_QTILE(Q, QN, i_) do { \
    f16* mp = Z + (row0 + 256 * (i_)) * ZW + ZC_GATE + 1536 + hm * 128 + 4 * h; \
    f16x4 gts[16]; \
    _Pragma("unroll") for (int i = 0; i < 16; ++i) gts[i] = *(const f16x4*)(mp + 32 * (i >> 2) + 8 * (i & 3)); \
    if ((i_) + 1 < 4) MEM_QLOAD(QN, (i_) + 1); \
    f32x16 o[4]; zero_o(o); \
    float m = NEG, l = 0.f; \
    _Pragma("unroll 1") for (int kt = 0; kt < 4; ++kt) { \
      f32x16 p0, p1; \
      qk128(p0, p1, smem + kt * 32768, Q, kbe, kbo); \
      osm_step(p0, p1, m, l, o); \
      pv_tile(o, vr0 + kt * 32768, vr1 + kt * 32768, p0, p1); \
    } \
    const float inv = 1.f / xhalf_sum(l); \
    _Pragma("unroll") for (int d = 0; d < 4; ++d) \
      _Pragma("unroll") for (int gg = 0; gg < 4; ++gg) { \
        const f16x4 gt = gts[4 * d + gg]; f16x4 v; \
        _Pragma("unroll") for (int e = 0; e < 4; ++e) v[e] = (f16)(o[d][4 * gg + e] * inv * siluf_((float)gt[e])); \
        *(f16x4*)(mp + 32 * d + 8 * gg) = v; \
      } } while (0)
#pragma unroll 1
  for (int i2 = 0; i2 < 4; i2 += 2) { MEM_QTILE(qa, qb, i2); MEM_QTILE(qb, qa, i2 + 1); }
#undef MEM_QTILE
#undef MEM_QLOAD
  ring_bar();
}

DI void ret_qk(f32x16& n0, f32x16& n1, const char* stg, const f16x8 (&qf)[4], int l31, int h, int xx) {
  const f32x16 zero = {0.f, 0.f, 0.f, 0.f, 0.f, 0.f, 0.f, 0.f, 0.f, 0.f, 0.f, 0.f, 0.f, 0.f, 0.f, 0.f};
#pragma unroll
  for (int s = 0; s < 4; ++s) {
    const unsigned cxs = (unsigned)(((2 * s + h) ^ xx) << 4);
    const f16x8 k0 = *(const f16x8*)(stg + l31 * 128 + cxs);
    const f16x8 k1 = *(const f16x8*)(stg + (l31 + 32) * 128 + cxs);
    n0 = MFMA(k0, qf[s], s == 0 ? zero : n0); n1 = MFMA(k1, qf[s], s == 0 ? zero : n1);
  }
}
DI void ret_qk_decay(f32x16& n0, f32x16& n1, const char* stg, const f16x8 (&qf)[4], int l31, int h, int xx, f32x16& c0, f32x16& c1, const float (&fac)[16], float base, float e32) {
  const f32x16 zero = {0.f, 0.f, 0.f, 0.f, 0.f, 0.f, 0.f, 0.f, 0.f, 0.f, 0.f, 0.f, 0.f, 0.f, 0.f, 0.f};
  const float base1 = base * e32;
#pragma unroll
  for (int s = 0; s < 4; ++s) {
    const unsigned cxs = (unsigned)(((2 * s + h) ^ xx) << 4);
    const f16x8 k0 = *(const f16x8*)(stg + l31 * 128 + cxs);
    const f16x8 k1 = *(const f16x8*)(stg + (l31 + 32) * 128 + cxs);
    n0 = MFMA(k0, qf[s], s == 0 ? zero : n0); n1 = MFMA(k1, qf[s], s == 0 ? zero : n1);
#pragma unroll
    for (int j = 0; j < 4; ++j) { const int r = 4 * s + j; c0[r] *= base * fac[r]; c1[r] *= base1 * fac[r]; }
  }
}
DI void ret_decay(f32x16& c0, f32x16& c1, const float (&fac)[16], float base, float e32) {
  const float base1 = base * e32;
#pragma unroll
  for (int r = 0; r < 16; ++r) { c0[r] *= base * fac[r]; c1[r] *= base1 * fac[r]; }
}
DI void ret_unit(const Params& p, int b, int hr, int tq, char* smem) {
  const int wid = __builtin_amdgcn_readfirstlane(threadIdx.x >> 6);
  int tid_ = threadIdx.x; asm volatile("" : "+v"(tid_)); const int tid = tid_, lane = tid & 63, l31 = lane & 31, h = lane >> 5;
  const int t = 256 * tq + 32 * wid + l31;
  const size_t row = (size_t)b * NT + t;
  f16* Z = (f16*)(p.ws + WS_Z);
  LAS unsigned char* lds = (LAS unsigned char*)smem;
  const unsigned ldsw = (unsigned)wid * 1024u;
  const char* Kb = p.ws + WS_Z + ((size_t)b * NT * ZW + ZC_KR + hr * 64) * 2;
  const char* Vb = p.ws + WS_Z + ((size_t)b * NT * ZW + ZC_VR + hr * 128) * 2;
  const unsigned kvo = dma_voff64(wid, lane, ZW * 2), vvo = dma_voff128(wid, lane, ZW * 2);
  const int ntile = 4 * (tq + 1);
#define RET_ISSUE(n_) do { const int n__ = (n_); LAS unsigned char* st__ = lds + (n__ & 3) * 32768; const size_t ko__ = (size_t)(64 * n__) * ZW * 2; \
    glds16(Kb + ko__ + (size_t)kvo, st__ + ldsw); glds16(Vb + ko__ + (size_t)vvo, st__ + 16384 + ldsw); glds16(Vb + ko__ + (size_t)32 * ZW * 2 + (size_t)vvo, st__ + 16384 + ldsw + 8192); } while (0)
#define RET_STEP(n_) do { ring_wait3(issued - 1 - (n_)); ring_bar(); while (issued <= (n_) + 2 && issued < ntile) { RET_ISSUE(issued); ++issued; } } while (0)
  RET_ISSUE(0); RET_ISSUE(1); RET_ISSUE(2);
  int issued = 3;
  f16x8 qf[4];
  {
    const f16* qrow = Z + row * ZW + ZC_QR + hr * 64 + 8 * h;
#pragma unroll
    for (int s = 0; s < 4; ++s) qf[s] = *(const f16x8*)(qrow + 16 * s);
  }
  const float lg = log2f(1.f - exp2f(-5.f - (float)hr));
  float fac[16];
#pragma unroll
  for (int r = 0; r < 16; ++r) fac[r] = fexp2(-lg * (float)crow(r, h));
  const float e32 = fexp2(-lg * 32.f);
  const int xx = (l31 >> 1) & 7;
  const int q4 = (lane & 15) >> 2, p4 = lane & 3, blk = (lane >> 4) & 1;
  const unsigned sbase = (unsigned)(uintptr_t)smem;
  const unsigned vr0 = sbase + 16384 + 64 * (4 * h + q4) + 16 * ((2 * blk + (p4 >> 1)) ^ (h)) + 8 * (p4 & 1);
  const unsigned vr1 = sbase + 16384 + 64 * (4 * h + q4) + 16 * ((2 * blk + (p4 >> 1)) ^ (2 + h)) + 8 * (p4 & 1);
  f32x16 o[4]; zero_o(o);
  const int mykt = 4 * tq + (wid >> 1);
  const int tlw = 32 * (wid & 1) + l31;
  f32x16 c0, c1, x0, x1;
  RET_STEP(0);
  ret_qk(c0, c1, smem, qf, l31, h, xx);
#define RET_BODY(C0, C1, X0, X1) do { \
    RET_STEP(kt + 1); \
    if (kt <= mykt) { \
      const float base = fexp2(lg * (float)(t - 64 * kt)); \
      if (kt < mykt) ret_qk_decay(X0, X1, smem + ((kt + 1) & 3) * 32768, qf, l31, h, xx, C0, C1, fac, base, e32); \
      else { \
        ret_decay(C0, C1, fac, base, e32); \
        int tlx = tlw - 4 * h; asm volatile("" : "+v"(tlx)); \
        _Pragma("unroll") for (int r = 0; r < 16; ++r) { const int key = crow(r, 0); C0[r] = (key <= tlx) ? C0[r] : 0.f; C1[r] = (key + 32 <= tlx) ? C1[r] : 0.f; } \
      } \
      pv_tile(o, vr0 + (kt & 3) * 32768, vr1 + (kt & 3) * 32768, C0, C1); \
    } } while (0)
  int kt = 0;
  for (; kt + 2 < ntile; kt += 2) { RET_BODY(c0, c1, x0, x1); ++kt; RET_BODY(x0, x1, c0, c1); --kt; }
  if (kt + 1 < ntile) { RET_BODY(c0, c1, x0, x1); c0 = x0; c1 = x1; ++kt; }
  if (kt <= mykt) {
    const float base = fexp2(lg * (float)(t - 64 * kt));
    ret_decay(c0, c1, fac, base, e32);
    int tlx = tlw - 4 * h; asm volatile("" : "+v"(tlx));
#pragma unroll
    for (int r = 0; r < 16; ++r) { const int key = crow(r, 0); c0[r] = (key <= tlx) ? c0[r] : 0.f; c1[r] = (key + 32 <= tlx) ? c1[r] : 0.f; }
    pv_tile(o, vr0 + (kt & 3) * 32768, vr1 + (kt & 3) * 32768, c0, c1);
  }
#undef RET_BODY
#undef RET_STEP
#undef RET_ISSUE
  f16* mp = Z + row * ZW + ZC_GATE + 1024 + hr * 128 + 4 * h;
  const float* gn = p.ret_gn + hr * 128 + 4 * h;
  f16x4 gts[16]; f32x4 gvs[16];
#pragma unroll
  for (int i = 0; i < 16; ++i) { gts[i] = *(const f16x4*)(mp + 32 * (i >> 2) + 8 * (i & 3)); gvs[i] = *(const f32x4*)(gn + 32 * (i >> 2) + 8 * (i & 3)); }
  float s1 = 0.f;
#pragma unroll
  for (int d = 0; d < 4; ++d)
#pragma unroll
    for (int r = 0; r < 16; ++r) s1 += o[d][r];
  s1 = xhalf_sum(s1);
  const float mu = s1 * (1.f / 128.f);
  float s2 = 0.f;
#pragma unroll
  for (int d = 0; d < 4; ++d)
#pragma unroll
    for (int r = 0; r < 16; ++r) { float c = o[d][r] - mu; s2 += c * c; }
  s2 = xhalf_sum(s2);
  const float rstd = rsqrtf(s2 * (1.f / 128.f) + 1e-6f);
#pragma unroll
  for (int d = 0; d < 4; ++d)
#pragma unroll
    for (int gg = 0; gg < 4; ++gg) {
      const f16x4 gt = gts[4 * d + gg]; const f32x4 gv = gvs[4 * d + gg]; f16x4 v;
#pragma unroll
      for (int e = 0; e < 4; ++e) v[e] = (f16)((o[d][4 * gg + e] - mu) * rstd * gv[e] * siluf_((float)gt[e]));
      *(f16x4*)(mp + 32 * d + 8 * gg) = v;
    }
  ring_bar();
}

constexpr int ATTN_UNITS = 288 + 64 + 512 + 128 + 1024;
DI unsigned* attn_dispatch(const Params& p, int u, char* smem) {
  int kind, a0, a1;
  if (u < 256) { kind = 3; a0 = u >> 5; a1 = u & 31; }
  else if (u < 288) { kind = 4; a0 = 0; a1 = u - 256; }
  else if (u < 352) { kind = 6; a0 = (u - 288) & 3; a1 = (u - 288) >> 2; }
  else {
    const int v = u - 352;
    if (v < 512) { kind = 1; a0 = 7 - (v >> 6); a1 = v & 63; }
    else if (v < 640) { const int w = v - 512; kind = 2; a0 = w >> 6; a1 = w & 63; }
    else { const int w = v - 640; kind = 0; a0 = 31 - (w >> 5); a1 = w & 31; }
  }
  unsigned* ctrs = (unsigned*)(p.ws + WS_CTR);
  unsigned* pend = nullptr;
  if (p.dry > 1) { const int kb = (kind == 0) ? 2 : (kind == 1) ? 4 : (kind == 2) ? 8 : 16; if (!(p.dry & kb)) return nullptr; }
  if (kind == 0) nsa_unit(p, a1 >> 1, a1 & 1, a0, smem);
  else if (kind == 1) ret_unit(p, a1 >> 2, a1 & 3, a0, smem);
  else if (kind == 2) mem_unit(p, a1 >> 2, a1 & 3, a0, smem);
  else if (kind == 6) { memkv_unit(p, a1, a0, smem); unit_drain(); pend = ctrs + 80 + a1; }
  else if (kind == 3) { csplit_unit(p, a1 >> 4, a1 & 15, a0, smem); pend = ctrs + 16 + a1; }
  else { cfin_unit(p, a1 >> 4, a1 & 15, smem); pend = ctrs + 64 + (a1 & 15); }
  return pend;
}

DI void phase_attn(const Params& p, char* smem, int ulo, int uhi, int cidx) {
  unsigned* ctr = (unsigned*)(p.ws + WS_CTR) + cidx;
  int* su = (int*)(smem + LDS_IMG + 16);
  unsigned* pend = nullptr;
  int nextu = 0;
  if (threadIdx.x == 0) nextu = ulo + (int)blockIdx.x;
  for (;;) {
    if (threadIdx.x == 0) {
      if (pend) publish_arrive(pend);
      *su = nextu;
    }
    __syncthreads();
    const int u = *su;
    __syncthreads();
    if (u >= uhi) { pend = nullptr; break; }
    if (threadIdx.x == 0) nextu = ulo + (int)gridDim.x + (int)atomicAdd(ctr, 1u);
    pend = attn_dispatch(p, u, smem);
  }
}

DI void phase_final(const Params& p) {
  int tid_ = threadIdx.x; asm volatile("" : "+v"(tid_));
  const int tid = tid_ & 511, lane = tid & 63, wid = __builtin_amdgcn_readfirstlane(tid >> 6);
  const float* PSS = (const float*)(p.ws + WS_PSS);
  const int G = gridDim.x;
  f32x4 g[4];
#pragma unroll
  for (int i = 0; i < 4; ++i) g[i] = *(const f32x4*)(p.norm_post + (i >> 1) * 512 + lane * 8 + 4 * (i & 1));
#define FIN_LOAD(Y, X, S, u_) do { const int row_ = (u_) * 8 + wid; \
    S = (lane < 16) ? PSS[(size_t)row_ * 16 + lane] : 0.f; \
    const f16* yi_ = (const f16*)(p.ws + WS_Y) + (size_t)row_ * 1024; const float* xi_ = p.x + (size_t)row_ * 1024; \
    Y[0] = *(const f16x8*)(yi_ + lane * 8); Y[1] = *(const f16x8*)(yi_ + 512 + lane * 8); \
    _Pragma("unroll") for (int i = 0; i < 4; ++i) X[i] = *(const f32x4*)(xi_ + (i >> 1) * 512 + lane * 8 + 4 * (i & 1)); } while (0)
#define FIN_ROW(Y, X, S, u_) do { float ss_ = S; \
    _Pragma("unroll") for (int o = 8; o >= 1; o >>= 1) ss_ += __shfl_xor(ss_, o); \
    ss_ = __shfl(ss_, 0); \
    const float rstd_ = rsqrtf(ss_ * (1.f / 1024.f) + 1e-6f); \
    float* yo_ = p.out + (size_t)((u_) * 8 + wid) * 1024; \
    _Pragma("unroll") for (int i = 0; i < 4; ++i) { const f16x8& y_ = Y[i >> 1]; const int q_ = i & 1; f32x4 r_; \
      r_[0] = X[i][0] + (float)y_[4 * q_] * rstd_ * g[i][0]; r_[1] = X[i][1] + (float)y_[4 * q_ + 1] * rstd_ * g[i][1]; \
      r_[2] = X[i][2] + (float)y_[4 * q_ + 2] * rstd_ * g[i][2]; r_[3] = X[i][3] + (float)y_[4 * q_ + 3] * rstd_ * g[i][3]; \
      *(f32x4*)(yo_ + (i >> 1) * 512 + lane * 8 + 4 * q_) = r_; } } while (0)
  f16x8 ya[2], yb[2]; f32x4 xa[4], xb[4]; float sa = 0.f, sb = 0.f;
  int u = blockIdx.x;
  if (u < NTOK / 8) FIN_LOAD(ya, xa, sa, u);
  while (u < NTOK / 8) {
    { const int un = u + G; if (un < NTOK / 8) FIN_LOAD(yb, xb, sb, un); FIN_ROW(ya, xa, sa, u); u = un; }
    if (u >= NTOK / 8) break;
    { const int un = u + G; if (un < NTOK / 8) FIN_LOAD(ya, xa, sa, un); FIN_ROW(yb, xb, sb, u); u = un; }
  }
#undef FIN_LOAD
#undef FIN_ROW
}

#define XB_TMO      128
#define XB_XCNT(j)  (256  + 64 * (j))
#define XB_XSUB(j)  (1280 + 64 * (j))
#define XB_XGEN(j)  (2304 + 64 * (j))
#define XB_TOP      3328
#define XB_TOPGEN   3392
#define XCD_BAR_WORDS 3456
#define XB_SPIN_CAP (1u << 22)
DI unsigned xb_ld(unsigned* p) { return __hip_atomic_load(p, __ATOMIC_RELAXED, __HIP_MEMORY_SCOPE_AGENT); }
DI unsigned xb_add(unsigned* p, unsigned v) { return __hip_atomic_fetch_add(p, v, __ATOMIC_RELAXED, __HIP_MEMORY_SCOPE_AGENT); }
DI unsigned xb_xcc_id() { return (unsigned)__builtin_amdgcn_s_getreg((3 << 11) | 20) & 0xFu; }
#define XB_SPIN(cond, bar) do { unsigned _sp = 0; while (cond) { __builtin_amdgcn_s_sleep(1); \
    if ((++_sp & 255u) == 0u) { if (xb_ld(&(bar)[XB_TMO])) break; if (_sp > XB_SPIN_CAP) { atomicAdd(&(bar)[XB_TMO], 1u); break; } } } } while (0)
struct XcdBarrier { unsigned* bar; unsigned x; volatile LAS unsigned* st; };
DI XcdBarrier xcd_barrier_post(unsigned* bar, volatile LAS unsigned* st) {
  XcdBarrier b; b.bar = bar; b.x = xb_xcc_id(); b.st = st;
  if (threadIdx.x == 0) (void)xb_add(&bar[XB_XCNT(b.x)], 1u);
  return b;
}
DI void xcd_barrier_complete(unsigned* bar, unsigned x, unsigned& nloc, unsigned& nx) {
  const unsigned G = gridDim.x * gridDim.y * gridDim.z;
  unsigned sum, cnt, mine, sp = 0u;
  for (;;) {
    sum = 0u; cnt = 0u; mine = 0u;
#pragma unroll
    for (unsigned j = 0; j < 16; ++j) { const unsigned c = xb_ld(&bar[XB_XCNT(j)]); sum += c; cnt += (c > 0u) ? 1u : 0u; mine = (j == x) ? c : mine; }
    if (sum == G) break;
    __builtin_amdgcn_s_sleep(1);
    if ((++sp & 255u) == 0u) { if (xb_ld(&bar[XB_TMO])) break; if (sp > XB_SPIN_CAP) { atomicAdd(&bar[XB_TMO], 1u); break; } }
  }
  nloc = mine > 0u ? mine : 1u; nx = cnt > 0u ? cnt : 1u;
}
DI void xcd_barrier(const XcdBarrier& b) {
  asm volatile("s_waitcnt vmcnt(0)" ::: "memory");
  __syncthreads();
  if (threadIdx.x == 0) {
    unsigned* bar = b.bar;
    __builtin_amdgcn_s_waitcnt(0);
    unsigned nloc = b.st[0], nx = b.st[1];
    if (nloc == 0u) { xcd_barrier_complete(bar, b.x, nloc, nx); b.st[0] = nloc; b.st[1] = nx; }
    const unsigned old = xb_add(&bar[XB_XSUB(b.x)], 1u);
    const unsigned gen = old / nloc;
    if (old + 1u == (gen + 1u) * nloc) {
      __builtin_amdgcn_fence(__ATOMIC_RELEASE, "agent");
      asm volatile("s_waitcnt vmcnt(0)" ::: "memory");
      const unsigned og = xb_add(&bar[XB_TOP], 1u);
      const unsigned tg = og / nx;
      if (og + 1u == (tg + 1u) * nx) xb_add(&bar[XB_TOPGEN], 1u);
      else XB_SPIN(xb_ld(&bar[XB_TOPGEN]) == tg, bar);
      __builtin_amdgcn_fence(__ATOMIC_ACQUIRE, "agent");
      xb_add(&bar[XB_XGEN(b.x)], 1u);
      asm volatile("s_waitcnt vmcnt(0)" ::: "memory");
    } else {
      XB_SPIN(xb_ld(&bar[XB_XGEN(b.x)]) == gen, bar);
      __builtin_amdgcn_fence(__ATOMIC_ACQUIRE, "agent");
      asm volatile("s_waitcnt vmcnt(0)" ::: "memory");
    }
  }
  __syncthreads();
}

template <int PH>
__global__ void __launch_bounds__(512, 2) hybrid_kernel(Params p) {
  __shared__ __attribute__((aligned(16))) char smem[LDS_BYTES];
  if (PH == -1) {
    unsigned* bar = (unsigned*)(p.ws + WS_BAR);
    volatile LAS unsigned* xst = (volatile LAS unsigned*)(smem + LDS_IMG);
    if (threadIdx.x == 0) { xst[0] = 0u; xst[1] = 0u; }
    __syncthreads();
    XcdBarrier xb = xcd_barrier_post(bar, xst);
    phase_prep(p, smem); xcd_barrier(xb);
    phase_gemm1(p, smem); xcd_barrier(xb);
    phase_attn(p, smem, 0, ATTN_UNITS, 0); xcd_barrier(xb);
    phase_gemm2(p, smem); xcd_barrier(xb);
    phase_final(p);
  } else {
    if (PH == 0) phase_prep(p, smem);
    if (PH == 1) phase_gemm1(p, smem);
    if (PH == 3) phase_attn(p, smem, 0, ATTN_UNITS, 0);
    if (PH == 4) phase_gemm2(p, smem);
    if (PH == 5) phase_final(p);
  }
}

extern "C" void kernel_launch(void* const* d_in, const int* in_sizes, int n_in, void* d_out, int out_size, void* d_ws, size_t ws_size, hipStream_t stream) {
  if (ws_size < WS_END) { fprintf(stderr, "kernel_launch: workspace too small: %zu < %zu\n", ws_size, (size_t)WS_END); return; }
  Params p{};
  p.x = (const float*)d_in[0]; p.mem = (const float*)d_in[1]; p.pos = (const int*)d_in[2]; p.norm_pre = (const float*)d_in[3]; p.w_in = (const float*)d_in[4];
  p.cpk = (const float*)d_in[5]; p.w1k = (const float*)d_in[6]; p.w2k = (const float*)d_in[7]; p.cpv = (const float*)d_in[8]; p.w1v = (const float*)d_in[9]; p.w2v = (const float*)d_in[10];
  p.ret_gn = (const float*)d_in[11]; p.mem_norm = (const float*)d_in[12]; p.w_mem_kv = (const float*)d_in[13]; p.w_out = (const float*)d_in[14]; p.norm_post = (const float*)d_in[15];
  p.out = (float*)d_out; p.ws = (char*)d_ws;
#if MEGA
  static int grid_blocks = 0;
  if (!grid_blocks) {
    int dev = 0, cus = 0, per_cu = 0;
    hipGetDevice(&dev); hipDeviceGetAttribute(&cus, hipDeviceAttributeMultiprocessorCount, dev);
    hipOccupancyMaxActiveBlocksPerMultiprocessor(&per_cu, hybrid_kernel<-1>, 512, 0);
    if (per_cu < 1) { fprintf(stderr, "kernel_launch: occupancy query returned %d\n", per_cu); return; }
    grid_blocks = cus;
  }
  (void)hipMemsetAsync(p.ws + WS_CTR, 0, WS_Y - WS_CTR, stream);
  hipLaunchKernelGGL(hybrid_kernel<-1>, dim3(grid_blocks), dim3(512), 0, stream, p);
  hipError_t e = hipGetLastError();
  if (e != hipSuccess) fprintf(stderr, "launch failed: %s (grid %d)\n", hipGetErrorString(e), grid_blocks);
#else
  hipLaunchKernelGGL(hybrid_kernel<0>, dim3(256), dim3(512), 0, stream, p);
  if (PROBE_DUP == 0) hipLaunchKernelGGL(hybrid_kernel<0>, dim3(256), dim3(512), 0, stream, p);
  hipLaunchKernelGGL(hybrid_kernel<1>, dim3(256), dim3(512), 0, stream, p);
  if (PROBE_DUP == 1) hipLaunchKernelGGL(hybrid_kernel<1>, dim3(256), dim3(512), 0, stream, p);
  hipLaunchKernelGGL(hybrid_kernel<3>, dim3(256), dim3(512), 0, stream, p);
  if (PROBE_DUP == 3) { Params q = p; q.dry = PROBE_ATT; (void)hipMemsetAsync(p.ws + WS_CTR, 0, 4, stream); hipLaunchKernelGGL(hybrid_kernel<3>, dim3(256), dim3(512), 0, stream, q); }
  hipLaunchKernelGGL(hybrid_kernel<4>, dim3(256), dim3(512), 0, stream, p);
  if (PROBE_DUP == 4) hipLaunchKernelGGL(hybrid_kernel<4>, dim3(256), dim3(512), 0, stream, p);
  hipLaunchKernelGGL(hybrid_kernel<5>, dim3(256), dim3(512), 0, stream, p);
#endif
}
```

```cpp
#include <hip/hip_runtime.h>
#include <hip/hip_cooperative_groups.h>
#include <cstdio>
#include <cstdint>
namespace cg = cooperative_groups;

#ifndef MEGA
#define MEGA 1
#endif
#ifndef PROBE_DUP
#define PROBE_DUP -1
#endif
#ifndef PROBE_ATT
#define PROBE_ATT 1
#endif

typedef _Float16 f16;
typedef _Float16 f16x8 __attribute__((ext_vector_type(8)));
typedef _Float16 f16x4 __attribute__((ext_vector_type(4)));
typedef float f32x16 __attribute__((ext_vector_type(16)));
typedef float f32x4 __attribute__((ext_vector_type(4)));
#define DI __device__ __forceinline__
#define MFMA(a, b, c) __builtin_amdgcn_mfma_f32_32x32x16_f16((a), (b), (c), 0, 0, 0)
#define SBAR() __builtin_amdgcn_sched_barrier(0)
#define LAS __attribute__((address_space(3)))

constexpr int NB = 16, NT = 2048, DM = 1024, NTOK = NB * NT, ZW = 6144;
constexpr int ZC_QN = 0, ZC_KV = 1024, ZC_QR = 2560, ZC_KR = 2816, ZC_VR = 3072, ZC_QM = 3584, ZC_GATE = 4096;
constexpr float QSCALE = 0.08838834764831845f * 1.4426950408889634f;
constexpr float THR = 8.f;
constexpr float NEG = -1e30f;

constexpr size_t al256(size_t x) { return (x + 255) / 256 * 256; }
constexpr size_t WS_Z = 0;
constexpr size_t WS_GATES = WS_Z + (size_t)NTOK * ZW * 2;
constexpr size_t WS_WINT = WS_GATES + (size_t)NTOK * 24 * 4;
constexpr size_t WS_WOUTT = WS_WINT + al256((size_t)6168 * 1024 * 2);
constexpr size_t WS_WMEMT = WS_WOUTT + (size_t)1024 * 2048 * 2;
constexpr size_t WS_W1T = WS_WMEMT + (size_t)1024 * 1024 * 2;
constexpr size_t WS_W2T = WS_W1T + (size_t)2 * 256 * 4096 * 2;
constexpr size_t WS_MEMN = WS_W2T + (size_t)2 * 128 * 256 * 2;
constexpr size_t WS_KVM = WS_MEMN + (size_t)4096 * 1024 * 2;
constexpr size_t WS_ROT = WS_KVM + (size_t)4096 * 1024 * 2;
constexpr size_t WS_PB1 = WS_ROT + (size_t)NTOK * 48 * 2 * 4;
constexpr size_t WS_HID = WS_PB1 + (size_t)2 * 16 * 256 * 4;
constexpr size_t WS_KC = WS_HID + (size_t)2 * 4096 * 256 * 2;
constexpr size_t WS_PSS = WS_KC + (size_t)2 * 4096 * 128 * 2;
constexpr size_t WS_CTR = WS_PSS + (size_t)NTOK * 16 * 4;
constexpr size_t WS_BAR = WS_CTR + 4096;
constexpr size_t WS_Y = WS_BAR + 16384;
constexpr size_t WS_END = WS_Y + (size_t)NTOK * 1024 * 2;

constexpr int LDS_IMG = 8 * 128 * 144;
constexpr int LDS_BYTES = LDS_IMG + 64;

struct Params {
  const float* x; const float* mem; const int* pos; const float* norm_pre; const float* w_in;
  const float* cpk; const float* w1k; const float* w2k; const float* cpv; const float* w1v; const float* w2v;
  const float* ret_gn; const float* mem_norm; const float* w_mem_kv; const float* w_out; const float* norm_post;
  float* out; char* ws;
  int dry;
  int pad_;
};

DI int crow(int r, int h) { return (r & 3) + 8 * (r >> 2) + 4 * h; }
DI unsigned swz128(int r, int c) { return (unsigned)(r * 128 + ((c ^ ((r >> 1) & 7)) << 4)); }
DI unsigned off_a(int row, int ch) { return (unsigned)(2048 * (row >> 3) + 512 * (ch >> 2) + 64 * (row & 7) + 16 * ((ch & 3) ^ ((row >> 2) & 3))); }
DI float xhalf_max(float v) { auto rr = __builtin_amdgcn_permlane32_swap(__float_as_uint(v), __float_as_uint(v), false, false); return fmaxf(__uint_as_float(rr[0]), __uint_as_float(rr[1])); }
DI float xhalf_sum(float v) { auto rr = __builtin_amdgcn_permlane32_swap(__float_as_uint(v), __float_as_uint(v), false, false); return __uint_as_float(rr[0]) + __uint_as_float(rr[1]); }
DI float fexp2(float x) { return __builtin_amdgcn_exp2f(x); }
DI float sigmoidf_(float x) { return __builtin_amdgcn_rcpf(1.f + __expf(-x)); }
DI float siluf_(float x) { return x * __builtin_amdgcn_rcpf(1.f + __expf(-x)); }
DI float gelu_tanh(float x) { float u = 0.7978845608028654f * (x + 0.044715f * x * x * x); float e = __expf(2.f * u); float t = 1.f - 2.f / (e + 1.f); return 0.5f * x * (1.f + t); }
template <int OFF> DI f16x4 tr_read(unsigned addr) { f16x4 r; asm volatile("ds_read_b64_tr_b16 %0, %1 offset:%2" : "=&v"(r) : "v"(addr), "i"(OFF) : "memory"); return r; }

struct TrU { const float* src; f16* dst; int N, ldd, k0, n0, remap; };
DI void tr_decode(const Params& p, int u, TrU& t) {
  char* ws = p.ws;
  int kt, nt; t.remap = 0;
  if (u < 1552) { t.src = p.w_in; t.N = 6168; t.dst = (f16*)(ws + WS_WINT); t.ldd = 1024; kt = u / 97; nt = u - kt * 97; t.remap = 1; }
  else if (u < 2064) { u -= 1552; t.src = p.w_out; t.N = 1024; t.dst = (f16*)(ws + WS_WOUTT); t.ldd = 2048; kt = u >> 4; nt = u & 15; }
  else if (u < 2320) { u -= 2064; t.src = p.w_mem_kv; t.N = 1024; t.dst = (f16*)(ws + WS_WMEMT); t.ldd = 1024; kt = u >> 4; nt = u & 15; }
  else if (u < 2832) { u -= 2320; const int kv = u >> 8, v = u & 255; t.src = kv ? p.w1v : p.w1k; t.N = 256; t.dst = (f16*)(ws + WS_W1T) + (size_t)kv * 256 * 4096; t.ldd = 4096; kt = v >> 2; nt = v & 3; }
  else { u -= 2832; const int kv = u >> 3, v = u & 7; t.src = kv ? p.w2v : p.w2k; t.N = 128; t.dst = (f16*)(ws + WS_W2T) + (size_t)kv * 128 * 256; t.ldd = 256; kt = v >> 1; nt = v & 1; }
  t.k0 = kt * 64; t.n0 = nt * 64;
}
DI void tr_load(const TrU& t, float (&v)[8], int tid) {
#pragma unroll
  for (int i = 0; i < 8; ++i) { const int e = tid + 512 * i, kk = e >> 6, nn = e & 63; const int n = min(t.n0 + nn, t.N - 1); v[i] = t.src[(size_t)(t.k0 + kk) * t.N + n]; }
}
constexpr int N_TR_UNITS = 2848;

#define MFMA16(a, b, c) __builtin_amdgcn_mfma_f32_16x16x32_f16((a), (b), (c), 0, 0, 0)
DI void phase_prep(const Params& p, char* smem) {
  const int tid = threadIdx.x, lane = tid & 63, wid = tid >> 6;
  const int G = gridDim.x;
  char* ws = p.ws;
  if (blockIdx.x == 0 && tid < 128) ((unsigned*)(ws + WS_CTR))[tid] = 0u;
  {
    LAS unsigned char* lds_ = (LAS unsigned char*)smem;
    {
      float wv[48];
#pragma unroll
      for (int i = 0; i < 48; ++i) { const int e = tid + 512 * i, k = e / 24, n = e - 24 * k; wv[i] = p.w_in[(size_t)k * 6168 + 2560 + n]; }
#pragma unroll
      for (int i = 0; i < 48; ++i) { const int e = tid + 512 * i, k = e / 24, n = e - 24 * k; *(LAS f16*)(lds_ + 32768 + n * 2064 + k * 2) = (f16)wv[i]; }
    }
    for (int e = tid; e < 8 * 1032; e += 512) { const int n = 24 + e / 1032, k = e % 1032; *(LAS f16*)(lds_ + 32768 + n * 2064 + k * 2) = (f16)0.f; }
    __syncthreads();
  }
  {
    float* tile = (float*)smem;
    int u = blockIdx.x; TrU t; float v[8];
    if (u < N_TR_UNITS) { tr_decode(p, u, t); tr_load(t, v, tid); }
    while (u < N_TR_UNITS) {
#pragma unroll
      for (int i = 0; i < 8; ++i) { const int e = tid + 512 * i; tile[(e >> 6) * 65 + (e & 63)] = v[i]; }
      __syncthreads();
      TrU tn = t; const int un = u + G;
      if (un < N_TR_UNITS) { tr_decode(p, un, tn); tr_load(tn, v, tid); }
#pragma unroll
      for (int i = 0; i < 4; ++i) {
        const int e = tid + 512 * i, nn = e >> 5, kk = (e & 31) * 2; const int n = t.n0 + nn;
        if (n < t.N) {
          int nd = n;
          if (t.remap) nd = (n < 2560) ? n : ((n < 2584) ? (6144 + n - 2560) : (n - 24));
          typedef _Float16 h2 __attribute__((ext_vector_type(2)));
          h2 w; w[0] = (f16)tile[kk * 65 + nn]; w[1] = (f16)tile[(kk + 1) * 65 + nn];
          *(h2*)(t.dst + (size_t)nd * t.ldd + t.k0 + kk) = w;
        }
      }
      __syncthreads();
      t = tn; u = un;
    }
  }
  f16* H = (f16*)p.out; f16* MEMN = (f16*)(ws + WS_MEMN);
#define RMS_ROW(V, DST) do { float ss_ = 0.f; \
      _Pragma("unroll") for (int i = 0; i < 4; ++i) ss_ += V[i][0] * V[i][0] + V[i][1] * V[i][1] + V[i][2] * V[i][2] + V[i][3] * V[i][3]; \
      _Pragma("unroll") for (int o = 32; o >= 1; o >>= 1) ss_ += __shfl_xor(ss_, o); \
      const float rstd_ = rsqrtf(ss_ * (1.f / 1024.f) + 1e-6f); \
      _Pragma("unroll") for (int i = 0; i < 4; ++i) { f16x4 o4; o4[0] = (f16)(V[i][0] * rstd_ * gn[i][0]); o4[1] = (f16)(V[i][1] * rstd_ * gn[i][1]); o4[2] = (f16)(V[i][2] * rstd_ * gn[i][2]); o4[3] = (f16)(V[i][3] * rstd_ * gn[i][3]); \
        *(f16x4*)((DST) + i * 256 + lane * 4) = o4; } } while (0)
#define RMS_LOAD(V, SRC) do { _Pragma("unroll") for (int i = 0; i < 4; ++i) V[i] = *(const f32x4*)((SRC) + i * 256 + lane * 4); } while (0)
  {
    f32x4 gn[4];
#pragma unroll
    for (int i = 0; i < 4; ++i) gn[i] = *(const f32x4*)(p.norm_pre + i * 256 + lane * 4);
    f32x4 va[4], vb[4], na[4], nb[4];
    float* GATES = (float*)(ws + WS_GATES);
    LAS unsigned char* lds_ = (LAS unsigned char*)smem;
    const int fr = lane & 15, fq = lane >> 4;
    for (int gi = blockIdx.x; gi < NTOK / 128; gi += G) {
      const int rowbase = 128 * gi + 16 * wid;
      { const float* s0 = p.x + (size_t)rowbase * 1024; RMS_LOAD(va, s0); RMS_LOAD(vb, s0 + 1024); }
#define RMS_STEP(CA, CB, NA, NB, j_) do { \
        if ((j_) + 1 < 8) { const float* s0 = p.x + (size_t)(rowbase + 2 * ((j_) + 1)) * 1024; RMS_LOAD(NA, s0); RMS_LOAD(NB, s0 + 1024); } \
        f16* d0 = H + (size_t)(rowbase + 2 * (j_)) * 1024; \
        RMS_ROW(CA, d0); RMS_ROW(CB, d0 + 1024); } while (0)
#pragma unroll 1
      for (int j = 0; j < 8; j += 2) { RMS_STEP(va, vb, na, nb, j); RMS_STEP(na, nb, va, vb, j + 1); }
#undef RMS_STEP
      asm volatile("s_waitcnt vmcnt(0)" ::: "memory");
      const f16* hrow = H + (size_t)(rowbase + fr) * 1024 + 8 * fq;
      f32x4 g0 = {0.f, 0.f, 0.f, 0.f}, g1 = {0.f, 0.f, 0.f, 0.f};
#pragma unroll 1
      for (int k0 = 0; k0 < 32; k0 += 16) {
        f16x8 af[16];
#pragma unroll
        for (int k = 0; k < 16; ++k) af[k] = *(const f16x8*)(hrow + 32 * (k0 + k));
#pragma unroll
        for (int k = 0; k < 16; ++k) {
          const f16x8 b0 = *(const LAS f16x8*)(lds_ + 32768 + fr * 2064 + (32 * (k0 + k) + 8 * fq) * 2);
          const f16x8 b1 = *(const LAS f16x8*)(lds_ + 32768 + (16 + fr) * 2064 + (32 * (k0 + k) + 8 * fq) * 2);
          g0 = MFMA16(b0, af[k], g0); g1 = MFMA16(b1, af[k], g1);
        }
      }
      float* gp = GATES + (size_t)(rowbase + fr) * 24 + 4 * fq;
#pragma unroll
      for (int j = 0; j < 4; ++j) { g0[j] = sigmoidf_(g0[j]); g1[j] = sigmoidf_(g1[j]); }
      *(f32x4*)gp = g0;
      if (fq < 2) *(f32x4*)(gp + 16) = g1;
    }
  }
  {
    f32x4 gn[4];
#pragma unroll
    for (int i = 0; i < 4; ++i) gn[i] = *(const f32x4*)(p.mem_norm + i * 256 + lane * 4);
    for (int u = blockIdx.x; u < 4096 / 8; u += G) {
      f32x4 va[4]; const int row = u * 8 + wid;
      RMS_LOAD(va, p.mem + (size_t)row * 1024);
      RMS_ROW(va, MEMN + (size_t)row * 1024);
    }
  }
#undef RMS_ROW
#undef RMS_LOAD
  float* ROT = (float*)(ws + WS_ROT);
  for (int e = blockIdx.x * 512 + tid; e < NTOK * 48; e += G * 512) {
    int tok = e / 48, f = e - tok * 48;
    float invf;
    if (f < 16) invf = exp2f(-((float)f / 16.f) * 18.931568569324174f);
    else invf = exp2f(-((float)(f - 16) / 32.f) * 13.287712379549449f);
    const float ang = (float)p.pos[tok] * invf;
    float sn, cs; sincosf(ang, &sn, &cs);
    ROT[(size_t)e * 2] = cs; ROT[(size_t)e * 2 + 1] = sn;
  }
  float* PB1 = (float*)(ws + WS_PB1);
  for (int u = G - 1 - (int)blockIdx.x; u < 32; u += G) {
    const int kv = u >> 4, ch = u & 15; const float* w1 = kv ? p.w1v : p.w1k; const float* cp = kv ? p.cpv : p.cpk;
    const int i0 = ch * 256 + wid * 32;
    f32x4 acc = {0.f, 0.f, 0.f, 0.f};
#pragma unroll 16
    for (int i = 0; i < 32; ++i) { const float c = cp[i0 + i]; const f32x4 w = *(const f32x4*)(w1 + (size_t)(i0 + i) * 256 + lane * 4); acc[0] += c * w[0]; acc[1] += c * w[1]; acc[2] += c * w[2]; acc[3] += c * w[3]; }
    float* red = (float*)smem;
    *(f32x4*)(red + wid * 256 + lane * 4) = acc;
    __syncthreads();
    if (tid < 256) { float sacc = 0.f;
#pragma unroll
      for (int w = 0; w < 8; ++w) sacc += red[w * 256 + tid];
      PB1[(kv * 16 + ch) * 256 + tid] = sacc; }
    __syncthreads();
  }
}

template <class KA, class KB>
DI void gemm_core(f32x16 (&acc)[4][2], const char* baseA, long strideA, unsigned voffA, const char* baseB, long strideB, unsigned voffB,
                  KA koffA, KB koffB, int nk, char* smem) {
  int tid_ = threadIdx.x; asm volatile("" : "+v"(tid_)); const int tid = tid_, lane = tid & 63, wid = tid >> 6, wm = wid >> 2, wn = wid & 3;
  const int lr = tid >> 3, lc = tid & 7;
  const unsigned so = swz128(lr, lc);
  f16x8 ra[4], rb[4], sa[4], sb[4];
#define GLOAD(RA, RB, kt) do { const char* a_ = baseA + koffA(kt) * 2; const char* b_ = baseB + koffB(kt) * 2; \
    RA[0] = *(const f16x8*)(a_ + (size_t)voffA); RA[1] = *(const f16x8*)(a_ + strideA + (size_t)voffA); RA[2] = *(const f16x8*)(a_ + 2 * strideA + (size_t)voffA); RA[3] = *(const f16x8*)(a_ + 3 * strideA + (size_t)voffA); \
    RB[0] = *(const f16x8*)(b_ + (size_t)voffB); RB[1] = *(const f16x8*)(b_ + strideB + (size_t)voffB); RB[2] = *(const f16x8*)(b_ + 2 * strideB + (size_t)voffB); RB[3] = *(const f16x8*)(b_ + 3 * strideB + (size_t)voffB); } while (0)
#define LSTORE(RA, RB, st) do { char* b_ = smem + (st) * 65536 + so; \
    *(f16x8*)(b_) = RA[0]; *(f16x8*)(b_ + 8192) = RA[1]; *(f16x8*)(b_ + 16384) = RA[2]; *(f16x8*)(b_ + 24576) = RA[3]; \
    *(f16x8*)(b_ + 32768) = RB[0]; *(f16x8*)(b_ + 32768 + 8192) = RB[1]; *(f16x8*)(b_ + 32768 + 16384) = RB[2]; *(f16x8*)(b_ + 32768 + 24576) = RB[3]; } while (0)
  const int l31 = lane & 31, h = lane >> 5, xx = (l31 >> 1) & 7;
  const unsigned fbase = l31 * 128;
  unsigned cx[4];
#pragma unroll
  for (int s = 0; s < 4; ++s) cx[s] = (unsigned)(((2 * s + h) ^ xx) << 4);
#define COMPUTE(kt) do { \
      const char* A = smem + ((kt) & 1) * 65536 + (128 * wm) * 128 + fbase; \
      const char* Bm = smem + ((kt) & 1) * 65536 + 32768 + (64 * wn) * 128 + fbase; \
      _Pragma("unroll") for (int s = 0; s < 4; ++s) { \
        f16x8 hf[4], wf[2]; \
        _Pragma("unroll") for (int i = 0; i < 4; ++i) hf[i] = *(const f16x8*)(A + i * 4096 + cx[s]); \
        _Pragma("unroll") for (int j = 0; j < 2; ++j) wf[j] = *(const f16x8*)(Bm + j * 4096 + cx[s]); \
        _Pragma("unroll") for (int i = 0; i < 4; ++i) _Pragma("unroll") for (int j = 0; j < 2; ++j) acc[i][j] = MFMA(wf[j], hf[i], acc[i][j]); \
      } } while (0)
  GLOAD(ra, rb, 0); GLOAD(sa, sb, 1);
  LSTORE(ra, rb, 0); __syncthreads();
  for (int kt = 0; kt < nk; kt += 2) {
    if (kt + 2 < nk) GLOAD(ra, rb, kt + 2);
    COMPUTE(kt);
    LSTORE(sa, sb, 1);
    __syncthreads();
    if (kt + 3 < nk) GLOAD(sa, sb, kt + 3);
    COMPUTE(kt + 1);
    if (kt + 2 < nk) LSTORE(ra, rb, 0);
    __syncthreads();
  }
#undef GLOAD
#undef LSTORE
#undef COMPUTE
}

template <class XF>
DI void store_tile_f16(const f32x16 (&acc)[4][2], f16* dst, long ld, char* smem, bool active, XF xf) {
  int tid_ = threadIdx.x; asm volatile("" : "+v"(tid_)); const int tid = tid_, lane = tid & 63, wid = tid >> 6, wm = wid >> 2, wn = wid & 3, l31 = lane & 31, h = lane >> 5;
  char* img = smem + wid * (128 * 144);
#pragma unroll
  for (int i = 0; i < 4; ++i)
#pragma unroll
    for (int j = 0; j < 2; ++j)
#pragma unroll
      for (int g = 0; g < 4; ++g) {
        f16x4 v; v[0] = (f16)acc[i][j][4 * g]; v[1] = (f16)acc[i][j][4 * g + 1]; v[2] = (f16)acc[i][j][4 * g + 2]; v[3] = (f16)acc[i][j][4 * g + 3];
        *(f16x4*)(img + (32 * i + l31) * 144 + (32 * j + 8 * g + 4 * h) * 2) = v;
      }
  __syncthreads();
  if (active) {
    f16* d = dst + (long)(128 * wm) * ld + 64 * wn;
#pragma unroll 2
    for (int it = 0; it < 16; ++it) {
      const int row = it * 8 + (lane >> 3), ch = lane & 7;
      const char* rowp = img + row * 144;
      f16x8 v = *(const f16x8*)(rowp + ch * 16);
      v = xf(v, rowp, 128 * wm + row, wn, ch);
      *(f16x8*)(d + (long)row * ld + ch * 8) = v;
    }
  }
  __syncthreads();
}
struct XfNone { DI f16x8 operator()(f16x8 v, const char*, int, int, int) const { return v; } };
struct XfGelu { DI f16x8 operator()(f16x8 v, const char*, int, int, int) const { f16x8 r;
#pragma unroll
  for (int e = 0; e < 8; ++e) r[e] = (f16)gelu_tanh((float)v[e]);
  return r; } };
struct XfZ {
  int seg; const float* rot;
  DI f16x8 operator()(f16x8 v, const char* rowp, int trow, int wn, int ch) const {
    f16x8 r = v;
    if (seg == 6) {
#pragma unroll
      for (int e = 0; e < 8; ++e) r[e] = (f16)siluf_((float)v[e]);
    } else if (seg == 0 || seg == 1) {
      float sc = (seg == 0) ? QSCALE : 1.f;
      if (((wn & 1) == 0) && ch < 4) {
        const f16x8 pv = *(const f16x8*)(rowp + (ch ^ 2) * 16);
        const float* rp = rot + (size_t)trow * 96 + 16 * (ch & 1);
        const bool first = ch < 2;
#pragma unroll
        for (int e2 = 0; e2 < 4; ++e2) {
          const f32x4 cs = *(const f32x4*)(rp + 4 * e2);
#pragma unroll
          for (int q = 0; q < 2; ++q) {
            const int e = 2 * e2 + q; const float c = cs[2 * q], sn = cs[2 * q + 1];
            const float x1 = first ? (float)v[e] : (float)pv[e], x2 = first ? (float)pv[e] : (float)v[e];
            r[e] = (f16)((first ? (x1 * c - x2 * sn) : (x1 * sn + x2 * c)) * sc);
          }
        }
      } else {
#pragma unroll
        for (int e = 0; e < 8; ++e) r[e] = (f16)((float)v[e] * sc);
      }
    } else if (seg == 3 || seg == 4) {
      const float sc = (seg == 4) ? 0.125f : 1.f;
      const f16x8 pv = *(const f16x8*)(rowp + (ch ^ 4) * 16);
      const float* rp = rot + (size_t)trow * 96 + 32 + 16 * (ch & 3);
      const bool first = ch < 4;
#pragma unroll
      for (int e2 = 0; e2 < 4; ++e2) {
        const f32x4 cs = *(const f32x4*)(rp + 4 * e2);
#pragma unroll
        for (int q = 0; q < 2; ++q) {
          const int e = 2 * e2 + q; const float c = cs[2 * q], sn = cs[2 * q + 1];
          const float x1 = first ? (float)v[e] : (float)pv[e], x2 = first ? (float)pv[e] : (float)v[e];
          r[e] = (f16)((first ? (x1 * c - x2 * sn) : (x1 * sn + x2 * c)) * sc);
        }
      }
    } else if (seg == 5) {
#pragma unroll
      for (int e = 0; e < 8; ++e) r[e] = (f16)((float)v[e] * QSCALE);
    }
    return r;
  }
};

struct KStd { DI long operator()(int kt) const { return (long)kt * 64; } };
struct KCmp { DI long operator()(int kt) const { return (long)(kt >> 1) * ZW + (kt & 1) * 64; } };

DI void zero_acc(f32x16 (&acc)[4][2]) {
#pragma unroll
  for (int i = 0; i < 4; ++i)
#pragma unroll
    for (int j = 0; j < 2; ++j)
#pragma unroll
      for (int r = 0; r < 16; ++r) acc[i][j][r] = 0.f;
}


constexpr int HTB = 128 * 64 * 2;
DI int lds_byte(int r, int c) { const int st = (r >> 4) * 2 + (c >> 5), rr = r & 15, cc = c & 31, ob = rr * 64 + cc * 2; return st * 1024 + (ob ^ (((ob >> 9) & 1) << 5)); }
DI void stage_rc(int b, int& R, int& C) { const int st = b / 1024, sb = b % 1024, swz = sb ^ (((sb >> 9) & 1) << 5); R = (st >> 1) * 16 + swz / 64; C = (st & 1) * 32 + (swz % 64) / 2; }
DI int perm32(int rho) { const int n = rho >> 4, i = rho & 15; return 8 * (i >> 2) + 4 * n + (i & 3); }
DI int brow_of(int bmode, int h, int R) {
  return bmode == 0 ? 128 * h + R : (bmode == 1 ? 128 * h + (R & ~31) + perm32(R & 31) : 64 * (R >> 5) + 32 * h + perm32(R & 31));
}
struct GUnit { const char* A; const char* B; int bmode, seg, pm, pn; };

template <class Sched, class Epi>
DI void gemm_stream(LAS unsigned char* lds, int K, long lda, long ldb, const Sched& S, const Epi& E) {
  int tid_ = threadIdx.x; asm volatile("" : "+v"(tid_));
  const int tid = tid_ & 511, wid = __builtin_amdgcn_readfirstlane(tid >> 6), lane = tid & 63, wr = wid >> 2, wc = wid & 3, fr = lane & 15, fq = lane >> 4;
  const int nt = K / 64;
  unsigned voffA[2], voffB0[2], voffB1[2];
#pragma unroll
  for (int i = 0; i < 2; ++i) { int R_, C_; stage_rc(tid * 16 + i * 8192, R_, C_); voffA[i] = (unsigned)(R_ * lda + C_ * 2); }
  const size_t kstep = 128, hstepA = (size_t)128 * lda;
  const unsigned ldsw = (unsigned)wid * 1024u;
  const int aoff = lds_byte(wr * 64 + fr, fq * 8), boff = lds_byte(wc * 32 + fr, fq * 8);
#define GS_SA(b, h) (((b) * 2 + (h)) * HTB)
#define GS_SB(b, h) ((4 + (b) * 2 + (h)) * HTB)
#define GS_STAGE(bufoff, gbase, voff) do { _Pragma("unroll") for (int _i = 0; _i < 2; ++_i) \
    __builtin_amdgcn_global_load_lds((const unsigned*)((const char*)(gbase) + (voff)[_i]), (LAS unsigned*)(lds + (bufoff) + ldsw + _i * 8192), 16, 0, 0); } while (0)
#define GS_LDA(dst, b, h) do { _Pragma("unroll") for (int m = 0; m < 4; ++m) _Pragma("unroll") for (int k = 0; k < 2; ++k) dst[m][k] = *(const LAS f16x8*)(lds + GS_SA(b, h) + aoff + m * 2048 + k * 1024); } while (0)
#define GS_LDB(dst, b, h) do { _Pragma("unroll") for (int n = 0; n < 2; ++n) _Pragma("unroll") for (int k = 0; k < 2; ++k) dst[n][k] = *(const LAS f16x8*)(lds + GS_SB(b, h) + boff + n * 2048 + k * 1024); } while (0)
#define GS_MMA(ai, bj, At, Bt) do { __builtin_amdgcn_s_setprio(1); _Pragma("unroll") for (int m = 0; m < 4; ++m) _Pragma("unroll") for (int n = 0; n < 2; ++n) _Pragma("unroll") for (int k = 0; k < 2; ++k) \
    acc[ai][bj][m][n] = MFMA16(Bt[n][k], At[m][k], acc[ai][bj][m][n]); __builtin_amdgcn_s_setprio(0); } while (0)
#define GS_WAIT_V(n) asm volatile("s_waitcnt vmcnt(" #n ")" ::: "memory")
#define GS_WAIT_L(n) asm volatile("s_waitcnt lgkmcnt(" #n ")" ::: "memory")
#define GS_BAR __builtin_amdgcn_s_barrier()
#define GS_SCHED __builtin_amdgcn_sched_barrier(0)
#define GS_SETB(mode) do { int tq_ = threadIdx.x; asm volatile("" : "+v"(tq_)); _Pragma("unroll") for (int _i = 0; _i < 2; ++_i) { int R_, C_; stage_rc(tq_ * 16 + _i * 8192, R_, C_); \
    voffB0[_i] = (unsigned)(brow_of(mode, 0, R_) * ldb + C_ * 2); voffB1[_i] = (unsigned)(brow_of(mode, 1, R_) * ldb + C_ * 2); } } while (0)
  GUnit cur, nxt; int ui = 0;
  if (!S.next(0, cur)) return;
  f32x4 acc[2][2][4][2];
#pragma unroll
  for (int a = 0; a < 2; ++a)
#pragma unroll
    for (int b = 0; b < 2; ++b)
#pragma unroll
      for (int m = 0; m < 4; ++m)
#pragma unroll
        for (int n = 0; n < 2; ++n) acc[a][b][m][n] = (f32x4){0.f, 0.f, 0.f, 0.f};
  f16x8 At[4][2], B0[2][2], B1[2][2];
  const char* cA = cur.A; const char* cB = cur.B;
  GS_SETB(cur.bmode);
  GS_STAGE(GS_SB(0, 0), cB, voffB0); GS_STAGE(GS_SA(0, 0), cA, voffA); GS_STAGE(GS_SB(0, 1), cB, voffB1); GS_STAGE(GS_SA(0, 1), cA + hstepA, voffA);
  if (wr == 1) GS_BAR;
  GS_WAIT_V(4); GS_BAR;
  GS_STAGE(GS_SB(1, 0), cB + kstep, voffB0); GS_STAGE(GS_SA(1, 0), cA + kstep, voffA); GS_STAGE(GS_SB(1, 1), cB + kstep, voffB1);
  GS_WAIT_V(6); GS_BAR;
  for (;;) {
    const bool has_next = S.next(ui + 1, nxt);
    const char* nA = has_next ? nxt.A : cA; const char* nB = has_next ? nxt.B : cB;
    for (int t = 0; t < nt; t += 2) {
      const bool last = (t == nt - 2);
      const char* a1 = cA + (size_t)(t + 1) * kstep;
      const char* a2 = last ? nA : cA + (size_t)(t + 2) * kstep; const char* b2 = last ? nB : cB + (size_t)(t + 2) * kstep;
      const char* a3 = a2 + kstep; const char* b3 = b2 + kstep;
      if (last && has_next) GS_SETB(nxt.bmode);
      GS_LDB(B0, 0, 0); GS_SCHED; GS_LDA(At, 0, 0); GS_STAGE(GS_SA(1, 1), a1 + hstepA, voffA);
      GS_WAIT_L(8); GS_BAR; GS_WAIT_L(0); GS_MMA(0, 0, At, B0); GS_BAR; GS_SCHED;
      GS_LDB(B1, 0, 1); GS_STAGE(GS_SB(0, 0), b2, voffB0);
      GS_BAR; GS_WAIT_L(0); GS_MMA(0, 1, At, B1); GS_BAR;
      GS_LDA(At, 0, 1); GS_STAGE(GS_SA(0, 0), a2, voffA);
      GS_BAR; GS_WAIT_L(0); GS_MMA(1, 0, At, B0); GS_BAR; GS_SCHED;
      GS_STAGE(GS_SB(0, 1), b2, voffB1);
      GS_WAIT_V(6); GS_BAR; GS_MMA(1, 1, At, B1); GS_BAR;
      GS_LDB(B0, 1, 0); GS_SCHED; GS_LDA(At, 1, 0); GS_STAGE(GS_SA(0, 1), a2 + hstepA, voffA);
      GS_WAIT_L(8); GS_BAR; GS_WAIT_L(0); GS_MMA(0, 0, At, B0); GS_BAR; GS_SCHED;
      GS_LDB(B1, 1, 1); GS_STAGE(GS_SB(1, 0), b3, voffB0);
      GS_BAR; GS_WAIT_L(0); GS_MMA(0, 1, At, B1); GS_BAR;
      GS_LDA(At, 1, 1); GS_STAGE(GS_SA(1, 0), a3, voffA);
      GS_BAR; GS_WAIT_L(0); GS_MMA(1, 0, At, B0); GS_BAR; GS_SCHED;
      GS_STAGE(GS_SB(1, 1), b3, voffB1);
      GS_WAIT_V(6); GS_BAR; GS_MMA(1, 1, At, B1); GS_BAR;
    }
    E(acc, cur, wr, wc, fr, fq);
    if (!has_next) break;
#pragma unroll
    for (int a = 0; a < 2; ++a)
#pragma unroll
      for (int b = 0; b < 2; ++b)
#pragma unroll
        for (int m = 0; m < 4; ++m)
#pragma unroll
          for (int n = 0; n < 2; ++n) acc[a][b][m][n] = (f32x4){0.f, 0.f, 0.f, 0.f};
    cur = nxt; cA = nA; cB = nB; ++ui;
  }
  GS_WAIT_V(0);
  if (wr == 0) GS_BAR;
  GS_BAR;
#undef GS_SA
#undef GS_SB
#undef GS_STAGE
#undef GS_LDA
#undef GS_LDB
#undef GS_MMA
#undef GS_WAIT_V
#undef GS_WAIT_L
#undef GS_BAR
#undef GS_SCHED
#undef GS_SETB
}

struct Sched1 {
  const char* H; const char* W; const char* MEMN; const char* WMEM; int b, G;
  DI bool next(int i, GUnit& u) const {
    int kind, mt, nt;
    if (G == 256) {
      if (i < 12) { const int xcd = b & 7, l = b >> 3; const int st = i * 8 + xcd; const int mg = st / 3, ng = st % 3; kind = 0; mt = mg * 4 + (l & 3); nt = ng * 8 + (l >> 2); }
      else return false;
    } else {
      const int L = i * G + b;
      if (L < 3072) { kind = 0; mt = L / 24; nt = L % 24; }
      else return false;
    }
    u.pm = mt; u.pn = nt;
    if (kind == 1) { u.A = MEMN + (size_t)mt * 256 * 2048; u.B = WMEM + (size_t)nt * 256 * 2048; u.seg = 8; u.bmode = 1; return true; }
    int seg = 2;
    if (nt == 4 || nt == 6 || nt == 8) seg = 1;     else if (nt == 10) seg = 3; else if (nt == 11) seg = 4;
    else if (nt == 14 || nt == 15) seg = 5; else if (nt >= 16 && nt < 24) seg = 6; else if (nt == 24) seg = 7;
    u.seg = seg; u.bmode = (seg <= 1) ? 0 : ((seg == 3 || seg == 4) ? 2 : 1);
    u.A = H + (size_t)mt * 256 * 2048; u.B = W + (size_t)(nt < 24 ? nt * 256 : 6144) * 2048;
    return true;
  }
};
DI unsigned pk2(float a, float b) { typedef _Float16 h2 __attribute__((ext_vector_type(2))); h2 v; v[0] = (f16)a; v[1] = (f16)b; return __builtin_bit_cast(unsigned, v); }
struct Epi1 {
  f16* Z; f16* KVM; float* GATES; const float* ROT;
  DI void operator()(const f32x4 (&acc)[2][2][4][2], const GUnit& u, int wr, int wc, int fr, int fq) const {
    typedef unsigned u32x4_ __attribute__((ext_vector_type(4)));
    typedef unsigned u32x2_ __attribute__((ext_vector_type(2)));
    const int seg = u.seg;
    const int row0 = u.pm * 256 + wr * 64 + fr;
    if (seg == 7) {
      if (wc == 0 && fq < 3) {
#pragma unroll
        for (int ai = 0; ai < 2; ++ai)
#pragma unroll
          for (int m = 0; m < 4; ++m) {
            float* gp = GATES + (size_t)(row0 + ai * 128 + m * 16) * 24 + 8 * fq;
            f32x4 v0 = acc[ai][0][m][0], v1 = acc[ai][0][m][1];
#pragma unroll
            for (int j = 0; j < 4; ++j) { v0[j] = sigmoidf_(v0[j]); v1[j] = sigmoidf_(v1[j]); }
            *(f32x4*)gp = v0; *(f32x4*)(gp + 4) = v1;
          }
      }
      return;
    }
    if (seg == 0 || seg == 1) {
      const float sc = (seg == 0) ? QSCALE : 1.f;
      if (wc == 0) {
#pragma unroll
        for (int ai = 0; ai < 2; ++ai) {
          f32x4 ca[4], cb[4];
#pragma unroll
          for (int m = 0; m < 4; ++m) { const float* rp = ROT + (size_t)(row0 + ai * 128 + m * 16) * 96 + 8 * fq; ca[m] = *(const f32x4*)rp; cb[m] = *(const f32x4*)(rp + 4); }
#pragma unroll
          for (int m = 0; m < 4; ++m) {
            f16* zp = Z + (size_t)(row0 + ai * 128 + m * 16) * ZW + u.pn * 256 + 4 * fq;
            const float cs[4] = {ca[m][0], ca[m][2], cb[m][0], cb[m][2]}, sn[4] = {ca[m][1], ca[m][3], cb[m][1], cb[m][3]};
#pragma unroll
            for (int bj = 0; bj < 2; ++bj) {
              const f32x4 x1 = acc[ai][bj][m][0], x2 = acc[ai][bj][m][1];
              f32x4 o1, o2;
#pragma unroll
              for (int j = 0; j < 4; ++j) { o1[j] = (x1[j] * cs[j] - x2[j] * sn[j]) * sc; o2[j] = (x1[j] * sn[j] + x2[j] * cs[j]) * sc; }
              u32x2_ w1, w2; w1.x = pk2(o1[0], o1[1]); w1.y = pk2(o1[2], o1[3]); w2.x = pk2(o2[0], o2[1]); w2.y = pk2(o2[2], o2[3]);
              __builtin_nontemporal_store(w1, (u32x2_*)(zp + bj * 128)); __builtin_nontemporal_store(w2, (u32x2_*)(zp + bj * 128 + 16));
            }
          }
        }
      } else {
#pragma unroll
        for (int ai = 0; ai < 2; ++ai)
#pragma unroll
          for (int m = 0; m < 4; ++m) {
            f16* zp = Z + (size_t)(row0 + ai * 128 + m * 16) * ZW + u.pn * 256 + 32 * wc + 4 * fq;
#pragma unroll
            for (int bj = 0; bj < 2; ++bj) {
              const f32x4 x1 = acc[ai][bj][m][0] * sc, x2 = acc[ai][bj][m][1] * sc;
              u32x2_ w1, w2; w1.x = pk2(x1[0], x1[1]); w1.y = pk2(x1[2], x1[3]); w2.x = pk2(x2[0], x2[1]); w2.y = pk2(x2[2], x2[3]);
              __builtin_nontemporal_store(w1, (u32x2_*)(zp + bj * 128)); __builtin_nontemporal_store(w2, (u32x2_*)(zp + bj * 128 + 16));
            }
          }
      }
      return;
    }
    if (seg == 3 || seg == 4) {
      const float sc = (seg == 4) ? 0.125f : 1.f;
#pragma unroll
      for (int ai = 0; ai < 2; ++ai) {
        f32x4 tt[4][4];
#pragma unroll
        for (int m = 0; m < 4; ++m) {
          const float* rp = ROT + (size_t)(row0 + ai * 128 + m * 16) * 96 + 32 + 16 * fq;
          tt[m][0] = *(const f32x4*)rp; tt[m][1] = *(const f32x4*)(rp + 4); tt[m][2] = *(const f32x4*)(rp + 8); tt[m][3] = *(const f32x4*)(rp + 12);
        }
#pragma unroll
        for (int m = 0; m < 4; ++m) {
          f16* zp = Z + (size_t)(row0 + ai * 128 + m * 16) * ZW + u.pn * 256 + 64 * wc + 8 * fq;
          const f32x4 t0 = tt[m][0], t1 = tt[m][1], t2 = tt[m][2], t3 = tt[m][3];
          const float cs[8] = {t0[0], t0[2], t1[0], t1[2], t2[0], t2[2], t3[0], t3[2]}, sn[8] = {t0[1], t0[3], t1[1], t1[3], t2[1], t2[3], t3[1], t3[3]};
          float lo[8], hi[8];
#pragma unroll
          for (int n = 0; n < 2; ++n)
#pragma unroll
            for (int j = 0; j < 4; ++j) { const int e = 4 * n + j; const float x1 = acc[ai][0][m][n][j], x2 = acc[ai][1][m][n][j]; lo[e] = (x1 * cs[e] - x2 * sn[e]) * sc; hi[e] = (x1 * sn[e] + x2 * cs[e]) * sc; }
          u32x4_ wl, wh; wl.x = pk2(lo[0], lo[1]); wl.y = pk2(lo[2], lo[3]); wl.z = pk2(lo[4], lo[5]); wl.w = pk2(lo[6], lo[7]);
          wh.x = pk2(hi[0], hi[1]); wh.y = pk2(hi[2], hi[3]); wh.z = pk2(hi[4], hi[5]); wh.w = pk2(hi[6], hi[7]);
          __builtin_nontemporal_store(wl, (u32x4_*)zp); __builtin_nontemporal_store(wh, (u32x4_*)(zp + 32));
        }
      }
      return;
    }
    f16* base = (seg == 8) ? KVM : Z; const long ld = (seg == 8) ? 1024 : ZW;
#pragma unroll
    for (int ai = 0; ai < 2; ++ai)
#pragma unroll
      for (int m = 0; m < 4; ++m) {
        f16* zp = base + (size_t)(row0 + ai * 128 + m * 16) * ld + u.pn * 256 + 32 * wc + 8 * fq;
#pragma unroll
        for (int bj = 0; bj < 2; ++bj) {
          f32x4 v0 = acc[ai][bj][m][0], v1 = acc[ai][bj][m][1];
          if (seg == 5) { v0 *= QSCALE; v1 *= QSCALE; }
          u32x4_ w; w.x = pk2(v0[0], v0[1]); w.y = pk2(v0[2], v0[3]); w.z = pk2(v1[0], v1[1]); w.w = pk2(v1[2], v1[3]);
          __builtin_nontemporal_store(w, (u32x4_*)(zp + bj * 128));
        }
      }
  }
};
DI void phase_gemm1(const Params& p, char* smem) {
  Sched1 S; S.H = (const char*)p.out; S.W = p.ws + WS_WINT; S.MEMN = p.ws + WS_MEMN; S.WMEM = p.ws + WS_WMEMT; S.b = blockIdx.x; S.G = gridDim.x;
  Epi1 E; E.Z = (f16*)(p.ws + WS_Z); E.KVM = (f16*)(p.ws + WS_KVM); E.GATES = (float*)(p.ws + WS_GATES); E.ROT = (const float*)(p.ws + WS_ROT);
  gemm_stream((LAS unsigned char*)smem, 1024, 2048, 2048, S, E);
}

struct SchedOne {
  const char* A; const char* B; int pm, pn;
  DI bool next(int i, GUnit& u) const { if (i != 0) return false; u.A = A; u.B = B; u.pm = pm; u.pn = pn; u.seg = 8; u.bmode = 1; return true; }
};
DI void memkv_unit(const Params& p, int mt, int nt, char* smem) {
  SchedOne S; S.A = p.ws + WS_MEMN + (size_t)mt * 256 * 2048; S.B = p.ws + WS_WMEMT + (size_t)nt * 256 * 2048; S.pm = mt; S.pn = nt;
  Epi1 E; E.Z = (f16*)(p.ws + WS_Z); E.KVM = (f16*)(p.ws + WS_KVM); E.GATES = (float*)(p.ws + WS_GATES); E.ROT = (const float*)(p.ws + WS_ROT);
  gemm_stream((LAS unsigned char*)smem, 1024, 2048, 2048, S, E);
}

struct Sched2 {
  const char* A; const char* W; int b, G;
  DI bool next(int i, GUnit& u) const {
    int mt, nt;
    if (G == 256) { if (i >= 2) return false; const int xcd = b & 7, l = b >> 3; const int st = i * 8 + xcd; mt = st * 8 + (l & 7); nt = l >> 3; }
    else { const int L = i * G + b; if (L >= 512) return false; mt = L >> 2; nt = L & 3; }
    u.pm = mt; u.pn = nt; u.seg = 0; u.bmode = 1;
    u.A = A + (size_t)mt * 256 * ZW * 2; u.B = W + (size_t)nt * 256 * 4096;
    return true;
  }
};
struct Epi2 {
  f16* Y; float* PSS;
  DI void operator()(const f32x4 (&acc)[2][2][4][2], const GUnit& u, int wr, int wc, int fr, int fq) const {
    typedef unsigned u32x4_ __attribute__((ext_vector_type(4)));
    const int row0 = u.pm * 256 + wr * 64 + fr, col0 = u.pn * 256 + wc * 32 + 8 * fq;
#pragma unroll
    for (int ai = 0; ai < 2; ++ai)
#pragma unroll
      for (int m = 0; m < 4; ++m) {
        const int r = row0 + ai * 128 + m * 16;
        f16* yp = Y + (size_t)r * 1024 + col0; float ss = 0.f;
#pragma unroll
        for (int bj = 0; bj < 2; ++bj) {
          const f32x4 v0 = acc[ai][bj][m][0], v1 = acc[ai][bj][m][1];
          ss += (v0[0] * v0[0] + v0[1] * v0[1]) + (v0[2] * v0[2] + v0[3] * v0[3]) + (v1[0] * v1[0] + v1[1] * v1[1]) + (v1[2] * v1[2] + v1[3] * v1[3]);
          u32x4_ w; w.x = pk2(v0[0], v0[1]); w.y = pk2(v0[2], v0[3]); w.z = pk2(v1[0], v1[1]); w.w = pk2(v1[2], v1[3]);
          *(u32x4_*)(yp + bj * 128) = w;
        }
        ss += __shfl_xor(ss, 16); ss += __shfl_xor(ss, 32);
        if (fq == 0) PSS[(size_t)r * 16 + u.pn * 4 + wc] = ss;
      }
  }
};
DI void phase_gemm2(const Params& p, char* smem) {
  Sched2 S; S.A = p.ws + WS_Z + (size_t)ZC_GATE * 2; S.W = p.ws + WS_WOUTT; S.b = blockIdx.x; S.G = gridDim.x;
  Epi2 E; E.Y = (f16*)(p.ws + WS_Y); E.PSS = (float*)(p.ws + WS_PSS);
  gemm_stream((LAS unsigned char*)smem, 2048, (long)ZW * 2, 4096, S, E);
}

struct KCmpS { int k0; DI long operator()(int kt) const { const int k = kt + k0; return (long)(k >> 1) * ZW + (k & 1) * 64; } };
struct KStdS { int k0; DI long operator()(int kt) const { return (long)(kt + k0) * 64; } };
DI void unit_drain() { asm volatile("s_waitcnt vmcnt(0)" ::: "memory"); __syncthreads(); }
DI void publish_arrive(unsigned* ctr) {
  __builtin_amdgcn_fence(__ATOMIC_RELEASE, "agent");
  asm volatile("s_waitcnt vmcnt(0)" ::: "memory");
  __hip_atomic_fetch_add(ctr, 1u, __ATOMIC_RELAXED, __HIP_MEMORY_SCOPE_AGENT);
}
DI void wait_count(unsigned* ctr, unsigned target) {
  if (threadIdx.x == 0) {
    unsigned sp = 0;
    while (__hip_atomic_load(ctr, __ATOMIC_RELAXED, __HIP_MEMORY_SCOPE_AGENT) < target) { __builtin_amdgcn_s_sleep(2); if (++sp > (1u << 24)) break; }
    __builtin_amdgcn_fence(__ATOMIC_ACQUIRE, "agent");
    asm volatile("s_waitcnt vmcnt(0)" ::: "memory");
  }
  __syncthreads();
}
DI void csplit_unit(const Params& p, int kv, int b, int ks, char* smem) {
  int tid_ = threadIdx.x; asm volatile("" : "+v"(tid_)); const int tid = tid_, lane = tid & 63, wid = tid >> 6;
  const int lr = tid >> 3, lc = tid & 7;
  const char* Z = (const char*)(p.ws + WS_Z);
  const char* W1 = (const char*)(p.ws + WS_W1T) + (size_t)kv * 256 * 4096 * 2;
  const unsigned voffA = (unsigned)((lr & 31) * 16 * ZW * 2 + (lr >> 5) * 256 + lc * 16);
  const unsigned voffB = (unsigned)(lr * 8192 + lc * 16);
  f32x16 acc[4][2]; zero_acc(acc);
  KCmpS ka; ka.k0 = ks * 8; KStdS kb; kb.k0 = ks * 8;
  gemm_core(acc, Z + ((size_t)(b * NT) * ZW + ZC_KV + kv * 256) * 2, (long)32 * 16 * ZW * 2, voffA, W1, 64 * 8192, voffB, ka, kb, 8, smem);
  float* slab = p.out + (size_t)(((kv * 16 + b) * 8 + ks)) * 65536;
#pragma unroll
  for (int i = 0; i < 4; ++i)
#pragma unroll
    for (int j = 0; j < 2; ++j)
#pragma unroll
      for (int g = 0; g < 4; ++g) {
        f32x4 v; v[0] = acc[i][j][4 * g]; v[1] = acc[i][j][4 * g + 1]; v[2] = acc[i][j][4 * g + 2]; v[3] = acc[i][j][4 * g + 3];
        *(f32x4*)(slab + (size_t)((((wid * 4 + i) * 2 + j) * 4 + g) * 64 + lane) * 4) = v;
      }
  unit_drain();
}
DI void cfin_unit(const Params& p, int kv, int b, char* smem) {
  int tid_ = threadIdx.x; asm volatile("" : "+v"(tid_)); const int tid = tid_, lane = tid & 63, wid = tid >> 6, wn = wid & 3, l31 = lane & 31, h = lane >> 5;
  const int lr = tid >> 3, lc = tid & 7;
  f16* HID = (f16*)(p.ws + WS_HID) + (size_t)kv * 4096 * 256;
  wait_count((unsigned*)(p.ws + WS_CTR) + 16 + kv * 16 + b, 8u);
  {
    float* bias = (float*)(smem + 131072);
    if (tid < 256) { const float* PB1 = (const float*)(p.ws + WS_PB1) + kv * 16 * 256; float sacc = 0.f; for (int c = 0; c < 16; ++c) sacc += PB1[c * 256 + tid]; bias[tid] = sacc; }
    __syncthreads();
    f32x16 acc[4][2];
#pragma unroll
    for (int j = 0; j < 2; ++j)
#pragma unroll
      for (int r = 0; r < 16; ++r) { const float bv = bias[64 * wn + 32 * j + crow(r, h)]; acc[0][j][r] = bv; acc[1][j][r] = bv; acc[2][j][r] = bv; acc[3][j][r] = bv; }
    const float* slab0 = p.out + (size_t)((kv * 16 + b) * 8) * 65536;
#pragma unroll 1
    for (int ks = 0; ks < 8; ks += 2) {
      const float* slab = slab0 + (size_t)ks * 65536;
#pragma unroll
      for (int i = 0; i < 4; ++i) {
#pragma unroll
        for (int qh = 0; qh < 2; ++qh) {
          f32x4 tv[4], tw[4];
#pragma unroll
          for (int q = 0; q < 4; ++q) {
            const size_t o_ = (size_t)(((wid * 4 + i) * 8 + 4 * qh + q) * 64 + lane) * 4;
            tv[q] = *(const f32x4*)(slab + o_); tw[q] = *(const f32x4*)(slab + 65536 + o_);
          }
#pragma unroll
          for (int g = 0; g < 4; ++g) {
            acc[i][qh][4 * g] += tv[g][0] + tw[g][0]; acc[i][qh][4 * g + 1] += tv[g][1] + tw[g][1]; acc[i][qh][4 * g + 2] += tv[g][2] + tw[g][2]; acc[i][qh][4 * g + 3] += tv[g][3] + tw[g][3];
          }
        }
      }
    }
    __syncthreads();
    {
      const int wm = wid >> 2;
      char* img = smem + wid * (128 * 144);
#pragma unroll
      for (int i = 0; i < 4; ++i)
#pragma unroll
        for (int j = 0; j < 2; ++j)
#pragma unroll
          for (int g = 0; g < 4; ++g) {
            f16x4 v; v[0] = (f16)acc[i][j][4 * g]; v[1] = (f16)acc[i][j][4 * g + 1]; v[2] = (f16)acc[i][j][4 * g + 2]; v[3] = (f16)acc[i][j][4 * g + 3];
            *(f16x4*)(img + (32 * i + l31) * 144 + (32 * j + 8 * g + 4 * h) * 2) = v;
          }
      __syncthreads();
#pragma unroll 2
      for (int it = 0; it < 16; ++it) {
        const int row = it * 8 + (lane >> 3), ch = lane & 7;
        const int slot = 128 * wm + row; const int lrr = slot & 63, ii = slot >> 6;
        const int n = (lrr & 31) + 32 * ii, g = lrr >> 5;
        f16x8 v = *(const f16x8*)(img + row * 144 + ch * 16);
        v = XfGelu()(v, nullptr, 0, 0, 0);
        *(f16x8*)(HID + (size_t)(b * 256 + g * 128 + n) * 256 + 64 * wn + ch * 8) = v;
      }
      __syncthreads();
    }
  }
  __threadfence_block();
  __syncthreads();
  {
    const char* W2 = (const char*)(p.ws + WS_W2T) + (size_t)kv * 128 * 256 * 2;
    const unsigned voff = (unsigned)(lr * 512 + lc * 16);
    f32x16 acc[4][2]; zero_acc(acc);
    gemm_core(acc, (const char*)HID + (size_t)(b * 256) * 512, 64 * 512, voff, W2, 64 * 512, voff, KStd(), KStd(), 4, smem);
    if (l31 == 31) {
#pragma unroll
      for (int j = 0; j < 2; ++j)
#pragma unroll
        for (int r = 0; r < 16; ++r) acc[3][j][r] = 0.f;
    }
    f16* KC = (f16*)(p.ws + WS_KC) + (size_t)kv * 4096 * 128;
    store_tile_f16(acc, KC + (size_t)(b * 256) * 128, 128, smem, wn < 2, XfNone());
  }
  unit_drain();
}

struct KV128 { f16x8 k[2], v[2]; };
DI void kv_gload(KV128& r, const char* K, const char* V, unsigned voff, long ldb) {
  r.k[0] = *(const f16x8*)(K + (size_t)voff); r.k[1] = *(const f16x8*)(K + 32 * ldb + (size_t)voff);
  r.v[0] = *(const f16x8*)(V + (size_t)voff); r.v[1] = *(const f16x8*)(V + 32 * ldb + (size_t)voff);
}
DI void kv_lstore(const KV128& r, char* stage, unsigned so) {
  *(f16x8*)(stage + so) = r.k[0]; *(f16x8*)(stage + so + 8192) = r.k[1];
  *(f16x8*)(stage + 16384 + so) = r.v[0]; *(f16x8*)(stage + 16384 + so + 8192) = r.v[1];
}
DI void qk128(f32x16& p0, f32x16& p1, const char* Kst, const f16x8 (&qf)[8], unsigned kbe, unsigned kbo) {
  const f32x16 zero = {0.f, 0.f, 0.f, 0.f, 0.f, 0.f, 0.f, 0.f, 0.f, 0.f, 0.f, 0.f, 0.f, 0.f, 0.f, 0.f};
  f16x8 ka[4], kb[4];
#define QK_LD(dst, s0) do { dst[0] = *(const f16x8*)(Kst + kbe + 512 * ((s0) >> 1)); dst[1] = *(const f16x8*)(Kst + kbe + 512 * ((s0) >> 1) + 8192); \
    dst[2] = *(const f16x8*)(Kst + kbo + 512 * ((s0) >> 1)); dst[3] = *(const f16x8*)(Kst + kbo + 512 * ((s0) >> 1) + 8192); } while (0)
  QK_LD(ka, 0);
  QK_LD(kb, 2);
  p0 = MFMA(ka[0], qf[0], zero); p1 = MFMA(ka[1], qf[0], zero); p0 = MFMA(ka[2], qf[1], p0); p1 = MFMA(ka[3], qf[1], p1);
  QK_LD(ka, 4);
  p0 = MFMA(kb[0], qf[2], p0); p1 = MFMA(kb[1], qf[2], p1); p0 = MFMA(kb[2], qf[3], p0); p1 = MFMA(kb[3], qf[3], p1);
  QK_LD(kb, 6);
  p0 = MFMA(ka[0], qf[4], p0); p1 = MFMA(ka[1], qf[4], p1); p0 = MFMA(ka[2], qf[5], p0); p1 = MFMA(ka[3], qf[5], p1);
  p0 = MFMA(kb[0], qf[6], p0); p1 = MFMA(kb[1], qf[6], p1); p0 = MFMA(kb[2], qf[7], p0); p1 = MFMA(kb[3], qf[7], p1);
#undef QK_LD
  __builtin_amdgcn_sched_group_barrier(0x100, 8, 0);
  __builtin_amdgcn_sched_group_barrier(0x008, 4, 0);
  __builtin_amdgcn_sched_group_barrier(0x100, 4, 0);
  __builtin_amdgcn_sched_group_barrier(0x008, 4, 0);
  __builtin_amdgcn_sched_group_barrier(0x100, 4, 0);
  __builtin_amdgcn_sched_group_barrier(0x008, 8, 0);
}
DI f16x8 pack8(const f32x16& x, int s) {
  f16x8 r;
#pragma unroll
  for (int j = 0; j < 8; ++j) r[j] = (f16)x[8 * s + j];
  return r;
}
struct VFrag { f16x4 l0, h0, l1, h1, l2, h2, l3, h3; };
template <int DT> DI void pv_rd(VFrag& f, unsigned vb0, unsigned vb1) {
  f.l0 = tr_read<512 * DT>(vb0); f.h0 = tr_read<512 * DT + 2048>(vb1);
  f.l1 = tr_read<512 * DT + 4096>(vb0); f.h1 = tr_read<512 * DT + 4096 + 2048>(vb1);
  f.l2 = tr_read<512 * DT + 8192>(vb0); f.h2 = tr_read<512 * DT + 8192 + 2048>(vb1);
  f.l3 = tr_read<512 * DT + 12288>(vb0); f.h3 = tr_read<512 * DT + 12288 + 2048>(vb1);
}
DI void pv_mm(f32x16& od, const VFrag& f, const f16x8 (&pb)[4]) {
#define PK(L, H) (f16x8){L[0], L[1], L[2], L[3], H[0], H[1], H[2], H[3]}
  od = MFMA(PK(f.l0, f.h0), pb[0], od);
  od = MFMA(PK(f.l1, f.h1), pb[1], od);
  od = MFMA(PK(f.l2, f.h2), pb[2], od);
  od = MFMA(PK(f.l3, f.h3), pb[3], od);
#undef PK
}
DI void pv_tile(f32x16 (&o)[4], unsigned vb0, unsigned vb1, const f32x16& p0, const f32x16& p1) {
  f16x8 pb[4]; pb[0] = pack8(p0, 0); pb[1] = pack8(p0, 1); pb[2] = pack8(p1, 0); pb[3] = pack8(p1, 1);
  VFrag fa, fb;
  pv_rd<0>(fa, vb0, vb1);
  pv_rd<1>(fb, vb0, vb1);
  asm volatile("s_waitcnt lgkmcnt(8)" ::: "memory"); SBAR();
  pv_mm(o[0], fa, pb);
  pv_rd<2>(fa, vb0, vb1);
  asm volatile("s_waitcnt lgkmcnt(8)" ::: "memory"); SBAR();
  pv_mm(o[1], fb, pb);
  pv_rd<3>(fb, vb0, vb1);
  asm volatile("s_waitcnt lgkmcnt(8)" ::: "memory"); SBAR();
  pv_mm(o[2], fa, pb);
  asm volatile("s_waitcnt lgkmcnt(0)" ::: "memory"); SBAR();
  pv_mm(o[3], fb, pb);
}
DI void qk_exp(f32x16& n0, f32x16& n1, const char* Kst, const f16x8 (&qf)[8], unsigned kbe, unsigned kbo, f32x16& c0, f32x16& c1, float me, float& ps) {
  const f32x16 zero = {0.f, 0.f, 0.f, 0.f, 0.f, 0.f, 0.f, 0.f, 0.f, 0.f, 0.f, 0.f, 0.f, 0.f, 0.f, 0.f};
  f16x8 ka[4], kb[4];
#define QK_LD(dst, s0) do { dst[0] = *(const f16x8*)(Kst + kbe + 512 * ((s0) >> 1)); dst[1] = *(const f16x8*)(Kst + kbe + 512 * ((s0) >> 1) + 8192); \
    dst[2] = *(const f16x8*)(Kst + kbo + 512 * ((s0) >> 1)); dst[3] = *(const f16x8*)(Kst + kbo + 512 * ((s0) >> 1) + 8192); } while (0)
#define EXP8(c, b0) do { _Pragma("unroll") for (int j_ = 0; j_ < 8; ++j_) { c[(b0) + j_] = fexp2(c[(b0) + j_] - me); s_ += c[(b0) + j_]; } } while (0)
  float s_ = 0.f;
  QK_LD(ka, 0);
  n0 = MFMA(ka[0], qf[0], zero); n1 = MFMA(ka[1], qf[0], zero); n0 = MFMA(ka[2], qf[1], n0); n1 = MFMA(ka[3], qf[1], n1);
  QK_LD(kb, 2);
  EXP8(c0, 0);
  n0 = MFMA(kb[0], qf[2], n0); n1 = MFMA(kb[1], qf[2], n1); n0 = MFMA(kb[2], qf[3], n0); n1 = MFMA(kb[3], qf[3], n1);
  QK_LD(ka, 4);
  EXP8(c0, 8);
  n0 = MFMA(ka[0], qf[4], n0); n1 = MFMA(ka[1], qf[4], n1); n0 = MFMA(ka[2], qf[5], n0); n1 = MFMA(ka[3], qf[5], n1);
  QK_LD(kb, 6);
  EXP8(c1, 0);
  n0 = MFMA(kb[0], qf[6], n0); n1 = MFMA(kb[1], qf[6], n1); n0 = MFMA(kb[2], qf[7], n0); n1 = MFMA(kb[3], qf[7], n1);
  EXP8(c1, 8);
  ps = s_;
#undef QK_LD
}
DI void exp_only(f32x16& c0, f32x16& c1, float me, float& ps) {
  float s_ = 0.f;
  EXP8(c0, 0); EXP8(c0, 8); EXP8(c1, 0); EXP8(c1, 8);
  ps = s_;
#undef EXP8
}
DI void pv_max(f32x16 (&o)[4], unsigned vb0, unsigned vb1, const f32x16& p0, const f32x16& p1, const f32x16& n0, const f32x16& n1, float& pm) {
  f16x8 pb[4]; pb[0] = pack8(p0, 0); pb[1] = pack8(p0, 1); pb[2] = pack8(p1, 0); pb[3] = pack8(p1, 1);
  VFrag fa;
  float mx = n0[0];
  pv_rd<0>(fa, vb0, vb1);
  asm volatile("s_waitcnt lgkmcnt(0)" ::: "memory"); SBAR();
  pv_mm(o[0], fa, pb);
  pv_rd<1>(fa, vb0, vb1);
#pragma unroll
  for (int r = 1; r < 8; ++r) mx = fmaxf(mx, n0[r]);
  asm volatile("s_waitcnt lgkmcnt(0)" ::: "memory"); SBAR();
  pv_mm(o[1], fa, pb);
  pv_rd<2>(fa, vb0, vb1);
#pragma unroll
  for (int r = 8; r < 16; ++r) mx = fmaxf(mx, n0[r]);
  asm volatile("s_waitcnt lgkmcnt(0)" ::: "memory"); SBAR();
  pv_mm(o[2], fa, pb);
  pv_rd<3>(fa, vb0, vb1);
#pragma unroll
  for (int r = 0; r < 8; ++r) mx = fmaxf(mx, n1[r]);
  asm volatile("s_waitcnt lgkmcnt(0)" ::: "memory"); SBAR();
  pv_mm(o[3], fa, pb);
#pragma unroll
  for (int r = 8; r < 16; ++r) mx = fmaxf(mx, n1[r]);
  pm = mx;
}
DI float rowmax32(const f32x16& c0, const f32x16& c1) {
  float pm = c0[0];
#pragma unroll
  for (int r = 1; r < 16; ++r) pm = fmaxf(pm, c0[r]);
#pragma unroll
  for (int r = 0; r < 16; ++r) pm = fmaxf(pm, c1[r]);
  return xhalf_max(pm);
}
DI void osm_decide(float pmn, float& m, float& l, f32x16 (&o)[4]) {
  if (!__all(pmn - m <= THR)) {
    float mn = fmaxf(m, pmn); float alpha = fexp2(m - mn); m = mn; l *= alpha;
#pragma unroll
    for (int d = 0; d < 4; ++d)
#pragma unroll
      for (int r = 0; r < 16; ++r) o[d][r] *= alpha;
  }
}
DI void osm_step(f32x16& p0, f32x16& p1, float& m, float& l, f32x16 (&o)[4], bool sel = true) {
  float pm = p0[0];
#pragma unroll
  for (int r = 1; r < 16; ++r) pm = fmaxf(pm, p0[r]);
#pragma unroll
  for (int r = 0; r < 16; ++r) pm = fmaxf(pm, p1[r]);
  pm = xhalf_max(pm);
  pm = sel ? pm : NEG;
  if (!__all(pm - m <= THR)) {
    float mn = fmaxf(m, pm); float alpha = fexp2(m - mn); m = mn; l *= alpha;
#pragma unroll
    for (int d = 0; d < 4; ++d)
#pragma unroll
      for (int r = 0; r < 16; ++r) o[d][r] *= alpha;
  }
  const float me = sel ? m : 1e30f;
  float ps = 0.f;
#pragma unroll
  for (int r = 0; r < 16; ++r) { p0[r] = fexp2(p0[r] - me); ps += p0[r]; }
#pragma unroll
  for (int r = 0; r < 16; ++r) { p1[r] = fexp2(p1[r] - me); ps += p1[r]; }
  l += ps;
}
DI void zero_o(f32x16 (&o)[4]) {
#pragma unroll
  for (int d = 0; d < 4; ++d)
#pragma unroll
    for (int r = 0; r < 16; ++r) o[d][r] = 0.f;
}


DI void glds16(const char* g, LAS unsigned char* l) { __builtin_amdgcn_global_load_lds((const unsigned*)g, (LAS unsigned*)l, 16, 0, 0); }
DI unsigned dma_voff128(int wid, int lane, long ldb) {
  const int r3 = wid >> 1, c2 = ((wid & 1) << 1) | (lane >> 5), r7 = (lane >> 2) & 7, x = lane & 3;
  const int row = 8 * r3 + r7, rr = ((r7 >> 2) | ((r3 & 1) << 1)) & 3, ch = 4 * c2 + (x ^ rr);
  return (unsigned)(row * ldb + ch * 16);
}
DI unsigned dma_voff64(int wid, int lane, long ldb) {
  const int row = 8 * wid + (lane >> 3), c = (lane & 7) ^ ((row >> 1) & 7);
  return (unsigned)(row * ldb + c * 16);
}
DI void dma_kv128(LAS unsigned char* stage, unsigned ldsw, const char* K, const char* V, unsigned voff, long ldb) {
  glds16(K + (size_t)voff, stage + ldsw); glds16(K + 32 * ldb + (size_t)voff, stage + ldsw + 8192);
  glds16(V + (size_t)voff, stage + 16384 + ldsw); glds16(V + 32 * ldb + (size_t)voff, stage + 16384 + ldsw + 8192);
}
#define VWAIT(n) asm volatile("s_waitcnt vmcnt(" #n ")" ::: "memory")
DI void ring_wait4(int rem) {
  if (rem >= 3) VWAIT(12); else if (rem == 2) VWAIT(8); else if (rem == 1) VWAIT(4); else VWAIT(0);
}
DI void ring_wait3(int rem) {
  if (rem >= 3) VWAIT(9); else if (rem == 2) VWAIT(6); else if (rem == 1) VWAIT(3); else VWAIT(0);
}
DI void ring_bar() { asm volatile("s_waitcnt lgkmcnt(0)" ::: "memory"); __builtin_amdgcn_s_barrier(); asm volatile("" ::: "memory"); }

DI void nsa_unit(const Params& p, int b, int g, int qt, char* smem) {
  const int wid = __builtin_amdgcn_readfirstlane(threadIdx.x >> 6);
  int tid_ = threadIdx.x; asm volatile("" : "+v"(tid_)); const int tid = tid_, lane = tid & 63, l31 = lane & 31, h = lane >> 5;
  const int tl = 8 * wid + (l31 >> 2), rr = l31 & 3, head = 4 * g + rr;
  const int t = 64 * qt + tl;
  const unsigned row = (unsigned)(b * NT + t);
  char* Zc = p.ws + WS_Z;
  LAS unsigned char* lds = (LAS unsigned char*)smem;
  const unsigned ldsw = (unsigned)wid * 1024u;
  const char* KC = p.ws + WS_KC + (size_t)((b * 2 + g) * 128) * 256;
  const char* VC = KC + (size_t)4096 * 256;
  const unsigned cvo = dma_voff128(wid, lane, 256), zvo = dma_voff128(wid, lane, ZW * 2);
  const char* Zb = Zc + (size_t)b * NT * ZW * 2;
  const int cKs = ZC_KV + 512 + g * 128, cVs = ZC_KV + 768 + g * 128, cKw = ZC_KV + 1024 + g * 128, cVw = ZC_KV + 1280 + g * 128;
  const int nwin = (qt >= 8) ? 9 : (qt + 1);
  const int NTILE = 3 + qt + nwin;
#define NSA_ISSUE(n_) do { const int n__ = (n_); LAS unsigned char* st__ = lds + (n__ & 3) * 32768; \
    if (n__ < 2) dma_kv128(st__, ldsw, KC + n__ * 64 * 256, VC + n__ * 64 * 256, cvo, 256); \
    else if (n__ < 3 + qt) { const size_t ko__ = (size_t)(64 * (qt - (n__ - 2))) * ZW * 2; dma_kv128(st__, ldsw, Zb + ko__ + cKs * 2, Zb + ko__ + cVs * 2, zvo, ZW * 2); } \
    else { const size_t ko__ = (size_t)(64 * (qt - (n__ - 3 - qt))) * ZW * 2; dma_kv128(st__, ldsw, Zb + ko__ + cKw * 2, Zb + ko__ + cVw * 2, zvo, ZW * 2); } } while (0)
  f16x8 qf[8];
  {
    const char* qrow = Zc + (size_t)((row * ZW + ZC_QN + head * 128 + 8 * h) * 2u);
#pragma unroll
    for (int s = 0; s < 8; ++s) qf[s] = *(const f16x8*)(qrow + 32 * s);
  }
  f32x4 rt[4];
  { const float* rp = (const float*)(p.ws + WS_ROT) + (size_t)row * 96 + 16 * h;
#pragma unroll
    for (int i = 0; i < 4; ++i) rt[i] = *(const f32x4*)(rp + 4 * i); }
  float g0, g1, g2;
  { const float* gp = (const float*)(p.ws + WS_GATES) + (size_t)(row * 24u + head); g0 = gp[0]; g1 = gp[8]; g2 = gp[16]; }
  NSA_ISSUE(2);
  wait_count((unsigned*)(p.ws + WS_CTR) + 64 + b, 2u);
  NSA_ISSUE(0); NSA_ISSUE(1);
  int issued = 3;
  const unsigned kbe = 2048 * (l31 >> 3) + 64 * (l31 & 7) + 16 * ((h) ^ ((l31 >> 2) & 3));
  const unsigned kbo = 2048 * (l31 >> 3) + 64 * (l31 & 7) + 16 * ((2 + h) ^ ((l31 >> 2) & 3));
  const int q4 = (lane & 15) >> 2, p4 = lane & 3, blk = (lane >> 4) & 1;
  const unsigned sbase = (unsigned)(uintptr_t)smem;
  const unsigned vr0 = sbase + 16384 + 64 * (4 * h + q4) + 16 * ((2 * blk + (p4 >> 1)) ^ (h)) + 8 * (p4 & 1);
  const unsigned vr1 = sbase + 16384 + 64 * (4 * h + q4) + 16 * ((2 * blk + (p4 >> 1)) ^ (2 + h)) + 8 * (p4 & 1);
  char* otg = (char*)p.out + (size_t)(64u << 20) + (size_t)(((b * 2 + g) * 32 + qt)) * 65536 + tid * 16;
  f32x16 o[4];
  unsigned selmask;
  {
    ring_wait4(0); ring_bar();
    {
#pragma unroll
      for (int e = 0; e < 8; ++e) {
        const float cs = rt[e >> 1][2 * (e & 1)], sn = rt[e >> 1][2 * (e & 1) + 1];
        const float x1 = (float)qf[0][e], x2 = (float)qf[1][e];
        qf[0][e] = (f16)((x1 * cs - x2 * sn) * QSCALE); qf[1][e] = (f16)((x1 * sn + x2 * cs) * QSCALE);
      }
#pragma unroll
      for (int s = 2; s < 8; ++s)
#pragma unroll
        for (int e = 0; e < 8; ++e) qf[s][e] = (f16)((float)qf[s][e] * QSCALE);
    }
    f32x16 c0, c1, c2, c3;
    qk128(c0, c1, smem, qf, kbe, kbo);
    qk128(c2, c3, smem + 32768, qf, kbe, kbo);
    const int nmax = (t - 31) >> 4;
    float mx = NEG;
#pragma unroll
    for (int r = 0; r < 16; ++r) {
      const int n = crow(r, h);
      c0[r] = (n <= nmax) ? c0[r] : NEG; c1[r] = (n + 32 <= nmax) ? c1[r] : NEG; c2[r] = (n + 64 <= nmax) ? c2[r] : NEG; c3[r] = (n + 96 <= nmax) ? c3[r] : NEG;
      mx = fmaxf(mx, fmaxf(fmaxf(c0[r], c1[r]), fmaxf(c2[r], c3[r])));
    }
    mx = xhalf_max(mx);
    float ls = 0.f;
#pragma unroll
    for (int r = 0; r < 16; ++r) {
      c0[r] = (c0[r] > -1e29f) ? fexp2(c0[r] - mx) : 0.f; c1[r] = (c1[r] > -1e29f) ? fexp2(c1[r] - mx) : 0.f;
      c2[r] = (c2[r] > -1e29f) ? fexp2(c2[r] - mx) : 0.f; c3[r] = (c3[r] > -1e29f) ? fexp2(c3[r] - mx) : 0.f;
      ls += (c0[r] + c1[r]) + (c2[r] + c3[r]);
    }
    ls = xhalf_sum(ls);
    const float inv = (ls > 0.f) ? 1.f / ls : 0.f;
#pragma unroll
    for (int r = 0; r < 16; ++r) { c0[r] *= inv; c1[r] *= inv; c2[r] *= inv; c3[r] *= inv; }
    if (qt <= 15) {
      selmask = (1u << (qt + 1)) - 1u;
    } else {
      float av[16], cv[16];
#pragma unroll
      for (int k = 0; k < 4; ++k)
#pragma unroll
        for (int gg = 0; gg < 4; ++gg) {
          const f32x16& c = (k == 0) ? c0 : (k == 1) ? c1 : (k == 2) ? c2 : c3;
          float half3 = 0.5f * c[4 * gg + 3];
          av[4 * k + gg] = c[4 * gg] + c[4 * gg + 1] + c[4 * gg + 2] + half3; cv[4 * k + gg] = half3;
        }
      float imp[16];
#pragma unroll
      for (int i = 0; i < 16; ++i) {
        auto x2 = __builtin_amdgcn_permlane32_swap(__float_as_uint(cv[i]), __float_as_uint(cv[i]), false, false);
        float oc = h ? __uint_as_float(x2[0]) : __uint_as_float(x2[1]);
        cv[i] = oc;
      }
#pragma unroll
      for (int i = 0; i < 16; ++i) {
        float carry = h ? cv[i] : (i > 0 ? cv[i - 1] : 0.f);
        float v = av[i] + carry;
        v += __shfl_xor(v, 1); v += __shfl_xor(v, 2);
        imp[i] = v;
      }
      float* impL = (float*)(smem + 131072) + wid * 256;
      if (rr == 0) {
#pragma unroll
        for (int i = 0; i < 16; ++i) impL[(l31 >> 2) * 32 + 2 * i + h] = imp[i];
      }
      asm volatile("s_waitcnt lgkmcnt(0)" ::: "memory");
      __builtin_amdgcn_wave_barrier();
      const int sub = rr + 4 * h;
      const float* vrow = impL + (l31 >> 2) * 32;
      f32x4 mine = *(const f32x4*)(vrow + 4 * sub);
      int cnt[4] = {0, 0, 0, 0};
#pragma unroll 4
      for (int j2 = 1; j2 <= qt - 2; ++j2) {
        float w = vrow[j2];
#pragma unroll
        for (int e = 0; e < 4; ++e) { int j = 4 * sub + e; cnt[e] += (w > mine[e] || (w == mine[e] && j2 < j)) ? 1 : 0; }
      }
      unsigned nib = 0;
#pragma unroll
      for (int e = 0; e < 4; ++e) { int j = 4 * sub + e; if (j >= 1 && j <= qt - 2 && cnt[e] < 13) nib |= 1u << j; }
      nib |= (unsigned)__shfl_xor((int)nib, 1); nib |= (unsigned)__shfl_xor((int)nib, 2); nib |= (unsigned)__shfl_xor((int)nib, 32);
      selmask = nib | 1u | (1u << qt) | (1u << (qt - 1));
    }
    zero_o(o);
    pv_tile(o, vr0, vr1, c0, c1);
    pv_tile(o, vr0 + 32768, vr1 + 32768, c2, c3);
#pragma unroll
    for (int d = 0; d < 4; ++d)
#pragma unroll
      for (int g2_ = 0; g2_ < 2; ++g2_) {
        f16x8 v;
#pragma unroll
        for (int e = 0; e < 8; ++e) v[e] = (f16)(g0 * o[d][8 * g2_ + e]);
        *(f16x8*)(otg + (2 * d + g2_) * 8192) = v;
      }
  }
  f16x8 rv[8];
#define NSA_STEP(n_) do { ring_wait4(issued - 1 - (n_)); ring_bar(); while (issued <= (n_) + 2 && issued < NTILE) { NSA_ISSUE(issued); ++issued; } } while (0)
  float m, l = 0.f;
  zero_o(o);
  {
    const int na = 2, nb = 2 + qt;
    f32x16 c0, c1;
    NSA_STEP(na);
    qk128(c0, c1, smem + (na & 3) * 32768, qf, kbe, kbo);
    {
      int tlx = tl - 4 * h; asm volatile("" : "+v"(tlx));
#pragma unroll
      for (int r = 0; r < 16; ++r) { const int key = crow(r, 0); c0[r] = (key <= tlx) ? c0[r] : NEG; c1[r] = (key + 32 <= tlx) ? c1[r] : NEG; }
    }
    m = rowmax32(c0, c1);
    bool selc = true;
    f32x16 x0, x1;
#define SLC_STEP(C0, C1, X0, X1) do { \
      NSA_STEP(n + 1); \
      const float me = selc ? m : 1e30f; float ps, pmn; \
      qk_exp(X0, X1, smem + ((n + 1) & 3) * 32768, qf, kbe, kbo, C0, C1, me, ps); \
      l += ps; \
      pv_max(o, vr0 + (n & 3) * 32768, vr1 + (n & 3) * 32768, C0, C1, X0, X1, pmn); \
      const bool seln = (selmask >> (qt - (n + 1 - 2))) & 1u; \
      pmn = xhalf_max(pmn); pmn = seln ? pmn : NEG; \
      osm_decide(pmn, m, l, o); \
      selc = seln; } while (0)
    int n = na;
    for (; n + 1 < nb; n += 2) { SLC_STEP(c0, c1, x0, x1); ++n; SLC_STEP(x0, x1, c0, c1); --n; }
    if (n < nb) { SLC_STEP(c0, c1, x0, x1); c0 = x0; c1 = x1; }
#undef SLC_STEP
#pragma unroll
    for (int k = 0; k < 8; ++k) rv[k] = *(const f16x8*)(otg + k * 8192);
    { const float me = selc ? m : 1e30f; float ps; exp_only(c0, c1, me, ps); l += ps; pv_tile(o, vr0 + (nb & 3) * 32768, vr1 + (nb & 3) * 32768, c0, c1); }
  }
  {
    float lt = xhalf_sum(l); float sc = g1 / lt;
#pragma unroll
    for (int d = 0; d < 4; ++d)
#pragma unroll
      for (int g2_ = 0; g2_ < 2; ++g2_) {
        f16x8 v = rv[2 * d + g2_];
#pragma unroll
        for (int e = 0; e < 8; ++e) v[e] = (f16)((float)v[e] + sc * o[d][8 * g2_ + e]);
        *(f16x8*)(otg + (2 * d + g2_) * 8192) = v;
      }
  }
  f16* mp = (f16*)(Zc + (size_t)((row * ZW + ZC_GATE + head * 128 + 4 * h) * 2u));
  f16x8 pvs[8]; f16x4 gts[16];
  l = 0.f; zero_o(o);
  {
    const int na = 3 + qt, nb = NTILE - 1;
    f32x16 c0, c1;
    NSA_STEP(na);
    qk128(c0, c1, smem + (na & 3) * 32768, qf, kbe, kbo);
    {
      int tlx = tl - 4 * h; asm volatile("" : "+v"(tlx));
#pragma unroll
      for (int r = 0; r < 16; ++r) { const int key = crow(r, 0); c0[r] = (key <= tlx) ? c0[r] : NEG; c1[r] = (key + 32 <= tlx) ? c1[r] : NEG; }
    }
    m = rowmax32(c0, c1);
    f32x16 x0, x1;
#define WIN_STEP(C0, C1, X0, X1) do { \
      NSA_STEP(n + 1); \
      float ps, pmn; \
      qk_exp(X0, X1, smem + ((n + 1) & 3) * 32768, qf, kbe, kbo, C0, C1, m, ps); \
      l += ps; \
      pv_max(o, vr0 + (n & 3) * 32768, vr1 + (n & 3) * 32768, C0, C1, X0, X1, pmn); \
      pmn = xhalf_max(pmn); \
      osm_decide(pmn, m, l, o); } while (0)
    int n = na;
    for (; n + 1 < nb; n += 2) { WIN_STEP(c0, c1, x0, x1); ++n; WIN_STEP(x0, x1, c0, c1); --n; }
    if (n < nb) { WIN_STEP(c0, c1, x0, x1); c0 = x0; c1 = x1; }
#undef WIN_STEP
    if (nwin == 9) {
      int tlx = tl - 4 * h; asm volatile("" : "+v"(tlx));
#pragma unroll
      for (int r = 0; r < 16; ++r) { const int key = crow(r, 0); c0[r] = (key > tlx) ? c0[r] : NEG; c1[r] = (key + 32 > tlx) ? c1[r] : NEG; }
    }
#pragma unroll
    for (int i = 0; i < 8; ++i) pvs[i] = *(const f16x8*)(otg + i * 8192);
#pragma unroll
    for (int i = 0; i < 16; ++i) gts[i] = *(const f16x4*)(mp + 32 * (i >> 2) + 8 * (i & 3));
    { float ps; exp_only(c0, c1, m, ps); l += ps; pv_tile(o, vr0 + (nb & 3) * 32768, vr1 + (nb & 3) * 32768, c0, c1); }
  }
#undef NSA_STEP
#undef NSA_ISSUE
  const float scw = g2 / xhalf_sum(l);
#pragma unroll
  for (int d = 0; d < 4; ++d)
#pragma unroll
    for (int g2_ = 0; g2_ < 2; ++g2_) {
      const f16x8 pv = pvs[2 * d + g2_];
#pragma unroll
      for (int q = 0; q < 2; ++q) {
        const int gg = 2 * g2_ + q;
        const f16x4 gt = gts[4 * d + gg]; f16x4 v;
#pragma unroll
        for (int e = 0; e < 4; ++e) v[e] = (f16)(((float)pv[4 * q + e] + scw * o[d][4 * gg + e]) * siluf_((float)gt[e]));
        *(f16x4*)(mp + 32 * d + 8 * gg) = v;
      }
    }
  ring_bar();
}

DI void mem_unit(const Params& p, int b, int hm, int half, char* smem) {
  const int wid = __builtin_amdgcn_readfirstlane(threadIdx.x >> 6);
  int tid_ = threadIdx.x; asm volatile("" : "+v"(tid_)); const int tid = tid_, lane = tid & 63, l31 = lane & 31, h = lane >> 5;
  f16* Z = (f16*)(p.ws + WS_Z);
  LAS unsigned char* lds = (LAS unsigned char*)smem;
  const unsigned ldsw = (unsigned)wid * 1024u;
  const char* Kb = p.ws + WS_KVM + ((size_t)(b * 256) * 1024 + hm * 128) * 2;
  const char* Vb = Kb + 1024;
  const unsigned kvo = dma_voff128(wid, lane, 2048);
  const size_t row0 = (size_t)b * NT + 1024 * half + 32 * wid + l31;
  wait_count((unsigned*)(p.ws + WS_CTR) + 80 + b, 4u);
  f16x8 qa[8], qb[8];
#define MEM_QLOAD(Q, i_) do { const f16* qrow = Z + (row0 + 256 * (i_)) * ZW + ZC_QM + hm * 128 + 8 * h; \
    _Pragma("unroll") for (int s = 0; s < 8; ++s) Q[s] = *(const f16x8*)(qrow + 16 * s); } while (0)
  MEM_QLOAD(qa, 0);
#pragma unroll
  for (int i = 0; i < 4; ++i) dma_kv128(lds + i * 32768, ldsw, Kb + (size_t)(64 * i) * 2048, Vb + (size_t)(64 * i) * 2048, kvo, 2048);
  const unsigned kbe = 2048 * (l31 >> 3) + 64 * (l31 & 7) + 16 * ((h) ^ ((l31 >> 2) & 3));
  const unsigned kbo = 2048 * (l31 >> 3) + 64 * (l31 & 7) + 16 * ((2 + h) ^ ((l31 >> 2) & 3));
  const int q4 = (lane & 15) >> 2, p4 = lane & 3, blk = (lane >> 4) & 1;
  const unsigned sbase = (unsigned)(uintptr_t)smem;
  const unsigned vr0 = sbase + 16384 + 64 * (4 * h + q4) + 16 * ((2 * blk + (p4 >> 1)) ^ (h)) + 8 * (p4 & 1);
  const unsigned vr1 = sbase + 16384 + 64 * (4 * h + q4) + 16 * ((2 * blk + (p4 >> 1)) ^ (2 + h)) + 8 * (p4 & 1);
  asm volatile("s_waitcnt vmcnt(0)" ::: "memory");
  ring_bar();
#define MEM_QTILE(Q, QN, i_) do { \
    f16* mp = Z + (row0 + 256 * (i_)) * ZW + ZC_GATE + 1536 + hm * 128 + 4 * h; \
    f16x4 gts[16]; \
    _Pragma("unroll") for (int i = 0; i < 16; ++i) gts[i] = *(const f16x4*)(mp + 32 * (i >> 2) + 8 * (i & 3)); \
    if ((i_) + 1 < 4) MEM_QLOAD(QN, (i_) + 1); \
    f32x16 o[4]; zero_o(o); \
    float m = NEG, l = 0.f; \
    _Pragma("unroll 1") for (int kt = 0; kt < 4; ++kt) { \
      f32x16 p0, p1; \
      qk128(p0, p1, smem + kt * 32768, Q, kbe, kbo); \
      osm_step(p0, p1, m, l, o); \
      pv_tile(o, vr0 + kt * 32768, vr1 + kt * 32768, p0, p1); \
    } \
    const float inv = 1.f / xhalf_sum(l); \
    _Pragma("unroll") for (int d = 0; d < 4; ++d) \
      _Pragma("unroll") for (int gg = 0; gg < 4; ++gg) { \
        const f16x4 gt = gts[4 * d + gg]; f16x4 v; \
        _Pragma("unroll") for (int e = 0; e < 4; ++e) v[e] = (f16)(o[d][4 * gg + e] * inv * siluf_((float)gt[e])); \
        *(f16x4*)(mp + 32 * d + 8 * gg) = v; \
      } } while (0)
#pragma unroll 1
  for (int i2 = 0; i2 < 4; i2 += 2) { MEM_QTILE(qa, qb, i2); MEM_QTILE(qb, qa, i2 + 1); }
#undef MEM_QTILE
#undef MEM_QLOAD
  ring_bar();
}

DI void ret_qk(f32x16& n0, f32x16& n1, const char* stg, const f16x8 (&qf)[4], int l31, int h, int xx) {
  const f32x16 zero = {0.f, 0.f, 0.f, 0.f, 0.f, 0.f, 0.f, 0.f, 0.f, 0.f, 0.f, 0.f, 0.f, 0.f, 0.f, 0.f};
#pragma unroll
  for (int s = 0; s < 4; ++s) {
    const unsigned cxs = (unsigned)(((2 * s + h) ^ xx) << 4);
    const f16x8 k0 = *(const f16x8*)(stg + l31 * 128 + cxs);
    const f16x8 k1 = *(const f16x8*)(stg + (l31 + 32) * 128 + cxs);
    n0 = MFMA(k0, qf[s], s == 0 ? zero : n0); n1 = MFMA(k1, qf[s], s == 0 ? zero : n1);
  }
}
DI void ret_qk_decay(f32x16& n0, f32x16& n1, const char* stg, const f16x8 (&qf)[4], int l31, int h, int xx, f32x16& c0, f32x16& c1, const float (&fac)[16], float base, float e32) {
  const f32x16 zero = {0.f, 0.f, 0.f, 0.f, 0.f, 0.f, 0.f, 0.f, 0.f, 0.f, 0.f, 0.f, 0.f, 0.f, 0.f, 0.f};
  const float base1 = base * e32;
#pragma unroll
  for (int s = 0; s < 4; ++s) {
    const unsigned cxs = (unsigned)(((2 * s + h) ^ xx) << 4);
    const f16x8 k0 = *(const f16x8*)(stg + l31 * 128 + cxs);
    const f16x8 k1 = *(const f16x8*)(stg + (l31 + 32) * 128 + cxs);
    n0 = MFMA(k0, qf[s], s == 0 ? zero : n0); n1 = MFMA(k1, qf[s], s == 0 ? zero : n1);
#pragma unroll
    for (int j = 0; j < 4; ++j) { const int r = 4 * s + j; c0[r] *= base * fac[r]; c1[r] *= base1 * fac[r]; }
  }
}
DI void ret_decay(f32x16& c0, f32x16& c1, const float (&fac)[16], float base, float e32) {
  const float base1 = base * e32;
#pragma unroll
  for (int r = 0; r < 16; ++r) { c0[r] *= base * fac[r]; c1[r] *= base1 * fac[r]; }
}
DI void ret_unit(const Params& p, int b, int hr, int tq, char* smem) {
  const int wid = __builtin_amdgcn_readfirstlane(threadIdx.x >> 6);
  int tid_ = threadIdx.x; asm volatile("" : "+v"(tid_)); const int tid = tid_, lane = tid & 63, l31 = lane & 31, h = lane >> 5;
  const int t = 256 * tq + 32 * wid + l31;
  const size_t row = (size_t)b * NT + t;
  f16* Z = (f16*)(p.ws + WS_Z);
  LAS unsigned char* lds = (LAS unsigned char*)smem;
  const unsigned ldsw = (unsigned)wid * 1024u;
  const char* Kb = p.ws + WS_Z + ((size_t)b * NT * ZW + ZC_KR + hr * 64) * 2;
  const char* Vb = p.ws + WS_Z + ((size_t)b * NT * ZW + ZC_VR + hr * 128) * 2;
  const unsigned kvo = dma_voff64(wid, lane, ZW * 2), vvo = dma_voff128(wid, lane, ZW * 2);
  const int ntile = 4 * (tq + 1);
#define RET_ISSUE(n_) do { const int n__ = (n_); LAS unsigned char* st__ = lds + (n__ & 3) * 32768; const size_t ko__ = (size_t)(64 * n__) * ZW * 2; \
    glds16(Kb + ko__ + (size_t)kvo, st__ + ldsw); glds16(Vb + ko__ + (size_t)vvo, st__ + 16384 + ldsw); glds16(Vb + ko__ + (size_t)32 * ZW * 2 + (size_t)vvo, st__ + 16384 + ldsw + 8192); } while (0)
#define RET_STEP(n_) do { ring_wait3(issued - 1 - (n_)); ring_bar(); while (issued <= (n_) + 2 && issued < ntile) { RET_ISSUE(issued); ++issued; } } while (0)
  RET_ISSUE(0); RET_ISSUE(1); RET_ISSUE(2);
  int issued = 3;
  f16x8 qf[4];
  {
    const f16* qrow = Z + row * ZW + ZC_QR + hr * 64 + 8 * h;
#pragma unroll
    for (int s = 0; s < 4; ++s) qf[s] = *(const f16x8*)(qrow + 16 * s);
  }
  const float lg = log2f(1.f - exp2f(-5.f - (float)hr));
  float fac[16];
#pragma unroll
  for (int r = 0; r < 16; ++r) fac[r] = fexp2(-lg * (float)crow(r, h));
  const float e32 = fexp2(-lg * 32.f);
  const int xx = (l31 >> 1) & 7;
  const int q4 = (lane & 15) >> 2, p4 = lane & 3, blk = (lane >> 4) & 1;
  const unsigned sbase = (unsigned)(uintptr_t)smem;
  const unsigned vr0 = sbase + 16384 + 64 * (4 * h + q4) + 16 * ((2 * blk + (p4 >> 1)) ^ (h)) + 8 * (p4 & 1);
  const unsigned vr1 = sbase + 16384 + 64 * (4 * h + q4) + 16 * ((2 * blk + (p4 >> 1)) ^ (2 + h)) + 8 * (p4 & 1);
  f32x16 o[4]; zero_o(o);
  const int mykt = 4 * tq + (wid >> 1);
  const int tlw = 32 * (wid & 1) + l31;
  f32x16 c0, c1, x0, x1;
  RET_STEP(0);
  ret_qk(c0, c1, smem, qf, l31, h, xx);
#define RET_BODY(C0, C1, X0, X1) do { \
    RET_STEP(kt + 1); \
    if (kt <= mykt) { \
      const float base = fexp2(lg * (float)(t - 64 * kt)); \
      if (kt < mykt) ret_qk_decay(X0, X1, smem + ((kt + 1) & 3) * 32768, qf, l31, h, xx, C0, C1, fac, base, e32); \
      else { \
        ret_decay(C0, C1, fac, base, e32); \
        int tlx = tlw - 4 * h; asm volatile("" : "+v"(tlx)); \
        _Pragma("unroll") for (int r = 0; r < 16; ++r) { const int key = crow(r, 0); C0[r] = (key <= tlx) ? C0[r] : 0.f; C1[r] = (key + 32 <= tlx) ? C1[r] : 0.f; } \
      } \
      pv_tile(o, vr0 + (kt & 3) * 32768, vr1 + (kt & 3) * 32768, C0, C1); \
    } } while (0)
  int kt = 0;
  for (; kt + 2 < ntile; kt += 2) { RET_BODY(c0, c1, x0, x1); ++kt; RET_BODY(x0, x1, c0, c1); --kt; }
  if (kt + 1 < ntile) { RET_BODY(c0, c1, x0, x1); c0 = x0; c1 = x1; ++kt; }
  if (kt <= mykt) {
    const float base = fexp2(lg * (float)(t - 64 * kt));
    ret_decay(c0, c1, fac, base, e32);
    int tlx = tlw - 4 * h; asm volatile("" : "+v"(tlx));
#pragma unroll
    for (int r = 0; r < 16; ++r) { const int key = crow(r, 0); c0[r] = (key <= tlx) ? c0[r] : 0.f; c1[r] = (key + 32 <= tlx) ? c1[r] : 0.f; }
    pv_tile(o, vr0 + (kt & 3) * 32768, vr1 + (kt & 3) * 32768, c0, c1);
  }
#undef RET_BODY
#undef RET_STEP
#undef RET_ISSUE
  f16* mp = Z + row * ZW + ZC_GATE + 1024 + hr * 128 + 4 * h;
  const float* gn = p.ret_gn + hr * 128 + 4 * h;
  f16x4 gts[16]; f32x4 gvs[16];
#pragma unroll
  for (int i = 0; i < 16; ++i) { gts[i] = *(const f16x4*)(mp + 32 * (i >> 2) + 8 * (i & 3)); gvs[i] = *(const f32x4*)(gn + 32 * (i >> 2) + 8 * (i & 3)); }
  float s1 = 0.f;
#pragma unroll
  for (int d = 0; d < 4; ++d)
#pragma unroll
    for (int r = 0; r < 16; ++r) s1 += o[d][r];
  s1 = xhalf_sum(s1);
  const float mu = s1 * (1.f / 128.f);
  float s2 = 0.f;
#pragma unroll
  for (int d = 0; d < 4; ++d)
#pragma unroll
    for (int r = 0; r < 16; ++r) { float c = o[d][r] - mu; s2 += c * c; }
  s2 = xhalf_sum(s2);
  const float rstd = rsqrtf(s2 * (1.f / 128.f) + 1e-6f);
#pragma unroll
  for (int d = 0; d < 4; ++d)
#pragma unroll
    for (int gg = 0; gg < 4; ++gg) {
      const f16x4 gt = gts[4 * d + gg]; const f32x4 gv = gvs[4 * d + gg]; f16x4 v;
#pragma unroll
      for (int e = 0; e < 4; ++e) v[e] = (f16)((o[d][4 * gg + e] - mu) * rstd * gv[e] * siluf_((float)gt[e]));
      *(f16x4*)(mp + 32 * d + 8 * gg) = v;
    }
  ring_bar();
}

constexpr int ATTN_UNITS = 288 + 64 + 512 + 128 + 1024;
DI unsigned* attn_dispatch(const Params& p, int u, char* smem) {
  int kind, a0, a1;
  if (u < 256) { kind = 3; a0 = u >> 5; a1 = u & 31; }
  else if (u < 288) { kind = 4; a0 = 0; a1 = u - 256; }
  else if (u < 352) { kind = 6; a0 = (u - 288) & 3; a1 = (u - 288) >> 2; }
  else {
    const int v = u - 352;
    if (v < 512) { kind = 1; a0 = 7 - (v >> 6); a1 = v & 63; }
    else if (v < 640) { const int w = v - 512; kind = 2; a0 = w >> 6; a1 = w & 63; }
    else { const int w = v - 640; kind = 0; a0 = 31 - (w >> 5); a1 = w & 31; }
  }
  unsigned* ctrs = (unsigned*)(p.ws + WS_CTR);
  unsigned* pend = nullptr;
  if (p.dry > 1) { const int kb = (kind == 0) ? 2 : (kind == 1) ? 4 : (kind == 2) ? 8 : 16; if (!(p.dry & kb)) return nullptr; }
  if (kind == 0) nsa_unit(p, a1 >> 1, a1 & 1, a0, smem);
  else if (kind == 1) ret_unit(p, a1 >> 2, a1 & 3, a0, smem);
  else if (kind == 2) mem_unit(p, a1 >> 2, a1 & 3, a0, smem);
  else if (kind == 6) { memkv_unit(p, a1, a0, smem); unit_drain(); pend = ctrs + 80 + a1; }
  else if (kind == 3) { csplit_unit(p, a1 >> 4, a1 & 15, a0, smem); pend = ctrs + 16 + a1; }
  else { cfin_unit(p, a1 >> 4, a1 & 15, smem); pend = ctrs + 64 + (a1 & 15); }
  return pend;
}

DI void phase_attn(const Params& p, char* smem, int ulo, int uhi, int cidx) {
  unsigned* ctr = (unsigned*)(p.ws + WS_CTR) + cidx;
  int* su = (int*)(smem + LDS_IMG + 16);
  unsigned* pend = nullptr;
  int nextu = 0;
  if (threadIdx.x == 0) nextu = ulo + (int)blockIdx.x;
  for (;;) {
    if (threadIdx.x == 0) {
      if (pend) publish_arrive(pend);
      *su = nextu;
    }
    __syncthreads();
    const int u = *su;
    __syncthreads();
    if (u >= uhi) { pend = nullptr; break; }
    if (threadIdx.x == 0) nextu = ulo + (int)gridDim.x + (int)atomicAdd(ctr, 1u);
    pend = attn_dispatch(p, u, smem);
  }
}

DI void phase_final(const Params& p) {
  int tid_ = threadIdx.x; asm volatile("" : "+v"(tid_));
  const int tid = tid_ & 511, lane = tid & 63, wid = __builtin_amdgcn_readfirstlane(tid >> 6);
  const float* PSS = (const float*)(p.ws + WS_PSS);
  const int G = gridDim.x;
  f32x4 g[4];
#pragma unroll
  for (int i = 0; i < 4; ++i) g[i] = *(const f32x4*)(p.norm_post + (i >> 1) * 512 + lane * 8 + 4 * (i & 1));
#define FIN_LOAD(Y, X, S, u_) do { const int row_ = (u_) * 8 + wid; \
    S = (lane < 16) ? PSS[(size_t)row_ * 16 + lane] : 0.f; \
    const f16* yi_ = (const f16*)(p.ws + WS_Y) + (size_t)row_ * 1024; const float* xi_ = p.x + (size_t)row_ * 1024; \
    Y[0] = *(const f16x8*)(yi_ + lane * 8); Y[1] = *(const f16x8*)(yi_ + 512 + lane * 8); \
    _Pragma("unroll") for (int i = 0; i < 4; ++i) X[i] = *(const f32x4*)(xi_ + (i >> 1) * 512 + lane * 8 + 4 * (i & 1)); } while (0)
#define FIN_ROW(Y, X, S, u_) do { float ss_ = S; \
    _Pragma("unroll") for (int o = 8; o >= 1; o >>= 1) ss_ += __shfl_xor(ss_, o); \
    ss_ = __shfl(ss_, 0); \
    const float rstd_ = rsqrtf(ss_ * (1.f / 1024.f) + 1e-6f); \
    float* yo_ = p.out + (size_t)((u_) * 8 + wid) * 1024; \
    _Pragma("unroll") for (int i = 0; i < 4; ++i) { const f16x8& y_ = Y[i >> 1]; const int q_ = i & 1; f32x4 r_; \
      r_[0] = X[i][0] + (float)y_[4 * q_] * rstd_ * g[i][0]; r_[1] = X[i][1] + (float)y_[4 * q_ + 1] * rstd_ * g[i][1]; \
      r_[2] = X[i][2] + (float)y_[4 * q_ + 2] * rstd_ * g[i][2]; r_[3] = X[i][3] + (float)y_[4 * q_ + 3] * rstd_ * g[i][3]; \
      *(f32x4*)(yo_ + (i >> 1) * 512 + lane * 8 + 4 * q_) = r_; } } while (0)
  f16x8 ya[2], yb[2]; f32x4 xa[4], xb[4]; float sa = 0.f, sb = 0.f;
  int u = blockIdx.x;
  if (u < NTOK / 8) FIN_LOAD(ya, xa, sa, u);
  while (u < NTOK / 8) {
    { const int un = u + G; if (un < NTOK / 8) FIN_LOAD(yb, xb, sb, un); FIN_ROW(ya, xa, sa, u); u = un; }
    if (u >= NTOK / 8) break;
    { const int un = u + G; if (un < NTOK / 8) FIN_LOAD(ya, xa, sa, un); FIN_ROW(yb, xb, sb, u); u = un; }
  }
#undef FIN_LOAD
#undef FIN_ROW
}

#define XB_TMO      128
#define XB_XCNT(j)  (256  + 64 * (j))
#define XB_XSUB(j)  (1280 + 64 * (j))
#define XB_XGEN(j)  (2304 + 64 * (j))
#define XB_TOP      3328
#define XB_TOPGEN   3392
#define XCD_BAR_WORDS 3456
#define XB_SPIN_CAP (1u << 22)
DI unsigned xb_ld(unsigned* p) { return __hip_atomic_load(p, __ATOMIC_RELAXED, __HIP_MEMORY_SCOPE_AGENT); }
DI unsigned xb_add(unsigned* p, unsigned v) { return __hip_atomic_fetch_add(p, v, __ATOMIC_RELAXED, __HIP_MEMORY_SCOPE_AGENT); }
DI unsigned xb_xcc_id() { return (unsigned)__builtin_amdgcn_s_getreg((3 << 11) | 20) & 0xFu; }
#define XB_SPIN(cond, bar) do { unsigned _sp = 0; while (cond) { __builtin_amdgcn_s_sleep(1); \
    if ((++_sp & 255u) == 0u) { if (xb_ld(&(bar)[XB_TMO])) break; if (_sp > XB_SPIN_CAP) { atomicAdd(&(bar)[XB_TMO], 1u); break; } } } } while (0)
struct XcdBarrier { unsigned* bar; unsigned x; volatile LAS unsigned* st; };
DI XcdBarrier xcd_barrier_post(unsigned* bar, volatile LAS unsigned* st) {
  XcdBarrier b; b.bar = bar; b.x = xb_xcc_id(); b.st = st;
  if (threadIdx.x == 0) (void)xb_add(&bar[XB_XCNT(b.x)], 1u);
  return b;
}
DI void xcd_barrier_complete(unsigned* bar, unsigned x, unsigned& nloc, unsigned& nx) {
  const unsigned G = gridDim.x * gridDim.y * gridDim.z;
  unsigned sum, cnt, mine, sp = 0u;
  for (;;) {
    sum = 0u; cnt = 0u; mine = 0u;
#pragma unroll
    for (unsigned j = 0; j < 16; ++j) { const unsigned c = xb_ld(&bar[XB_XCNT(j)]); sum += c; cnt += (c > 0u) ? 1u : 0u; mine = (j == x) ? c : mine; }
    if (sum == G) break;
    __builtin_amdgcn_s_sleep(1);
    if ((++sp & 255u) == 0u) { if (xb_ld(&bar[XB_TMO])) break; if (sp > XB_SPIN_CAP) { atomicAdd(&bar[XB_TMO], 1u); break; } }
  }
  nloc = mine > 0u ? mine : 1u; nx = cnt > 0u ? cnt : 1u;
}
DI void xcd_barrier(const XcdBarrier& b) {
  asm volatile("s_waitcnt vmcnt(0)" ::: "memory");
  __syncthreads();
  if (threadIdx.x == 0) {
    unsigned* bar = b.bar;
    __builtin_amdgcn_s_waitcnt(0);
    unsigned nloc = b.st[0], nx = b.st[1];
    if (nloc == 0u) { xcd_barrier_complete(bar, b.x, nloc, nx); b.st[0] = nloc; b.st[1] = nx; }
    const unsigned old = xb_add(&bar[XB_XSUB(b.x)], 1u);
    const unsigned gen = old / nloc;
    if (old + 1u == (gen + 1u) * nloc) {
      __builtin_amdgcn_fence(__ATOMIC_RELEASE, "agent");
      asm volatile("s_waitcnt vmcnt(0)" ::: "memory");
      const unsigned og = xb_add(&bar[XB_TOP], 1u);
      const unsigned tg = og / nx;
      if (og + 1u == (tg + 1u) * nx) xb_add(&bar[XB_TOPGEN], 1u);
      else XB_SPIN(xb_ld(&bar[XB_TOPGEN]) == tg, bar);
      __builtin_amdgcn_fence(__ATOMIC_ACQUIRE, "agent");
      xb_add(&bar[XB_XGEN(b.x)], 1u);
      asm volatile("s_waitcnt vmcnt(0)" ::: "memory");
    } else {
      XB_SPIN(xb_ld(&bar[XB_XGEN(b.x)]) == gen, bar);
      __builtin_amdgcn_fence(__ATOMIC_ACQUIRE, "agent");
      asm volatile("s_waitcnt vmcnt(0)" ::: "memory");
    }
  }
  __syncthreads();
}

template <int PH>
__global__ void __launch_bounds__(512, 2) hybrid_kernel(Params p) {
  __shared__ __attribute__((aligned(16))) char smem[LDS_BYTES];
  if (PH == -1) {
    unsigned* bar = (unsigned*)(p.ws + WS_BAR);
    volatile LAS unsigned* xst = (volatile LAS unsigned*)(smem + LDS_IMG);
    if (threadIdx.x == 0) { xst[0] = 0u; xst[1] = 0u; }
    __syncthreads();
    XcdBarrier xb = xcd_barrier_post(bar, xst);
    phase_prep(p, smem); xcd_barrier(xb);
    phase_gemm1(p, smem); xcd_barrier(xb);
    phase_attn(p, smem, 0, ATTN_UNITS, 0); xcd_barrier(xb);
    phase_gemm2(p, smem); xcd_barrier(xb);
    phase_final(p);
  } else {
    if (PH == 0) phase_prep(p, smem);
    if (PH == 1) phase_gemm1(p, smem);
    if (PH == 3) phase_attn(p, smem, 0, ATTN_UNITS, 0);
    if (PH == 4) phase_gemm2(p, smem);
    if (PH == 5) phase_final(p);
  }
}

extern "C" void kernel_launch(void* const* d_in, const int* in_sizes, int n_in, void* d_out, int out_size, void* d_ws, size_t ws_size, hipStream_t stream) {
  if (ws_size < WS_END) { fprintf(stderr, "kernel_launch: workspace too small: %zu < %zu\n", ws_size, (size_t)WS_END); return; }
  Params p{};
  p.x = (const float*)d_in[0]; p.mem = (const float*)d_in[1]; p.pos = (const int*)d_in[2]; p.norm_pre = (const float*)d_in[3]; p.w_in = (const float*)d_in[4];
  p.cpk = (const float*)d_in[5]; p.w1k = (const float*)d_in[6]; p.w2k = (const float*)d_in[7]; p.cpv = (const float*)d_in[8]; p.w1v = (const float*)d_in[9]; p.w2v = (const float*)d_in[10];
  p.ret_gn = (const float*)d_in[11]; p.mem_norm = (const float*)d_in[12]; p.w_mem_kv = (const float*)d_in[13]; p.w_out = (const float*)d_in[14]; p.norm_post = (const float*)d_in[15];
  p.out = (float*)d_out; p.ws = (char*)d_ws;
#if MEGA
  static int grid_blocks = 0;
  if (!grid_blocks) {
    int dev = 0, cus = 0, per_cu = 0;
    hipGetDevice(&dev); hipDeviceGetAttribute(&cus, hipDeviceAttributeMultiprocessorCount, dev);
    hipOccupancyMaxActiveBlocksPerMultiprocessor(&per_cu, hybrid_kernel<-1>, 512, 0);
    if (per_cu < 1) { fprintf(stderr, "kernel_launch: occupancy query returned %d\n", per_cu); return; }
    grid_blocks = cus;
  }
  (void)hipMemsetAsync(p.ws + WS_CTR, 0, WS_Y - WS_CTR, stream);
  hipLaunchKernelGGL(hybrid_kernel<-1>, dim3(grid_blocks), dim3(512), 0, stream, p);
  hipError_t e = hipGetLastError();
  if (e != hipSuccess) fprintf(stderr, "launch failed: %s (grid %d)\n", hipGetErrorString(e), grid_blocks);
#else
  hipLaunchKernelGGL(hybrid_kernel<0>, dim3(256), dim3(512), 0, stream, p);
  if (PROBE_DUP == 0) hipLaunchKernelGGL(hybrid_kernel<0>, dim3(256), dim3(512), 0, stream, p);
  hipLaunchKernelGGL(hybrid_kernel<1>, dim3(256), dim3(512), 0, stream, p);
  if (PROBE_DUP == 1) hipLaunchKernelGGL(hybrid_kernel<1>, dim3(256), dim3(512), 0, stream, p);
  hipLaunchKernelGGL(hybrid_kernel<3>, dim3(256), dim3(512), 0, stream, p);
  if (PROBE_DUP == 3) { Params q = p; q.dry = PROBE_ATT; (void)hipMemsetAsync(p.ws + WS_CTR, 0, 4, stream); hipLaunchKernelGGL(hybrid_kernel<3>, dim3(256), dim3(512), 0, stream, q); }
  hipLaunchKernelGGL(hybrid_kernel<4>, dim3(256), dim3(512), 0, stream, p);
  if (PROBE_DUP == 4) hipLaunchKernelGGL(hybrid_kernel<4>, dim3(256), dim3(512), 0, stream, p);
  hipLaunchKernelGGL(hybrid_kernel<5>, dim3(256), dim3(512), 0, stream, p);
#endif
}
```

```cpp
#include <hip/hip_runtime.h>
#include <hip/hip_cooperative_groups.h>
#include <cstdio>
#include <cstdint>
namespace cg = cooperative_groups;

#ifndef MEGA
#define MEGA 1
#endif
#ifndef PROBE_DUP
#define PROBE_DUP -1
#endif
#ifndef PROBE_ATT
#define PROBE_ATT 1
#endif

typedef _Float16 f16;
typedef _Float16 f16x8 __attribute__((ext_vector_type(8)));
typedef _Float16 f16x4 __attribute__((ext_vector_type(4)));
typedef float f32x16 __attribute__((ext_vector_type(16)));
typedef float f32x4 __attribute__((ext_vector_type(4)));
#define DI __device__ __forceinline__
#define MFMA(a, b, c) __builtin_amdgcn_mfma_f32_32x32x16_f16((a), (b), (c), 0, 0, 0)
#define SBAR() __builtin_amdgcn_sched_barrier(0)
#define LAS __attribute__((address_space(3)))

constexpr int NB = 16, NT = 2048, DM = 1024, NTOK = NB * NT, ZW = 6144;
constexpr int ZC_QN = 0, ZC_KV = 1024, ZC_QR = 2560, ZC_KR = 2816, ZC_VR = 3072, ZC_QM = 3584, ZC_GATE = 4096;
constexpr float QSCALE = 0.08838834764831845f * 1.4426950408889634f;
constexpr float THR = 8.f;
constexpr float NEG = -1e30f;

constexpr size_t al256(size_t x) { return (x + 255) / 256 * 256; }
constexpr size_t WS_Z = 0;
constexpr size_t WS_GATES = WS_Z + (size_t)NTOK * ZW * 2;
constexpr size_t WS_WINT = WS_GATES + (size_t)NTOK * 24 * 4;
constexpr size_t WS_WOUTT = WS_WINT + al256((size_t)6168 * 1024 * 2);
constexpr size_t WS_WMEMT = WS_WOUTT + (size_t)1024 * 2048 * 2;
constexpr size_t WS_W1T = WS_WMEMT + (size_t)1024 * 1024 * 2;
constexpr size_t WS_W2T = WS_W1T + (size_t)2 * 256 * 4096 * 2;
constexpr size_t WS_MEMN = WS_W2T + (size_t)2 * 128 * 256 * 2;
constexpr size_t WS_KVM = WS_MEMN + (size_t)4096 * 1024 * 2;
constexpr size_t WS_ROT = WS_KVM + (size_t)4096 * 1024 * 2;
constexpr size_t WS_PB1 = WS_ROT + (size_t)NTOK * 48 * 2 * 4;
constexpr size_t WS_HID = WS_PB1 + (size_t)2 * 16 * 256 * 4;
constexpr size_t WS_KC = WS_HID + (size_t)2 * 4096 * 256 * 2;
constexpr size_t WS_PSS = WS_KC + (size_t)2 * 4096 * 128 * 2;
constexpr size_t WS_CTR = WS_PSS + (size_t)NTOK * 16 * 4;
constexpr size_t WS_BAR = WS_CTR + 4096;
constexpr size_t WS_Y = WS_BAR + 16384;
constexpr size_t WS_END = WS_Y + (size_t)NTOK * 1024 * 2;

constexpr int LDS_IMG = 8 * 128 * 144;
constexpr int LDS_BYTES = LDS_IMG + 64;

struct Params {
  const float* x; const float* mem; const int* pos; const float* norm_pre; const float* w_in;
  const float* cpk; const float* w1k; const float* w2k; const float* cpv; const float* w1v; const float* w2v;
  const float* ret_gn; const float* mem_norm; const float* w_mem_kv; const float* w_out; const float* norm_post;
  float* out; char* ws;
  int dry;
  int pad_;
};

DI int crow(int r, int h) { return (r & 3) + 8 * (r >> 2) + 4 * h; }
DI unsigned swz128(int r, int c) { return (unsigned)(r * 128 + ((c ^ ((r >> 1) & 7)) << 4)); }
DI unsigned off_a(int row, int ch) { return (unsigned)(2048 * (row >> 3) + 512 * (ch >> 2) + 64 * (row & 7) + 16 * ((ch & 3) ^ ((row >> 2) & 3))); }
DI float xhalf_max(float v) { auto rr = __builtin_amdgcn_permlane32_swap(__float_as_uint(v), __float_as_uint(v), false, false); return fmaxf(__uint_as_float(rr[0]), __uint_as_float(rr[1])); }
DI float xhalf_sum(float v) { auto rr = __builtin_amdgcn_permlane32_swap(__float_as_uint(v), __float_as_uint(v), false, false); return __uint_as_float(rr[0]) + __uint_as_float(rr[1]); }
DI float fexp2(float x) { return __builtin_amdgcn_exp2f(x); }
DI float sigmoidf_(float x) { return __builtin_amdgcn_rcpf(1.f + __expf(-x)); }
DI float siluf_(float x) { return x * __builtin_amdgcn_rcpf(1.f + __expf(-x)); }
DI float gelu_tanh(float x) { float u = 0.7978845608028654f * (x + 0.044715f * x * x * x); float e = __expf(2.f * u); float t = 1.f - 2.f / (e + 1.f); return 0.5f * x * (1.f + t); }
template <int OFF> DI f16x4 tr_read(unsigned addr) { f16x4 r; asm volatile("ds_read_b64_tr_b16 %0, %1 offset:%2" : "=&v"(r) : "v"(addr), "i"(OFF) : "memory"); return r; }

struct TrU { const float* src; f16* dst; int N, ldd, k0, n0, remap; };
DI void tr_decode(const Params& p, int u, TrU& t) {
  char* ws = p.ws;
  int kt, nt; t.remap = 0;
  if (u < 1552) { t.src = p.w_in; t.N = 6168; t.dst = (f16*)(ws + WS_WINT); t.ldd = 1024; kt = u / 97; nt = u - kt * 97; t.remap = 1; }
  else if (u < 2064) { u -= 1552; t.src = p.w_out; t.N = 1024; t.dst = (f16*)(ws + WS_WOUTT); t.ldd = 2048; kt = u >> 4; nt = u & 15; }
  else if (u < 2320) { u -= 2064; t.src = p.w_mem_kv; t.N = 1024; t.dst = (f16*)(ws + WS_WMEMT); t.ldd = 1024; kt = u >> 4; nt = u & 15; }
  else if (u < 2832) { u -= 2320; const int kv = u >> 8, v = u & 255; t.src = kv ? p.w1v : p.w1k; t.N = 256; t.dst = (f16*)(ws + WS_W1T) + (size_t)kv * 256 * 4096; t.ldd = 4096; kt = v >> 2; nt = v & 3; }
  else { u -= 2832; const int kv = u >> 3, v = u & 7; t.src = kv ? p.w2v : p.w2k; t.N = 128; t.dst = (f16*)(ws + WS_W2T) + (size_t)kv * 128 * 256; t.ldd = 256; kt = v >> 1; nt = v & 1; }
  t.k0 = kt * 64; t.n0 = nt * 64;
}
DI void tr_load(const TrU& t, float (&v)[8], int tid) {
#pragma unroll
  for (int i = 0; i < 8; ++i) { const int e = tid + 512 * i, kk = e >> 6, nn = e & 63; const int n = min(t.n0 + nn, t.N - 1); v[i] = t.src[(size_t)(t.k0 + kk) * t.N + n]; }
}
constexpr int N_TR_UNITS = 2848;

#define MFMA16(a, b, c) __builtin_amdgcn_mfma_f32_16x16x32_f16((a), (b), (c), 0, 0, 0)
DI void phase_prep(const Params& p, char* smem) {
  const int tid = threadIdx.x, lane = tid & 63, wid = tid >> 6;
  const int G = gridDim.x;
  char* ws = p.ws;
  if (blockIdx.x == 0 && tid < 128) ((unsigned*)(ws + WS_CTR))[tid] = 0u;
  {
    LAS unsigned char* lds_ = (LAS unsigned char*)smem;
    {
      float wv[48];
#pragma unroll
      for (int i = 0; i < 48; ++i) { const int e = tid + 512 * i, k = e / 24, n = e - 24 * k; wv[i] = p.w_in[(size_t)k * 6168 + 2560 + n]; }
#pragma unroll
      for (int i = 0; i < 48; ++i) { const int e = tid + 512 * i, k = e / 24, n = e - 24 * k; *(LAS f16*)(lds_ + 32768 + n * 2064 + k * 2) = (f16)wv[i]; }
    }
    for (int e = tid; e < 8 * 1032; e += 512) { const int n = 24 + e / 1032, k = e % 1032; *(LAS f16*)(lds_ + 32768 + n * 2064 + k * 2) = (f16)0.f; }
    __syncthreads();
  }
  {
    float* tile = (float*)smem;
    int u = blockIdx.x; TrU t; float v[8];
    if (u < N_TR_UNITS) { tr_decode(p, u, t); tr_load(t, v, tid); }
    while (u < N_TR_UNITS) {
#pragma unroll
      for (int i = 0; i < 8; ++i) { const int e = tid + 512 * i; tile[(e >> 6) * 65 + (e & 63)] = v[i]; }
      __syncthreads();
      TrU tn = t; const int un = u + G;
      if (un < N_TR_UNITS) { tr_decode(p, un, tn); tr_load(tn, v, tid); }
#pragma unroll
      for (int i = 0; i < 4; ++i) {
        const int e = tid + 512 * i, nn = e >> 5, kk = (e & 31) * 2; const int n = t.n0 + nn;
        if (n < t.N) {
          int nd = n;
          if (t.remap) nd = (n < 2560) ? n : ((n < 2584) ? (6144 + n - 2560) : (n - 24));
          typedef _Float16 h2 __attribute__((ext_vector_type(2)));
          h2 w; w[0] = (f16)tile[kk * 65 + nn]; w[1] = (f16)tile[(kk + 1) * 65 + nn];
          *(h2*)(t.dst + (size_t)nd * t.ldd + t.k0 + kk) = w;
        }
      }
      __syncthreads();
      t = tn; u = un;
    }
  }
  f16* H = (f16*)p.out; f16* MEMN = (f16*)(ws + WS_MEMN);
#define RMS_ROW(V, DST) do { float ss_ = 0.f; \
      _Pragma("unroll") for (int i = 0; i < 4; ++i) ss_ += V[i][0] * V[i][0] + V[i][1] * V[i][1] + V[i][2] * V[i][2] + V[i][3] * V[i][3]; \
      _Pragma("unroll") for (int o = 32; o >= 1; o >>= 1) ss_ += __shfl_xor(ss_, o); \
      const float rstd_ = rsqrtf(ss_ * (1.f / 1024.f) + 1e-6f); \
      _Pragma("unroll") for (int i = 0; i < 4; ++i) { f16x4 o4; o4[0] = (f16)(V[i][0] * rstd_ * gn[i][0]); o4[1] = (f16)(V[i][1] * rstd_ * gn[i][1]); o4[2] = (f16)(V[i][2] * rstd_ * gn[i][2]); o4[3] = (f16)(V[i][3] * rstd_ * gn[i][3]); \
        *(f16x4*)((DST) + i * 256 + lane * 4) = o4; } } while (0)
#define RMS_LOAD(V, SRC) do { _Pragma("unroll") for (int i = 0; i < 4; ++i) V[i] = __builtin_nontemporal_load((const f32x4*)((SRC) + i * 256 + lane * 4)); } while (0)
  {
    f32x4 gn[4];
#pragma unroll
    for (int i = 0; i < 4; ++i) gn[i] = *(const f32x4*)(p.norm_pre + i * 256 + lane * 4);
    f32x4 va[4], vb[4], na[4], nb[4];
    float* GATES = (float*)(ws + WS_GATES);
    LAS unsigned char* lds_ = (LAS unsigned char*)smem;
    const int fr = lane & 15, fq = lane >> 4;
    for (int gi = blockIdx.x; gi < NTOK / 128; gi += G) {
      const int rowbase = 128 * gi + 16 * wid;
      { const float* s0 = p.x + (size_t)rowbase * 1024; RMS_LOAD(va, s0); RMS_LOAD(vb, s0 + 1024); }
#define RMS_STEP(CA, CB, NA, NB, j_) do { \
        if ((j_) + 1 < 8) { const float* s0 = p.x + (size_t)(rowbase + 2 * ((j_) + 1)) * 1024; RMS_LOAD(NA, s0); RMS_LOAD(NB, s0 + 1024); } \
        f16* d0 = H + (size_t)(rowbase + 2 * (j_)) * 1024; \
        RMS_ROW(CA, d0); RMS_ROW(CB, d0 + 1024); } while (0)
#pragma unroll 1
      for (int j = 0; j < 8; j += 2) { RMS_STEP(va, vb, na, nb, j); RMS_STEP(na, nb, va, vb, j + 1); }
#undef RMS_STEP
      asm volatile("s_waitcnt vmcnt(0)" ::: "memory");
      const f16* hrow = H + (size_t)(rowbase + fr) * 1024 + 8 * fq;
      f32x4 g0 = {0.f, 0.f, 0.f, 0.f}, g1 = {0.f, 0.f, 0.f, 0.f};
#pragma unroll 1
      for (int k0 = 0; k0 < 32; k0 += 16) {
        f16x8 af[16];
#pragma unroll
        for (int k = 0; k < 16; ++k) af[k] = *(const f16x8*)(hrow + 32 * (k0 + k));
#pragma unroll
        for (int k = 0; k < 16; ++k) {
          const f16x8 b0 = *(const LAS f16x8*)(lds_ + 32768 + fr * 2064 + (32 * (k0 + k) + 8 * fq) * 2);
          const f16x8 b1 = *(const LAS f16x8*)(lds_ + 32768 + (16 + fr) * 2064 + (32 * (k0 + k) + 8 * fq) * 2);
          g0 = MFMA16(b0, af[k], g0); g1 = MFMA16(b1, af[k], g1);
        }
      }
      float* gp = GATES + (size_t)(rowbase + fr) * 24 + 4 * fq;
#pragma unroll
      for (int j = 0; j < 4; ++j) { g0[j] = sigmoidf_(g0[j]); g1[j] = sigmoidf_(g1[j]); }
      *(f32x4*)gp = g0;
      if (fq < 2) *(f32x4*)(gp + 16) = g1;
    }
  }
  {
    f32x4 gn[4];
#pragma unroll
    for (int i = 0; i < 4; ++i) gn[i] = *(const f32x4*)(p.mem_norm + i * 256 + lane * 4);
    for (int u = blockIdx.x; u < 4096 / 8; u += G) {
      f32x4 va[4]; const int row = u * 8 + wid;
      RMS_LOAD(va, p.mem + (size_t)row * 1024);
      RMS_ROW(va, MEMN + (size_t)row * 1024);
    }
  }
#undef RMS_ROW
#undef RMS_LOAD
  float* ROT = (float*)(ws + WS_ROT);
  for (int e = blockIdx.x * 512 + tid; e < NTOK * 48; e += G * 512) {
    int tok = e / 48, f = e - tok * 48;
    float invf;
    if (f < 16) invf = exp2f(-((float)f / 16.f) * 18.931568569324174f);
    else invf = exp2f(-((float)(f - 16) / 32.f) * 13.287712379549449f);
    const float ang = (float)p.pos[tok] * invf;
    float sn, cs; sincosf(ang, &sn, &cs);
    ROT[(size_t)e * 2] = cs; ROT[(size_t)e * 2 + 1] = sn;
  }
  float* PB1 = (float*)(ws + WS_PB1);
  for (int u = G - 1 - (int)blockIdx.x; u < 32; u += G) {
    const int kv = u >> 4, ch = u & 15; const float* w1 = kv ? p.w1v : p.w1k; const float* cp = kv ? p.cpv : p.cpk;
    const int i0 = ch * 256 + wid * 32;
    f32x4 acc = {0.f, 0.f, 0.f, 0.f};
#pragma unroll 16
    for (int i = 0; i < 32; ++i) { const float c = cp[i0 + i]; const f32x4 w = *(const f32x4*)(w1 + (size_t)(i0 + i) * 256 + lane * 4); acc[0] += c * w[0]; acc[1] += c * w[1]; acc[2] += c * w[2]; acc[3] += c * w[3]; }
    float* red = (float*)smem;
    *(f32x4*)(red + wid * 256 + lane * 4) = acc;
    __syncthreads();
    if (tid < 256) { float sacc = 0.f;
#pragma unroll
      for (int w = 0; w < 8; ++w) sacc += red[w * 256 + tid];
      PB1[(kv * 16 + ch) * 256 + tid] = sacc; }
    __syncthreads();
  }
}

template <class KA, class KB>
DI void gemm_core(f32x16 (&acc)[4][2], const char* baseA, long strideA, unsigned voffA, const char* baseB, long strideB, unsigned voffB,
                  KA koffA, KB koffB, int nk, char* smem) {
  int tid_ = threadIdx.x; asm volatile("" : "+v"(tid_)); const int tid = tid_, lane = tid & 63, wid = tid >> 6, wm = wid >> 2, wn = wid & 3;
  const int lr = tid >> 3, lc = tid & 7;
  const unsigned so = swz128(lr, lc);
  f16x8 ra[4], rb[4], sa[4], sb[4];
#define GLOAD(RA, RB, kt) do { const char* a_ = baseA + koffA(kt) * 2; const char* b_ = baseB + koffB(kt) * 2; \
    RA[0] = *(const f16x8*)(a_ + (size_t)voffA); RA[1] = *(const f16x8*)(a_ + strideA + (size_t)voffA); RA[2] = *(const f16x8*)(a_ + 2 * strideA + (size_t)voffA); RA[3] = *(const f16x8*)(a_ + 3 * strideA + (size_t)voffA); \
    RB[0] = *(const f16x8*)(b_ + (size_t)voffB); RB[1] = *(const f16x8*)(b_ + strideB + (size_t)voffB); RB[2] = *(const f16x8*)(b_ + 2 * strideB + (size_t)voffB); RB[3] = *(const f16x8*)(b_ + 3 * strideB + (size_t)voffB); } while (0)
#define LSTORE(RA, RB, st) do { char* b_ = smem + (st) * 65536 + so; \
    *(f16x8*)(b_) = RA[0]; *(f16x8*)(b_ + 8192) = RA[1]; *(f16x8*)(b_ + 16384) = RA[2]; *(f16x8*)(b_ + 24576) = RA[3]; \
    *(f16x8*)(b_ + 32768) = RB[0]; *(f16x8*)(b_ + 32768 + 8192) = RB[1]; *(f16x8*)(b_ + 32768 + 16384) = RB[2]; *(f16x8*)(b_ + 32768 + 24576) = RB[3]; } while (0)
  const int l31 = lane & 31, h = lane >> 5, xx = (l31 >> 1) & 7;
  const unsigned fbase = l31 * 128;
  unsigned cx[4];
#pragma unroll
  for (int s = 0; s < 4; ++s) cx[s] = (unsigned)(((2 * s + h) ^ xx) << 4);
#define COMPUTE(kt) do { \
      const char* A = smem + ((kt) & 1) * 65536 + (128 * wm) * 128 + fbase; \
      const char* Bm = smem + ((kt) & 1) * 65536 + 32768 + (64 * wn) * 128 + fbase; \
      _Pragma("unroll") for (int s = 0; s < 4; ++s) { \
        f16x8 hf[4], wf[2]; \
        _Pragma("unroll") for (int i = 0; i < 4; ++i) hf[i] = *(const f16x8*)(A + i * 4096 + cx[s]); \
        _Pragma("unroll") for (int j = 0; j < 2; ++j) wf[j] = *(const f16x8*)(Bm + j * 4096 + cx[s]); \
        _Pragma("unroll") for (int i = 0; i < 4; ++i) _Pragma("unroll") for (int j = 0; j < 2; ++j) acc[i][j] = MFMA(wf[j], hf[i], acc[i][j]); \
      } } while (0)
  GLOAD(ra, rb, 0); GLOAD(sa, sb, 1);
  LSTORE(ra, rb, 0); __syncthreads();
  for (int kt = 0; kt < nk; kt += 2) {
    if (kt + 2 < nk) GLOAD(ra, rb, kt + 2);
    COMPUTE(kt);
    LSTORE(sa, sb, 1);
    __syncthreads();
    if (kt + 3 < nk) GLOAD(sa, sb, kt + 3);
    COMPUTE(kt + 1);
    if (kt + 2 < nk) LSTORE(ra, rb, 0);
    __syncthreads();
  }
#undef GLOAD
#undef LSTORE
#undef COMPUTE
}

template <class XF>
DI void store_tile_f16(const f32x16 (&acc)[4][2], f16* dst, long ld, char* smem, bool active, XF xf) {
  int tid_ = threadIdx.x; asm volatile("" : "+v"(tid_)); const int tid = tid_, lane = tid & 63, wid = tid >> 6, wm = wid >> 2, wn = wid & 3, l31 = lane & 31, h = lane >> 5;
  char* img = smem + wid * (128 * 144);
#pragma unroll
  for (int i = 0; i < 4; ++i)
#pragma unroll
    for (int j = 0; j < 2; ++j)
#pragma unroll
      for (int g = 0; g < 4; ++g) {
        f16x4 v; v[0] = (f16)acc[i][j][4 * g]; v[1] = (f16)acc[i][j][4 * g + 1]; v[2] = (f16)acc[i][j][4 * g + 2]; v[3] = (f16)acc[i][j][4 * g + 3];
        *(f16x4*)(img + (32 * i + l31) * 144 + (32 * j + 8 * g + 4 * h) * 2) = v;
      }
  __syncthreads();
  if (active) {
    f16* d = dst + (long)(128 * wm) * ld + 64 * wn;
#pragma unroll 2
    for (int it = 0; it < 16; ++it) {
      const int row = it * 8 + (lane >> 3), ch = lane & 7;
      const char* rowp = img + row * 144;
      f16x8 v = *(const f16x8*)(rowp + ch * 16);
      v = xf(v, rowp, 128 * wm + row, wn, ch);
      *(f16x8*)(d + (long)row * ld + ch * 8) = v;
    }
  }
  __syncthreads();
}
struct XfNone { DI f16x8 operator()(f16x8 v, const char*, int, int, int) const { return v; } };
struct XfGelu { DI f16x8 operator()(f16x8 v, const char*, int, int, int) const { f16x8 r;
#pragma unroll
  for (int e = 0; e < 8; ++e) r[e] = (f16)gelu_tanh((float)v[e]);
  return r; } };
struct XfZ {
  int seg; const float* rot;
  DI f16x8 operator()(f16x8 v, const char* rowp, int trow, int wn, int ch) const {
    f16x8 r = v;
    if (seg == 6) {
#pragma unroll
      for (int e = 0; e < 8; ++e) r[e] = (f16)siluf_((float)v[e]);
    } else if (seg == 0 || seg == 1) {
      float sc = (seg == 0) ? QSCALE : 1.f;
      if (((wn & 1) == 0) && ch < 4) {
        const f16x8 pv = *(const f16x8*)(rowp + (ch ^ 2) * 16);
        const float* rp = rot + (size_t)trow * 96 + 16 * (ch & 1);
        const bool first = ch < 2;
#pragma unroll
        for (int e2 = 0; e2 < 4; ++e2) {
          const f32x4 cs = *(const f32x4*)(rp + 4 * e2);
#pragma unroll
          for (int q = 0; q < 2; ++q) {
            const int e = 2 * e2 + q; const float c = cs[2 * q], sn = cs[2 * q + 1];
            const float x1 = first ? (float)v[e] : (float)pv[e], x2 = first ? (float)pv[e] : (float)v[e];
            r[e] = (f16)((first ? (x1 * c - x2 * sn) : (x1 * sn + x2 * c)) * sc);
          }
        }
      } else {
#pragma unroll
        for (int e = 0; e < 8; ++e) r[e] = (f16)((float)v[e] * sc);
      }
    } else if (seg == 3 || seg == 4) {
      const float sc = (seg == 4) ? 0.125f : 1.f;
      const f16x8 pv = *(const f16x8*)(rowp + (ch ^ 4) * 16);
      const float* rp = rot + (size_t)trow * 96 + 32 + 16 * (ch & 3);
      const bool first = ch < 4;
#pragma unroll
      for (int e2 = 0; e2 < 4; ++e2) {
        const f32x4 cs = *(const f32x4*)(rp + 4 * e2);
#pragma unroll
        for (int q = 0; q < 2; ++q) {
          const int e = 2 * e2 + q; const float c = cs[2 * q], sn = cs[2 * q + 1];
          const float x1 = first ? (float)v[e] : (float)pv[e], x2 = first ? (float)pv[e] : (float)v[e];
          r[e] = (f16)((first ? (x1 * c - x2 * sn) : (x1 * sn + x2 * c)) * sc);
        }
      }
    } else if (seg == 5) {
#pragma unroll
      for (int e = 0; e < 8; ++e) r[e] = (f16)((float)v[e] * QSCALE);
    }
    return r;
  }
};

struct KStd { DI long operator()(int kt) const { return (long)kt * 64; } };
struct KCmp { DI long operator()(int kt) const { return (long)(kt >> 1) * ZW + (kt & 1) * 64; } };

DI void zero_acc(f32x16 (&acc)[4][2]) {
#pragma unroll
  for (int i = 0; i < 4; ++i)
#pragma unroll
    for (int j = 0; j < 2; ++j)
#pragma unroll
      for (int r = 0; r < 16; ++r) acc[i][j][r] = 0.f;
}


constexpr int HTB = 128 * 64 * 2;
DI int lds_byte(int r, int c) { const int st = (r >> 4) * 2 + (c >> 5), rr = r & 15, cc = c & 31, ob = rr * 64 + cc * 2; return st * 1024 + (ob ^ (((ob >> 9) & 1) << 5)); }
DI void stage_rc(int b, int& R, int& C) { const int st = b / 1024, sb = b % 1024, swz = sb ^ (((sb >> 9) & 1) << 5); R = (st >> 1) * 16 + swz / 64; C = (st & 1) * 32 + (swz % 64) / 2; }
DI int perm32(int rho) { const int n = rho >> 4, i = rho & 15; return 8 * (i >> 2) + 4 * n + (i & 3); }
DI int brow_of(int bmode, int h, int R) {
  return bmode == 0 ? 128 * h + R : (bmode == 1 ? 128 * h + (R & ~31) + perm32(R & 31) : 64 * (R >> 5) + 32 * h + perm32(R & 31));
}
struct GUnit { const char* A; const char* B; int bmode, seg, pm, pn; };

template <bool PEEL, class Sched, class Epi>
DI void gemm_stream(LAS unsigned char* lds, int K, long lda, long ldb, const Sched& S, const Epi& E) {
  int tid_ = threadIdx.x; asm volatile("" : "+v"(tid_));
  const int tid = tid_ & 511, wid = __builtin_amdgcn_readfirstlane(tid >> 6), lane = tid & 63, wr = wid >> 2, wc = wid & 3, fr = lane & 15, fq = lane >> 4;
  const int nt = K / 64;
  unsigned voffA, voffB; long stepB, halfB;
  const long stepA = 64 * lda;
  { int R_, C_; stage_rc(tid * 16, R_, C_); voffA = (unsigned)(R_ * lda + C_ * 2); }
  const size_t kstep = 128, hstepA = (size_t)128 * lda;
  const unsigned ldsw = (unsigned)wid * 1024u;
  const int aoff = lds_byte(wr * 64 + fr, fq * 8), boff = lds_byte(wc * 32 + fr, fq * 8);
#define GS_SA(b, h) (((b) * 2 + (h)) * HTB)
#define GS_SB(b, h) ((4 + (b) * 2 + (h)) * HTB)
#define GS_STAGE(bufoff, gbase, voff, step) do { \
    __builtin_amdgcn_global_load_lds((const unsigned*)((const char*)(gbase) + (voff)), (LAS unsigned*)(lds + (bufoff) + ldsw), 16, 0, 0); \
    __builtin_amdgcn_global_load_lds((const unsigned*)((const char*)(gbase) + (step) + (voff)), (LAS unsigned*)(lds + (bufoff) + ldsw + 8192), 16, 0, 0); } while (0)
#define GS_LDA(dst, b, h) do { _Pragma("unroll") for (int m = 0; m < 4; ++m) _Pragma("unroll") for (int k = 0; k < 2; ++k) dst[m][k] = *(const LAS f16x8*)(lds + GS_SA(b, h) + aoff + m * 2048 + k * 1024); } while (0)
#define GS_LDB(dst, b, h) do { _Pragma("unroll") for (int n = 0; n < 2; ++n) _Pragma("unroll") for (int k = 0; k < 2; ++k) dst[n][k] = *(const LAS f16x8*)(lds + GS_SB(b, h) + boff + n * 2048 + k * 1024); } while (0)
#define GS_MMA(ai, bj, At, Bt) do { __builtin_amdgcn_s_setprio(1); _Pragma("unroll") for (int m = 0; m < 4; ++m) _Pragma("unroll") for (int n = 0; n < 2; ++n) _Pragma("unroll") for (int k = 0; k < 2; ++k) \
    acc[ai][bj][m][n] = MFMA16(Bt[n][k], At[m][k], acc[ai][bj][m][n]); __builtin_amdgcn_s_setprio(0); } while (0)
#define GS_WAIT_V(n) asm volatile("s_waitcnt vmcnt(" #n ")" ::: "memory")
#define GS_WAIT_L(n) asm volatile("s_waitcnt lgkmcnt(" #n ")" ::: "memory")
#define GS_BAR __builtin_amdgcn_s_barrier()
#define GS_SCHED __builtin_amdgcn_sched_barrier(0)
#define GS_SETB(mode) do { int tq_ = threadIdx.x; asm volatile("" : "+v"(tq_)); int R_, C_; stage_rc(tq_ * 16, R_, C_); \
    voffB = (unsigned)(brow_of(mode, 0, R_) * ldb + C_ * 2); stepB = ((mode) == 2 ? 128 : 64) * ldb; halfB = ((mode) == 2 ? 32 : 128) * ldb; } while (0)
  GUnit cur, nxt; int ui = 0;
  if (!S.next(0, cur)) return;
  f32x4 acc[2][2][4][2];
#pragma unroll
  for (int a = 0; a < 2; ++a)
#pragma unroll
    for (int b = 0; b < 2; ++b)
#pragma unroll
      for (int m = 0; m < 4; ++m)
#pragma unroll
        for (int n = 0; n < 2; ++n) { acc[a][b][m][n] = (f32x4){0.f, 0.f, 0.f, 0.f}; asm volatile("" : "+v"(acc[a][b][m][n])); }
  f16x8 At[4][2], B0[2][2], B1[2][2];
  const char* cA = cur.A; const char* cB = cur.B;
  GS_SETB(cur.bmode);
  GS_STAGE(GS_SB(0, 0), cB, voffB, stepB); GS_STAGE(GS_SA(0, 0), cA, voffA, stepA); GS_STAGE(GS_SB(0, 1), (cB) + halfB, voffB, stepB); GS_STAGE(GS_SA(0, 1), cA + hstepA, voffA, stepA);
  if (wr == 1) GS_BAR;
  GS_WAIT_V(4); GS_BAR;
  GS_STAGE(GS_SB(1, 0), cB + kstep, voffB, stepB); GS_STAGE(GS_SA(1, 0), cA + kstep, voffA, stepA); GS_STAGE(GS_SB(1, 1), (cB + kstep) + halfB, voffB, stepB);
  if (PEEL) { GS_STAGE(GS_SA(1, 1), cA + kstep + hstepA, voffA, stepA); GS_WAIT_V(0); } else GS_WAIT_V(6);
  GS_BAR;
  for (;;) {
    const bool has_next = S.next(ui + 1, nxt);
    const char* nA = has_next ? nxt.A : cA; const char* nB = has_next ? nxt.B : cB;
#define GS_TRIP(t, EARLY) do { \
      const bool last = (t == nt - 2); \
      const char* a1 = cA + (size_t)(t + 1) * kstep; \
      const char* a2 = last ? nA : cA + (size_t)(t + 2) * kstep; const char* b2 = last ? nB : cB + (size_t)(t + 2) * kstep; \
      const char* a3 = a2 + kstep; const char* b3 = b2 + kstep; \
      if (last && has_next) GS_SETB(nxt.bmode);            \
        \
      GS_LDB(B0, 0, 0); GS_SCHED; GS_LDA(At, 0, 0); if (!(EARLY)) GS_STAGE(GS_SA(1, 1), a1 + hstepA, voffA, stepA); \
      GS_WAIT_L(8); GS_BAR; GS_WAIT_L(0); GS_MMA(0, 0, At, B0); GS_BAR; GS_SCHED; \
        \
      GS_LDB(B1, 0, 1); GS_STAGE(GS_SB(0, 0), b2, voffB, stepB); \
      GS_BAR; GS_WAIT_L(0); GS_MMA(0, 1, At, B1); GS_BAR; \
        \
      GS_LDA(At, 0, 1); GS_STAGE(GS_SA(0, 0), a2, voffA, stepA); \
      GS_BAR; GS_WAIT_L(0); GS_MMA(1, 0, At, B0); GS_BAR; GS_SCHED; \
        \
      GS_STAGE(GS_SB(0, 1), (b2) + halfB, voffB, stepB); \
      if (!(EARLY)) GS_WAIT_V(6); GS_BAR; GS_MMA(1, 1, At, B1); GS_BAR; \
        \
      GS_LDB(B0, 1, 0); GS_SCHED; GS_LDA(At, 1, 0); GS_STAGE(GS_SA(0, 1), a2 + hstepA, voffA, stepA); \
      GS_WAIT_L(8); GS_BAR; GS_WAIT_L(0); GS_MMA(0, 0, At, B0); GS_BAR; GS_SCHED; \
        \
      GS_LDB(B1, 1, 1); GS_STAGE(GS_SB(1, 0), b3, voffB, stepB); \
      GS_BAR; GS_WAIT_L(0); GS_MMA(0, 1, At, B1); GS_BAR; \
        \
      GS_LDA(At, 1, 1); GS_STAGE(GS_SA(1, 0), a3, voffA, stepA); \
      GS_BAR; GS_WAIT_L(0); GS_MMA(1, 0, At, B0); GS_BAR; GS_SCHED; \
        \
      GS_STAGE(GS_SB(1, 1), (b3) + halfB, voffB, stepB); \
      GS_WAIT_V(6); GS_BAR; GS_MMA(1, 1, At, B1); GS_BAR; \
     \
    } while (0)
    if (PEEL) { GS_TRIP(0, 1); for (int t = 2; t < nt; t += 2) { GS_TRIP(t, 0); } }
    else { for (int t = 0; t < nt; t += 2) { GS_TRIP(t, 0); } }
#undef GS_TRIP
    if (PEEL && has_next) {
      GS_STAGE(GS_SA(1, 1), nA + kstep + hstepA, voffA, stepA);
      GS_WAIT_V(0);
    }
    E(acc, cur, wr, wc, fr, fq);
    if (!has_next) break;
#pragma unroll
    for (int a = 0; a < 2; ++a)
#pragma unroll
      for (int b = 0; b < 2; ++b)
#pragma unroll
        for (int m = 0; m < 4; ++m)
#pragma unroll
          for (int n = 0; n < 2; ++n) { acc[a][b][m][n] = (f32x4){0.f, 0.f, 0.f, 0.f}; asm volatile("" : "+v"(acc[a][b][m][n])); }
    cur = nxt; cA = nA; cB = nB; ++ui;
  }
  GS_WAIT_V(0);
  if (wr == 0) GS_BAR;
  GS_BAR;
#undef GS_SA
#undef GS_SB
#undef GS_STAGE
#undef GS_LDA
#undef GS_LDB
#undef GS_MMA
#undef GS_WAIT_V
#undef GS_WAIT_L
#undef GS_BAR
#undef GS_SCHED
#undef GS_SETB
}

struct Sched1 {
  const char* H; const char* W; const char* MEMN; const char* WMEM; int b, G;
  DI bool next(int i, GUnit& u) const {
    int kind, mt, nt;
    if (G == 256) {
      if (i < 12) { const int xcd = b & 7, l = b >> 3; const int st = i * 8 + xcd; const int mg = st / 3, ng = st % 3; kind = 0; mt = mg * 4 + (l & 3); nt = ng * 8 + (l >> 2); }
      else return false;
    } else {
      const int L = i * G + b;
      if (L < 3072) { kind = 0; mt = L / 24; nt = L % 24; }
      else return false;
    }
    u.pm = mt; u.pn = nt;
    if (kind == 1) { u.A = MEMN + (size_t)mt * 256 * 2048; u.B = WMEM + (size_t)nt * 256 * 2048; u.seg = 8; u.bmode = 1; return true; }
    int seg = 2;
    if (nt == 4 || nt == 6 || nt == 8) seg = 1;     else if (nt == 10) seg = 3; else if (nt == 11) seg = 4;
    else if (nt == 14 || nt == 15) seg = 5; else if (nt >= 16 && nt < 24) seg = 6; else if (nt == 24) seg = 7;
    u.seg = seg; u.bmode = (seg <= 1) ? 0 : ((seg == 3 || seg == 4) ? 2 : 1);
    u.A = H + (size_t)mt * 256 * 2048; u.B = W + (size_t)(nt < 24 ? nt * 256 : 6144) * 2048;
    return true;
  }
};
DI unsigned pk2(float a, float b) { typedef _Float16 h2 __attribute__((ext_vector_type(2))); h2 v; v[0] = (f16)a; v[1] = (f16)b; return __builtin_bit_cast(unsigned, v); }
struct Epi1 {
  f16* Z; f16* KVM; float* GATES; const float* ROT;
  DI void operator()(const f32x4 (&acc)[2][2][4][2], const GUnit& u, int wr, int wc, int fr, int fq) const {
    typedef unsigned u32x4_ __attribute__((ext_vector_type(4)));
    typedef unsigned u32x2_ __attribute__((ext_vector_type(2)));
    const int seg = u.seg;
    const int row0 = u.pm * 256 + wr * 64 + fr;
    if (seg == 7) {
      if (wc == 0 && fq < 3) {
#pragma unroll
        for (int ai = 0; ai < 2; ++ai)
#pragma unroll
          for (int m = 0; m < 4; ++m) {
            float* gp = GATES + (size_t)(row0 + ai * 128 + m * 16) * 24 + 8 * fq;
            f32x4 v0 = acc[ai][0][m][0], v1 = acc[ai][0][m][1];
#pragma unroll
            for (int j = 0; j < 4; ++j) { v0[j] = sigmoidf_(v0[j]); v1[j] = sigmoidf_(v1[j]); }
            *(f32x4*)gp = v0; *(f32x4*)(gp + 4) = v1;
          }
      }
      return;
    }
    if (seg == 0 || seg == 1) {
      const float sc = (seg == 0) ? QSCALE : 1.f;
      if (wc == 0) {
#pragma unroll
        for (int ai = 0; ai < 2; ++ai) {
          f32x4 ca[4], cb[4];
#pragma unroll
          for (int m = 0; m < 4; ++m) { const float* rp = ROT + (size_t)(row0 + ai * 128 + m * 16) * 96 + 8 * fq; ca[m] = *(const f32x4*)rp; cb[m] = *(const f32x4*)(rp + 4); }
#pragma unroll
          for (int m = 0; m < 4; ++m) {
            f16* zp = Z + (size_t)(row0 + ai * 128 + m * 16) * ZW + u.pn * 256 + 4 * fq;
            const float cs[4] = {ca[m][0], ca[m][2], cb[m][0], cb[m][2]}, sn[4] = {ca[m][1], ca[m][3], cb[m][1], cb[m][3]};
#pragma unroll
            for (int bj = 0; bj < 2; ++bj) {
              const f32x4 x1 = acc[ai][bj][m][0], x2 = acc[ai][bj][m][1];
              f32x4 o1, o2;
#pragma unroll
              for (int j = 0; j < 4; ++j) { o1[j] = (x1[j] * cs[j] - x2[j] * sn[j]) * sc; o2[j] = (x1[j] * sn[j] + x2[j] * cs[j]) * sc; }
              u32x2_ w1, w2; w1.x = pk2(o1[0], o1[1]); w1.y = pk2(o1[2], o1[3]); w2.x = pk2(o2[0], o2[1]); w2.y = pk2(o2[2], o2[3]);
              __builtin_nontemporal_store(w1, (u32x2_*)(zp + bj * 128)); __builtin_nontemporal_store(w2, (u32x2_*)(zp + bj * 128 + 16));
            }
          }
        }
      } else {
#pragma unroll
        for (int ai = 0; ai < 2; ++ai)
#pragma unroll
          for (int m = 0; m < 4; ++m) {
            f16* zp = Z + (size_t)(row0 + ai * 128 + m * 16) * ZW + u.pn * 256 + 32 * wc + 4 * fq;
#pragma unroll
            for (int bj = 0; bj < 2; ++bj) {
              const f32x4 x1 = acc[ai][bj][m][0] * sc, x2 = acc[ai][bj][m][1] * sc;
              u32x2_ w1, w2; w1.x = pk2(x1[0], x1[1]); w1.y = pk2(x1[2], x1[3]); w2.x = pk2(x2[0], x2[1]); w2.y = pk2(x2[2], x2[3]);
              __builtin_nontemporal_store(w1, (u32x2_*)(zp + bj * 128)); __builtin_nontemporal_store(w2, (u32x2_*)(zp + bj * 128 + 16));
            }
          }
      }
      return;
    }
    if (seg == 3 || seg == 4) {
      const float sc = (seg == 4) ? 0.125f : 1.f;
#pragma unroll
      for (int ai = 0; ai < 2; ++ai) {
        f32x4 tt[4][4];
#pragma unroll
        for (int m = 0; m < 4; ++m) {
          const float* rp = ROT + (size_t)(row0 + ai * 128 + m * 16) * 96 + 32 + 16 * fq;
          tt[m][0] = *(const f32x4*)rp; tt[m][1] = *(const f32x4*)(rp + 4); tt[m][2] = *(const f32x4*)(rp + 8); tt[m][3] = *(const f32x4*)(rp + 12);
        }
#pragma unroll
        for (int m = 0; m < 4; ++m) {
          f16* zp = Z + (size_t)(row0 + ai * 128 + m * 16) * ZW + u.pn * 256 + 64 * wc + 8 * fq;
          const f32x4 t0 = tt[m][0], t1 = tt[m][1], t2 = tt[m][2], t3 = tt[m][3];
          const float cs[8] = {t0[0], t0[2], t1[0], t1[2], t2[0], t2[2], t3[0], t3[2]}, sn[8] = {t0[1], t0[3], t1[1], t1[3], t2[1], t2[3], t3[1], t3[3]};
          float lo[8], hi[8];
#pragma unroll
          for (int n = 0; n < 2; ++n)
#pragma unroll
            for (int j = 0; j < 4; ++j) { const int e = 4 * n + j; const float x1 = acc[ai][0][m][n][j], x2 = acc[ai][1][m][n][j]; lo[e] = (x1 * cs[e] - x2 * sn[e]) * sc; hi[e] = (x1 * sn[e] + x2 * cs[e]) * sc; }
          u32x4_ wl, wh; wl.x = pk2(lo[0], lo[1]); wl.y = pk2(lo[2], lo[3]); wl.z = pk2(lo[4], lo[5]); wl.w = pk2(lo[6], lo[7]);
          wh.x = pk2(hi[0], hi[1]); wh.y = pk2(hi[2], hi[3]); wh.z = pk2(hi[4], hi[5]); wh.w = pk2(hi[6], hi[7]);
          __builtin_nontemporal_store(wl, (u32x4_*)zp); __builtin_nontemporal_store(wh, (u32x4_*)(zp + 32));
        }
      }
      return;
    }
    f16* base = (seg == 8) ? KVM : Z; const long ld = (seg == 8) ? 1024 : ZW;
#pragma unroll
    for (int ai = 0; ai < 2; ++ai)
#pragma unroll
      for (int m = 0; m < 4; ++m) {
        f16* zp = base + (size_t)(row0 + ai * 128 + m * 16) * ld + u.pn * 256 + 32 * wc + 8 * fq;
#pragma unroll
        for (int bj = 0; bj < 2; ++bj) {
          f32x4 v0 = acc[ai][bj][m][0], v1 = acc[ai][bj][m][1];
          if (seg == 5) { v0 *= QSCALE; v1 *= QSCALE; }
          u32x4_ w; w.x = pk2(v0[0], v0[1]); w.y = pk2(v0[2], v0[3]); w.z = pk2(v1[0], v1[1]); w.w = pk2(v1[2], v1[3]);
          __builtin_nontemporal_store(w, (u32x4_*)(zp + bj * 128));
        }
      }
  }
};
DI void phase_gemm1(const Params& p, char* smem) {
  Sched1 S; S.H = (const char*)p.out; S.W = p.ws + WS_WINT; S.MEMN = p.ws + WS_MEMN; S.WMEM = p.ws + WS_WMEMT; S.b = blockIdx.x; S.G = gridDim.x;
  Epi1 E; E.Z = (f16*)(p.ws + WS_Z); E.KVM = (f16*)(p.ws + WS_KVM); E.GATES = (float*)(p.ws + WS_GATES); E.ROT = (const float*)(p.ws + WS_ROT);
  gemm_stream<false>((LAS unsigned char*)smem, 1024, 2048, 2048, S, E);
}

struct SchedOne {
  const char* A; const char* B; int pm, pn;
  DI bool next(int i, GUnit& u) const { if (i != 0) return false; u.A = A; u.B = B; u.pm = pm; u.pn = pn; u.seg = 8; u.bmode = 1; return true; }
};
DI void memkv_unit(const Params& p, int mt, int nt, char* smem) {
  SchedOne S; S.A = p.ws + WS_MEMN + (size_t)mt * 256 * 2048; S.B = p.ws + WS_WMEMT + (size_t)nt * 256 * 2048; S.pm = mt; S.pn = nt;
  Epi1 E; E.Z = (f16*)(p.ws + WS_Z); E.KVM = (f16*)(p.ws + WS_KVM); E.GATES = (float*)(p.ws + WS_GATES); E.ROT = (const float*)(p.ws + WS_ROT);
  gemm_stream<true>((LAS unsigned char*)smem, 1024, 2048, 2048, S, E);
}

struct Sched2 {
  const char* A; const char* W; int b, G;
  DI bool next(int i, GUnit& u) const {
    int mt, nt;
    if (G == 256) { if (i >= 2) return false; const int xcd = b & 7, l = b >> 3; const int st = i * 8 + xcd; mt = st * 8 + (l & 7); nt = l >> 3; }
    else { const int L = i * G + b; if (L >= 512) return false; mt = L >> 2; nt = L & 3; }
    u.pm = mt; u.pn = nt; u.seg = 0; u.bmode = 1;
    u.A = A + (size_t)mt * 256 * ZW * 2; u.B = W + (size_t)nt * 256 * 4096;
    return true;
  }
};
struct Epi2 {
  f16* Y; float* PSS;
  DI void operator()(const f32x4 (&acc)[2][2][4][2], const GUnit& u, int wr, int wc, int fr, int fq) const {
    typedef unsigned u32x4_ __attribute__((ext_vector_type(4)));
    const int row0 = u.pm * 256 + wr * 64 + fr, col0 = u.pn * 256 + wc * 32 + 8 * fq;
#pragma unroll
    for (int ai = 0; ai < 2; ++ai)
#pragma unroll
      for (int m = 0; m < 4; ++m) {
        const int r = row0 + ai * 128 + m * 16;
        f16* yp = Y + (size_t)r * 1024 + col0; float ss = 0.f;
#pragma unroll
        for (int bj = 0; bj < 2; ++bj) {
          const f32x4 v0 = acc[ai][bj][m][0], v1 = acc[ai][bj][m][1];
          ss += (v0[0] * v0[0] + v0[1] * v0[1]) + (v0[2] * v0[2] + v0[3] * v0[3]) + (v1[0] * v1[0] + v1[1] * v1[1]) + (v1[2] * v1[2] + v1[3] * v1[3]);
          u32x4_ w; w.x = pk2(v0[0], v0[1]); w.y = pk2(v0[2], v0[3]); w.z = pk2(v1[0], v1[1]); w.w = pk2(v1[2], v1[3]);
          *(u32x4_*)(yp + bj * 128) = w;
        }
        ss += __shfl_xor(ss, 16); ss += __shfl_xor(ss, 32);
        if (fq == 0) PSS[(size_t)r * 16 + u.pn * 4 + wc] = ss;
      }
  }
};
DI void phase_gemm2(const Params& p, char* smem) {
  Sched2 S; S.A = p.ws + WS_Z + (size_t)ZC_GATE * 2; S.W = p.ws + WS_WOUTT; S.b = blockIdx.x; S.G = gridDim.x;
  Epi2 E; E.Y = (f16*)(p.ws + WS_Y); E.PSS = (float*)(p.ws + WS_PSS);
  gemm_stream<false>((LAS unsigned char*)smem, 2048, (long)ZW * 2, 4096, S, E);
}

struct KCmpS { int k0; DI long operator()(int kt) const { const int k = kt + k0; return (long)(k >> 1) * ZW + (k & 1) * 64; } };
struct KStdS { int k0; DI long operator()(int kt) const { return (long)(kt + k0) * 64; } };
DI void unit_drain() { asm volatile("s_waitcnt vmcnt(0)" ::: "memory"); __syncthreads(); }
DI void publish_arrive(unsigned* ctr) {
  __builtin_amdgcn_fence(__ATOMIC_RELEASE, "agent");
  asm volatile("s_waitcnt vmcnt(0)" ::: "memory");
  __hip_atomic_fetch_add(ctr, 1u, __ATOMIC_RELAXED, __HIP_MEMORY_SCOPE_AGENT);
}
DI void wait_count(unsigned* ctr, unsigned target) {
  if (threadIdx.x == 0) {
    unsigned sp = 0;
    while (__hip_atomic_load(ctr, __ATOMIC_RELAXED, __HIP_MEMORY_SCOPE_AGENT) < target) { __builtin_amdgcn_s_sleep(2); if (++sp > (1u << 24)) break; }
    __builtin_amdgcn_fence(__ATOMIC_ACQUIRE, "agent");
    asm volatile("s_waitcnt vmcnt(0)" ::: "memory");
  }
  __syncthreads();
}
DI void csplit_unit(const Params& p, int kv, int b, int ks, char* smem) {
  int tid_ = threadIdx.x; asm volatile("" : "+v"(tid_)); const int tid = tid_, lane = tid & 63, wid = tid >> 6;
  const int lr = tid >> 3, lc = tid & 7;
  const char* Z = (const char*)(p.ws + WS_Z);
  const char* W1 = (const char*)(p.ws + WS_W1T) + (size_t)kv * 256 * 4096 * 2;
  const unsigned voffA = (unsigned)((lr & 31) * 16 * ZW * 2 + (lr >> 5) * 256 + lc * 16);
  const unsigned voffB = (unsigned)(lr * 8192 + lc * 16);
  f32x16 acc[4][2]; zero_acc(acc);
  KCmpS ka; ka.k0 = ks * 8; KStdS kb; kb.k0 = ks * 8;
  gemm_core(acc, Z + ((size_t)(b * NT) * ZW + ZC_KV + kv * 256) * 2, (long)32 * 16 * ZW * 2, voffA, W1, 64 * 8192, voffB, ka, kb, 8, smem);
  float* slab = p.out + (size_t)(((kv * 16 + b) * 8 + ks)) * 65536;
#pragma unroll
  for (int i = 0; i < 4; ++i)
#pragma unroll
    for (int j = 0; j < 2; ++j)
#pragma unroll
      for (int g = 0; g < 4; ++g) {
        f32x4 v; v[0] = acc[i][j][4 * g]; v[1] = acc[i][j][4 * g + 1]; v[2] = acc[i][j][4 * g + 2]; v[3] = acc[i][j][4 * g + 3];
        *(f32x4*)(slab + (size_t)((((wid * 4 + i) * 2 + j) * 4 + g) * 64 + lane) * 4) = v;
      }
  unit_drain();
}
DI void cfin_unit(const Params& p, int kv, int b, char* smem) {
  int tid_ = threadIdx.x; asm volatile("" : "+v"(tid_)); const int tid = tid_, lane = tid & 63, wid = tid >> 6, wn = wid & 3, l31 = lane & 31, h = lane >> 5;
  const int lr = tid >> 3, lc = tid & 7;
  f16* HID = (f16*)(p.ws + WS_HID) + (size_t)kv * 4096 * 256;
  wait_count((unsigned*)(p.ws + WS_CTR) + 16 + kv * 16 + b, 8u);
  {
    float* bias = (float*)(smem + 131072);
    if (tid < 256) { const float* PB1 = (const float*)(p.ws + WS_PB1) + kv * 16 * 256; float sacc = 0.f; for (int c = 0; c < 16; ++c) sacc += PB1[c * 256 + tid]; bias[tid] = sacc; }
    __syncthreads();
    f32x16 acc[4][2];
#pragma unroll
    for (int j = 0; j < 2; ++j)
#pragma unroll
      for (int r = 0; r < 16; ++r) { const float bv = bias[64 * wn + 32 * j + crow(r, h)]; acc[0][j][r] = bv; acc[1][j][r] = bv; acc[2][j][r] = bv; acc[3][j][r] = bv; }
    const float* slab0 = p.out + (size_t)((kv * 16 + b) * 8) * 65536;
#pragma unroll 1
    for (int ks = 0; ks < 8; ks += 2) {
      const float* slab = slab0 + (size_t)ks * 65536;
#pragma unroll
      for (int i = 0; i < 4; ++i) {
#pragma unroll
        for (int qh = 0; qh < 2; ++qh) {
          f32x4 tv[4], tw[4];
#pragma unroll
          for (int q = 0; q < 4; ++q) {
            const size_t o_ = (size_t)(((wid * 4 + i) * 8 + 4 * qh + q) * 64 + lane) * 4;
            tv[q] = *(const f32x4*)(slab + o_); tw[q] = *(const f32x4*)(slab + 65536 + o_);
          }
#pragma unroll
          for (int g = 0; g < 4; ++g) {
            acc[i][qh][4 * g] += tv[g][0] + tw[g][0]; acc[i][qh][4 * g + 1] += tv[g][1] + tw[g][1]; acc[i][qh][4 * g + 2] += tv[g][2] + tw[g][2]; acc[i][qh][4 * g + 3] += tv[g][3] + tw[g][3];
          }
        }
      }
    }
    __syncthreads();
    {
      const int wm = wid >> 2;
      char* img = smem + wid * (128 * 144);
#pragma unroll
      for (int i = 0; i < 4; ++i)
#pragma unroll
        for (int j = 0; j < 2; ++j)
#pragma unroll
          for (int g = 0; g < 4; ++g) {
            f16x4 v; v[0] = (f16)acc[i][j][4 * g]; v[1] = (f16)acc[i][j][4 * g + 1]; v[2] = (f16)acc[i][j][4 * g + 2]; v[3] = (f16)acc[i][j][4 * g + 3];
            *(f16x4*)(img + (32 * i + l31) * 144 + (32 * j + 8 * g + 4 * h) * 2) = v;
          }
      __syncthreads();
#pragma unroll 2
      for (int it = 0; it < 16; ++it) {
        const int row = it * 8 + (lane >> 3), ch = lane & 7;
        const int slot = 128 * wm + row; const int lrr = slot & 63, ii = slot >> 6;
        const int n = (lrr & 31) + 32 * ii, g = lrr >> 5;
        f16x8 v = *(const f16x8*)(img + row * 144 + ch * 16);
        v = XfGelu()(v, nullptr, 0, 0, 0);
        *(f16x8*)(HID + (size_t)(b * 256 + g * 128 + n) * 256 + 64 * wn + ch * 8) = v;
      }
      __syncthreads();
    }
  }
  __threadfence_block();
  __syncthreads();
  {
    const char* W2 = (const char*)(p.ws + WS_W2T) + (size_t)kv * 128 * 256 * 2;
    const unsigned voff = (unsigned)(lr * 512 + lc * 16);
    f32x16 acc[4][2]; zero_acc(acc);
    gemm_core(acc, (const char*)HID + (size_t)(b * 256) * 512, 64 * 512, voff, W2, 64 * 512, voff, KStd(), KStd(), 4, smem);
    if (l31 == 31) {
#pragma unroll
      for (int j = 0; j < 2; ++j)
#pragma unroll
        for (int r = 0; r < 16; ++r) acc[3][j][r] = 0.f;
    }
    f16* KC = (f16*)(p.ws + WS_KC) + (size_t)kv * 4096 * 128;
    store_tile_f16(acc, KC + (size_t)(b * 256) * 128, 128, smem, wn < 2, XfNone());
  }
  unit_drain();
}

struct KV128 { f16x8 k[2], v[2]; };
DI void kv_gload(KV128& r, const char* K, const char* V, unsigned voff, long ldb) {
  r.k[0] = *(const f16x8*)(K + (size_t)voff); r.k[1] = *(const f16x8*)(K + 32 * ldb + (size_t)voff);
  r.v[0] = *(const f16x8*)(V + (size_t)voff); r.v[1] = *(const f16x8*)(V + 32 * ldb + (size_t)voff);
}
DI void kv_lstore(const KV128& r, char* stage, unsigned so) {
  *(f16x8*)(stage + so) = r.k[0]; *(f16x8*)(stage + so + 8192) = r.k[1];
  *(f16x8*)(stage + 16384 + so) = r.v[0]; *(f16x8*)(stage + 16384 + so + 8192) = r.v[1];
}
DI void qk128(f32x16& p0, f32x16& p1, const char* Kst, const f16x8 (&qf)[8], unsigned kbe, unsigned kbo) {
  const f32x16 zero = {0.f, 0.f, 0.f, 0.f, 0.f, 0.f, 0.f, 0.f, 0.f, 0.f, 0.f, 0.f, 0.f, 0.f, 0.f, 0.f};
  f16x8 ka[4], kb[4];
#define QK_LD(dst, s0) do { dst[0] = *(const f16x8*)(Kst + kbe + 512 * ((s0) >> 1)); dst[1] = *(const f16x8*)(Kst + kbe + 512 * ((s0) >> 1) + 8192); \
    dst[2] = *(const f16x8*)(Kst + kbo + 512 * ((s0) >> 1)); dst[3] = *(const f16x8*)(Kst + kbo + 512 * ((s0) >> 1) + 8192); } while (0)
  QK_LD(ka, 0);
  QK_LD(kb, 2);
  p0 = MFMA(ka[0], qf[0], zero); p1 = MFMA(ka[1], qf[0], zero); p0 = MFMA(ka[2], qf[1], p0); p1 = MFMA(ka[3], qf[1], p1);
  QK_LD(ka, 4);
  p0 = MFMA(kb[0], qf[2], p0); p1 = MFMA(kb[1], qf[2], p1); p0 = MFMA(kb[2], qf[3], p0); p1 = MFMA(kb[3], qf[3], p1);
  QK_LD(kb, 6);
  p0 = MFMA(ka[0], qf[4], p0); p1 = MFMA(ka[1], qf[4], p1); p0 = MFMA(ka[2], qf[5], p0); p1 = MFMA(ka[3], qf[5], p1);
  p0 = MFMA(kb[0], qf[6], p0); p1 = MFMA(kb[1], qf[6], p1); p0 = MFMA(kb[2], qf[7], p0); p1 = MFMA(kb[3], qf[7], p1);
#undef QK_LD
  __builtin_amdgcn_sched_group_barrier(0x100, 8, 0);
  __builtin_amdgcn_sched_group_barrier(0x008, 4, 0);
  __builtin_amdgcn_sched_group_barrier(0x100, 4, 0);
  __builtin_amdgcn_sched_group_barrier(0x008, 4, 0);
  __builtin_amdgcn_sched_group_barrier(0x100, 4, 0);
  __builtin_amdgcn_sched_group_barrier(0x008, 8, 0);
}
DI f16x8 pack8(const f32x16& x, int s) {
  f16x8 r;
#pragma unroll
  for (int j = 0; j < 8; ++j) r[j] = (f16)x[8 * s + j];
  return r;
}
struct VFrag { f16x4 l0, h0, l1, h1, l2, h2, l3, h3; };
template <int DT> DI void pv_rd(VFrag& f, unsigned vb0, unsigned vb1) {
  f.l0 = tr_read<512 * DT>(vb0); f.h0 = tr_read<512 * DT + 2048>(vb1);
  f.l1 = tr_read<512 * DT + 4096>(vb0); f.h1 = tr_read<512 * DT + 4096 + 2048>(vb1);
  f.l2 = tr_read<512 * DT + 8192>(vb0); f.h2 = tr_read<512 * DT + 8192 + 2048>(vb1);
  f.l3 = tr_read<512 * DT + 12288>(vb0); f.h3 = tr_read<512 * DT + 12288 + 2048>(vb1);
}
DI void pv_mm(f32x16& od, const VFrag& f, const f16x8 (&pb)[4]) {
#define PK(L, H) (f16x8){L[0], L[1], L[2], L[3], H[0], H[1], H[2], H[3]}
  od = MFMA(PK(f.l0, f.h0), pb[0], od);
  od = MFMA(PK(f.l1, f.h1), pb[1], od);
  od = MFMA(PK(f.l2, f.h2), pb[2], od);
  od = MFMA(PK(f.l3, f.h3), pb[3], od);
#undef PK
}
DI void pv_tile(f32x16 (&o)[4], unsigned vb0, unsigned vb1, const f32x16& p0, const f32x16& p1) {
  f16x8 pb[4]; pb[0] = pack8(p0, 0); pb[1] = pack8(p0, 1); pb[2] = pack8(p1, 0); pb[3] = pack8(p1, 1);
  VFrag fa, fb;
  pv_rd<0>(fa, vb0, vb1);
  pv_rd<1>(fb, vb0, vb1);
  asm volatile("s_waitcnt lgkmcnt(8)" ::: "memory"); SBAR();
  pv_mm(o[0], fa, pb);
  pv_rd<2>(fa, vb0, vb1);
  asm volatile("s_waitcnt lgkmcnt(8)" ::: "memory"); SBAR();
  pv_mm(o[1], fb, pb);
  pv_rd<3>(fb, vb0, vb1);
  asm volatile("s_waitcnt lgkmcnt(8)" ::: "memory"); SBAR();
  pv_mm(o[2], fa, pb);
  asm volatile("s_waitcnt lgkmcnt(0)" ::: "memory"); SBAR();
  pv_mm(o[3], fb, pb);
}
DI void qk_exp(f32x16& n0, f32x16& n1, const char* Kst, const f16x8 (&qf)[8], unsigned kbe, unsigned kbo, f32x16& c0, f32x16& c1, float me, float& ps) {
  const f32x16 zero = {0.f, 0.f, 0.f, 0.f, 0.f, 0.f, 0.f, 0.f, 0.f, 0.f, 0.f, 0.f, 0.f, 0.f, 0.f, 0.f};
  f16x8 ka[4], kb[4];
#define QK_LD(dst, s0) do { dst[0] = *(const f16x8*)(Kst + kbe + 512 * ((s0) >> 1)); dst[1] = *(const f16x8*)(Kst + kbe + 512 * ((s0) >> 1) + 8192); \
    dst[2] = *(const f16x8*)(Kst + kbo + 512 * ((s0) >> 1)); dst[3] = *(const f16x8*)(Kst + kbo + 512 * ((s0) >> 1) + 8192); } while (0)
#define EXP8(c, b0) do { _Pragma("unroll") for (int j_ = 0; j_ < 8; ++j_) { c[(b0) + j_] = fexp2(c[(b0) + j_] - me); s_ += c[(b0) + j_]; } } while (0)
  float s_ = 0.f;
  QK_LD(ka, 0);
  n0 = MFMA(ka[0], qf[0], zero); n1 = MFMA(ka[1], qf[0], zero); n0 = MFMA(ka[2], qf[1], n0); n1 = MFMA(ka[3], qf[1], n1);
  QK_LD(kb, 2);
  EXP8(c0, 0);
  n0 = MFMA(kb[0], qf[2], n0); n1 = MFMA(kb[1], qf[2], n1); n0 = MFMA(kb[2], qf[3], n0); n1 = MFMA(kb[3], qf[3], n1);
  QK_LD(ka, 4);
  EXP8(c0, 8);
  n0 = MFMA(ka[0], qf[4], n0); n1 = MFMA(ka[1], qf[4], n1); n0 = MFMA(ka[2], qf[5], n0); n1 = MFMA(ka[3], qf[5], n1);
  QK_LD(kb, 6);
  EXP8(c1, 0);
  n0 = MFMA(kb[0], qf[6], n0); n1 = MFMA(kb[1], qf[6], n1); n0 = MFMA(kb[2], qf[7], n0); n1 = MFMA(kb[3], qf[7], n1);
  EXP8(c1, 8);
  ps = s_;
#undef QK_LD
}
DI void exp_only(f32x16& c0, f32x16& c1, float me, float& ps) {
  float s_ = 0.f;
  EXP8(c0, 0); EXP8(c0, 8); EXP8(c1, 0); EXP8(c1, 8);
  ps = s_;
#undef EXP8
}
DI void pv_max(f32x16 (&o)[4], unsigned vb0, unsigned vb1, const f32x16& p0, const f32x16& p1, const f32x16& n0, const f32x16& n1, float& pm) {
  f16x8 pb[4]; pb[0] = pack8(p0, 0); pb[1] = pack8(p0, 1); pb[2] = pack8(p1, 0); pb[3] = pack8(p1, 1);
  VFrag fa;
  float mx = n0[0];
  pv_rd<0>(fa, vb0, vb1);
  asm volatile("s_waitcnt lgkmcnt(0)" ::: "memory"); SBAR();
  pv_mm(o[0], fa, pb);
  pv_rd<1>(fa, vb0, vb1);
#pragma unroll
  for (int r = 1; r < 8; ++r) mx = fmaxf(mx, n0[r]);
  asm volatile("s_waitcnt lgkmcnt(0)" ::: "memory"); SBAR();
  pv_mm(o[1], fa, pb);
  pv_rd<2>(fa, vb0, vb1);
#pragma unroll
  for (int r = 8; r < 16; ++r) mx = fmaxf(mx, n0[r]);
  asm volatile("s_waitcnt lgkmcnt(0)" ::: "memory"); SBAR();
  pv_mm(o[2], fa, pb);
  pv_rd<3>(fa, vb0, vb1);
#pragma unroll
  for (int r = 0; r < 8; ++r) mx = fmaxf(mx, n1[r]);
  asm volatile("s_waitcnt lgkmcnt(0)" ::: "memory"); SBAR();
  pv_mm(o[3], fa, pb);
#pragma unroll
  for (int r = 8; r < 16; ++r) mx = fmaxf(mx, n1[r]);
  pm = mx;
}
DI float rowmax32(const f32x16& c0, const f32x16& c1) {
  float pm = c0[0];
#pragma unroll
  for (int r = 1; r < 16; ++r) pm = fmaxf(pm, c0[r]);
#pragma unroll
  for (int r = 0; r < 16; ++r) pm = fmaxf(pm, c1[r]);
  return xhalf_max(pm);
}
DI void osm_decide(float pmn, float& m, float& l, f32x16 (&o)[4]) {
  if (!__all(pmn - m <= THR)) {
    float mn = fmaxf(m, pmn); float alpha = fexp2(m - mn); m = mn; l *= alpha;
#pragma unroll
    for (int d = 0; d < 4; ++d)
#pragma unroll
      for (int r = 0; r < 16; ++r) o[d][r] *= alpha;
  }
}
DI void osm_step(f32x16& p0, f32x16& p1, float& m, float& l, f32x16 (&o)[4], bool sel = true) {
  float pm = p0[0];
#pragma unroll
  for (int r = 1; r < 16; ++r) pm = fmaxf(pm, p0[r]);
#pragma unroll
  for (int r = 0; r < 16; ++r) pm = fmaxf(pm, p1[r]);
  pm = xhalf_max(pm);
  pm = sel ? pm : NEG;
  if (!__all(pm - m <= THR)) {
    float mn = fmaxf(m, pm); float alpha = fexp2(m - mn); m = mn; l *= alpha;
#pragma unroll
    for (int d = 0; d < 4; ++d)
#pragma unroll
      for (int r = 0; r < 16; ++r) o[d][r] *= alpha;
  }
  const float me = sel ? m : 1e30f;
  float ps = 0.f;
#pragma unroll
  for (int r = 0; r < 16; ++r) { p0[r] = fexp2(p0[r] - me); ps += p0[r]; }
#pragma unroll
  for (int r = 0; r < 16; ++r) { p1[r] = fexp2(p1[r] - me); ps += p1[r]; }
  l += ps;
}
DI void zero_o(f32x16 (&o)[4]) {
#pragma unroll
  for (int d = 0; d < 4; ++d)
#pragma unroll
    for (int r = 0; r < 16; ++r) o[d][r] = 0.f;
}


DI void glds16(const char* g, LAS unsigned char* l) { __builtin_amdgcn_global_load_lds((const unsigned*)g, (LAS unsigned*)l, 16, 0, 0); }
DI unsigned dma_voff128(int wid, int lane, long ldb) {
  const int r3 = wid >> 1, c2 = ((wid & 1) << 1) | (lane >> 5), r7 = (lane >> 2) & 7, x = lane & 3;
  const int row = 8 * r3 + r7, rr = ((r7 >> 2) | ((r3 & 1) << 1)) & 3, ch = 4 * c2 + (x ^ rr);
  return (unsigned)(row * ldb + ch * 16);
}
DI unsigned dma_voff64(int wid, int lane, long ldb) {
  const int row = 8 * wid + (lane >> 3), c = (lane & 7) ^ ((row >> 1) & 7);
  return (unsigned)(row * ldb + c * 16);
}
DI void dma_kv128(LAS unsigned char* stage, unsigned ldsw, const char* K, const char* V, unsigned voff, long ldb) {
  glds16(K + (size_t)voff, stage + ldsw); glds16(K + 32 * ldb + (size_t)voff, stage + ldsw + 8192);
  glds16(V + (size_t)voff, stage + 16384 + ldsw); glds16(V + 32 * ldb + (size_t)voff, stage + 16384 + ldsw + 8192);
}
#define VWAIT(n) asm volatile("s_waitcnt vmcnt(" #n ")" ::: "memory")
DI void ring_wait4(int rem) {
  if (rem >= 3) VWAIT(12); else if (rem == 2) VWAIT(8); else if (rem == 1) VWAIT(4); else VWAIT(0);
}
DI void ring_wait3(int rem) {
  if (rem >= 3) VWAIT(9); else if (rem == 2) VWAIT(6); else if (rem == 1) VWAIT(3); else VWAIT(0);
}
DI void ring_bar() { asm volatile("s_waitcnt lgkmcnt(0)" ::: "memory"); __builtin_amdgcn_s_barrier(); asm volatile("" ::: "memory"); }

DI void nsa_unit(const Params& p, int b, int g, int qt, char* smem) {
  const int wid = __builtin_amdgcn_readfirstlane(threadIdx.x >> 6);
  int tid_ = threadIdx.x; asm volatile("" : "+v"(tid_)); const int tid = tid_, lane = tid & 63, l31 = lane & 31, h = lane >> 5;
  const int tl = 8 * wid + (l31 >> 2), rr = l31 & 3, head = 4 * g + rr;
  const int t = 64 * qt + tl;
  const unsigned row = (unsigned)(b * NT + t);
  char* Zc = p.ws + WS_Z;
  LAS unsigned char* lds = (LAS unsigned char*)smem;
  const unsigned ldsw = (unsigned)wid * 1024u;
  const char* KC = p.ws + WS_KC + (size_t)((b * 2 + g) * 128) * 256;
  const char* VC = KC + (size_t)4096 * 256;
  const unsigned cvo = dma_voff128(wid, lane, 256), zvo = dma_voff128(wid, lane, ZW * 2);
  const char* Zb = Zc + (size_t)b * NT * ZW * 2;
  const int cKs = ZC_KV + 512 + g * 128, cVs = ZC_KV + 768 + g * 128, cKw = ZC_KV + 1024 + g * 128, cVw = ZC_KV + 1280 + g * 128;
  const int nwin = (qt >= 8) ? 9 : (qt + 1);
  const int NTILE = 3 + qt + nwin;
#define NSA_ISSUE(n_) do { const int n__ = (n_); LAS unsigned char* st__ = lds + (n__ & 3) * 32768; \
    if (n__ < 2) dma_kv128(st__, ldsw, KC + n__ * 64 * 256, VC + n__ * 64 * 256, cvo, 256); \
    else if (n__ < 3 + qt) { const size_t ko__ = (size_t)(64 * (qt - (n__ - 2))) * ZW * 2; dma_kv128(st__, ldsw, Zb + ko__ + cKs * 2, Zb + ko__ + cVs * 2, zvo, ZW * 2); } \
    else { const size_t ko__ = (size_t)(64 * (qt - (n__ - 3 - qt))) * ZW * 2; dma_kv128(st__, ldsw, Zb + ko__ + cKw * 2, Zb + ko__ + cVw * 2, zvo, ZW * 2); } } while (0)
  f16x8 qf[8];
  LAS unsigned char* qst = lds + (unsigned)(2 + (wid >> 2)) * 32768u + (unsigned)(wid & 3) * 8192u;
  {
    const unsigned qsrc0 = ((unsigned)(b * NT + 64 * qt + 8 * wid) * (unsigned)ZW + (unsigned)(ZC_QN + 4 * g * 128)) * 2u;
    const int hc = lane >> 4, jc = lane & 15;
#pragma unroll
    for (int i = 0; i < 8; ++i) {
      const unsigned kq = (unsigned)(((i & 3) << 2) | hc);
      glds16(Zc + (size_t)(qsrc0 + (unsigned)i * (unsigned)(ZW * 2) + (((unsigned)hc * 16u + ((unsigned)jc ^ kq)) << 4)), qst + i * 1024);
    }
  }
  f32x4 rt[4];
  { const float* rp = (const float*)(p.ws + WS_ROT) + (size_t)row * 96 + 16 * h;
#pragma unroll
    for (int i = 0; i < 4; ++i) rt[i] = *(const f32x4*)(rp + 4 * i); }
  float g0, g1, g2;
  { const float* gp = (const float*)(p.ws + WS_GATES) + (size_t)(row * 24u + head); g0 = gp[0]; g1 = gp[8]; g2 = gp[16]; }
  wait_count((unsigned*)(p.ws + WS_CTR) + 64 + b, 2u);
  NSA_ISSUE(0); if (qt >= 16) NSA_ISSUE(1);
  int issued = 3;
  const unsigned kbe = 2048 * (l31 >> 3) + 64 * (l31 & 7) + 16 * ((h) ^ ((l31 >> 2) & 3));
  const unsigned kbo = 2048 * (l31 >> 3) + 64 * (l31 & 7) + 16 * ((2 + h) ^ ((l31 >> 2) & 3));
  const int q4 = (lane & 15) >> 2, p4 = lane & 3, blk = (lane >> 4) & 1;
  const unsigned sbase = (unsigned)(uintptr_t)smem;
  const unsigned vr0 = sbase + 16384 + 64 * (4 * h + q4) + 16 * ((2 * blk + (p4 >> 1)) ^ (h)) + 8 * (p4 & 1);
  const unsigned vr1 = sbase + 16384 + 64 * (4 * h + q4) + 16 * ((2 * blk + (p4 >> 1)) ^ (2 + h)) + 8 * (p4 & 1);
  char* otg = (char*)p.out + (size_t)(64u << 20) + (size_t)(((b * 2 + g) * 32 + qt)) * 65536 + tid * 16;
  f32x16 o[4];
  unsigned selmask;
  {
    ring_wait4(0);
    {
      const int tok_l = l31 >> 2;
      const unsigned kq = (unsigned)(((tok_l & 3) << 2) | rr);
      const unsigned qb = (unsigned)tok_l * 1024u + (unsigned)rr * 256u;
#pragma unroll
      for (int s = 0; s < 8; ++s) qf[s] = *(const LAS f16x8*)(qst + qb + ((((unsigned)(2 * s + h)) ^ kq) << 4));
      asm volatile("s_waitcnt lgkmcnt(0)" ::: "memory");
    }
    ring_bar();
    NSA_ISSUE(2);
    {
#pragma unroll
      for (int e = 0; e < 8; ++e) {
        const float cs = rt[e >> 1][2 * (e & 1)], sn = rt[e >> 1][2 * (e & 1) + 1];
        const float x1 = (float)qf[0][e], x2 = (float)qf[1][e];
        qf[0][e] = (f16)((x1 * cs - x2 * sn) * QSCALE); qf[1][e] = (f16)((x1 * sn + x2 * cs) * QSCALE);
      }
#pragma unroll
      for (int s = 2; s < 8; ++s)
#pragma unroll
        for (int e = 0; e < 8; ++e) qf[s][e] = (f16)((float)qf[s][e] * QSCALE);
    }
    f32x16 c0, c1, c2, c3;
    qk128(c0, c1, smem, qf, kbe, kbo);
    if (qt >= 16) qk128(c2, c3, smem + 32768, qf, kbe, kbo);
    else {
#pragma unroll
      for (int r = 0; r < 16; ++r) { c2[r] = 0.f; c3[r] = 0.f; }
    }
    const int nmax = (t - 31) >> 4;
    float mx = NEG;
#pragma unroll
    for (int r = 0; r < 16; ++r) {
      const int n = crow(r, h);
      c0[r] = (n <= nmax) ? c0[r] : NEG; c1[r] = (n + 32 <= nmax) ? c1[r] : NEG; c2[r] = (n + 64 <= nmax) ? c2[r] : NEG; c3[r] = (n + 96 <= nmax) ? c3[r] : NEG;
      mx = fmaxf(mx, fmaxf(fmaxf(c0[r], c1[r]), fmaxf(c2[r], c3[r])));
    }
    mx = xhalf_max(mx);
    float ls = 0.f;
#pragma unroll
    for (int r = 0; r < 16; ++r) {
      c0[r] = (c0[r] > -1e29f) ? fexp2(c0[r] - mx) : 0.f; c1[r] = (c1[r] > -1e29f) ? fexp2(c1[r] - mx) : 0.f;
      c2[r] = (c2[r] > -1e29f) ? fexp2(c2[r] - mx) : 0.f; c3[r] = (c3[r] > -1e29f) ? fexp2(c3[r] - mx) : 0.f;
      ls += (c0[r] + c1[r]) + (c2[r] + c3[r]);
    }
    ls = xhalf_sum(ls);
    const float inv = (ls > 0.f) ? 1.f / ls : 0.f;
#pragma unroll
    for (int r = 0; r < 16; ++r) { c0[r] *= inv; c1[r] *= inv; c2[r] *= inv; c3[r] *= inv; }
    if (qt <= 15) {
      selmask = (1u << (qt + 1)) - 1u;
    } else {
      float av[16], cv[16];
#pragma unroll
      for (int k = 0; k < 4; ++k)
#pragma unroll
        for (int gg = 0; gg < 4; ++gg) {
          const f32x16& c = (k == 0) ? c0 : (k == 1) ? c1 : (k == 2) ? c2 : c3;
          float half3 = 0.5f * c[4 * gg + 3];
          av[4 * k + gg] = c[4 * gg] + c[4 * gg + 1] + c[4 * gg + 2] + half3; cv[4 * k + gg] = half3;
        }
      float imp[16];
#pragma unroll
      for (int i = 0; i < 16; ++i) {
        auto x2 = __builtin_amdgcn_permlane32_swap(__float_as_uint(cv[i]), __float_as_uint(cv[i]), false, false);
        float oc = h ? __uint_as_float(x2[0]) : __uint_as_float(x2[1]);
        cv[i] = oc;
      }
#pragma unroll
      for (int i = 0; i < 16; ++i) {
        float carry = h ? cv[i] : (i > 0 ? cv[i - 1] : 0.f);
        float v = av[i] + carry;
        v += __shfl_xor(v, 1); v += __shfl_xor(v, 2);
        imp[i] = v;
      }
      float* impL = (float*)(smem + 131072) + wid * 256;
      if (rr == 0) {
#pragma unroll
        for (int i = 0; i < 16; ++i) impL[(l31 >> 2) * 32 + 2 * i + h] = imp[i];
      }
      asm volatile("s_waitcnt lgkmcnt(0)" ::: "memory");
      __builtin_amdgcn_wave_barrier();
      const int sub = rr + 4 * h;
      const float* vrow = impL + (l31 >> 2) * 32;
      f32x4 mine = *(const f32x4*)(vrow + 4 * sub);
      int cnt[4] = {0, 0, 0, 0};
#pragma unroll 4
      for (int j2 = 1; j2 <= qt - 2; ++j2) {
        float w = vrow[j2];
#pragma unroll
        for (int e = 0; e < 4; ++e) { int j = 4 * sub + e; cnt[e] += (w > mine[e] || (w == mine[e] && j2 < j)) ? 1 : 0; }
      }
      unsigned nib = 0;
#pragma unroll
      for (int e = 0; e < 4; ++e) { int j = 4 * sub + e; if (j >= 1 && j <= qt - 2 && cnt[e] < 13) nib |= 1u << j; }
      nib |= (unsigned)__shfl_xor((int)nib, 1); nib |= (unsigned)__shfl_xor((int)nib, 2); nib |= (unsigned)__shfl_xor((int)nib, 32);
      selmask = nib | 1u | (1u << qt) | (1u << (qt - 1));
    }
    zero_o(o);
    pv_tile(o, vr0, vr1, c0, c1);
    if (qt >= 16) pv_tile(o, vr0 + 32768, vr1 + 32768, c2, c3);
#pragma unroll
    for (int d = 0; d < 4; ++d)
#pragma unroll
      for (int g2_ = 0; g2_ < 2; ++g2_) {
        f16x8 v;
#pragma unroll
        for (int e = 0; e < 8; ++e) v[e] = (f16)(g0 * o[d][8 * g2_ + e]);
        *(f16x8*)(otg + (2 * d + g2_) * 8192) = v;
      }
  }
  f16x8 rv[8];
#define NSA_STEP(n_) do { ring_wait4(issued - 1 - (n_)); ring_bar(); while (issued <= (n_) + 2 && issued < NTILE) { NSA_ISSUE(issued); ++issued; } } while (0)
  float m, l = 0.f;
  zero_o(o);
  {
    const int na = 2, nb = 2 + qt;
    f32x16 c0, c1;
    NSA_STEP(na);
    qk128(c0, c1, smem + (na & 3) * 32768, qf, kbe, kbo);
    {
      int tlx = tl - 4 * h; asm volatile("" : "+v"(tlx));
#pragma unroll
      for (int r = 0; r < 16; ++r) { const int key = crow(r, 0); c0[r] = (key <= tlx) ? c0[r] : NEG; c1[r] = (key + 32 <= tlx) ? c1[r] : NEG; }
    }
    m = rowmax32(c0, c1);
    bool selc = true;
    f32x16 x0, x1;
#define SLC_STEP(C0, C1, X0, X1) do { \
      NSA_STEP(n + 1); \
      const float me = selc ? m : 1e30f; float ps, pmn; \
      qk_exp(X0, X1, smem + ((n + 1) & 3) * 32768, qf, kbe, kbo, C0, C1, me, ps); \
      l += ps; \
      pv_max(o, vr0 + (n & 3) * 32768, vr1 + (n & 3) * 32768, C0, C1, X0, X1, pmn); \
      const bool seln = (selmask >> (qt - (n + 1 - 2))) & 1u; \
      pmn = xhalf_max(pmn); pmn = seln ? pmn : NEG; \
      osm_decide(pmn, m, l, o); \
      selc = seln; } while (0)
    int n = na;
    for (; n + 1 < nb; n += 2) { SLC_STEP(c0, c1, x0, x1); ++n; SLC_STEP(x0, x1, c0, c1); --n; }
    if (n < nb) { SLC_STEP(c0, c1, x0, x1); c0 = x0; c1 = x1; }
#undef SLC_STEP
#pragma unroll
    for (int k = 0; k < 8; ++k) rv[k] = *(const f16x8*)(otg + k * 8192);
    { const float me = selc ? m : 1e30f; float ps; exp_only(c0, c1, me, ps); l += ps; pv_tile(o, vr0 + (nb & 3) * 32768, vr1 + (nb & 3) * 32768, c0, c1); }
  }
  {
    float lt = xhalf_sum(l); float sc = g1 / lt;
#pragma unroll
    for (int d = 0; d < 4; ++d)
#pragma unroll
      for (int g2_ = 0; g2_ < 2; ++g2_) {
        f16x8 v = rv[2 * d + g2_];
#pragma unroll
        for (int e = 0; e < 8; ++e) v[e] = (f16)((float)v[e] + sc * o[d][8 * g2_ + e]);
        *(f16x8*)(otg + (2 * d + g2_) * 8192) = v;
      }
  }
  const unsigned grow0 = ((unsigned)(b * NT + 64 * qt + 8 * wid) * (unsigned)ZW + (unsigned)(ZC_GATE + 4 * g * 128)) * 2u + (unsigned)lane * 16u;
  f16x8 pvs[8]; f16x8 gts[8];
  l = 0.f; zero_o(o);
  {
    const int na = 3 + qt, nb = NTILE - 1;
    f32x16 c0, c1;
    NSA_STEP(na);
    qk128(c0, c1, smem + (na & 3) * 32768, qf, kbe, kbo);
    {
      int tlx = tl - 4 * h; asm volatile("" : "+v"(tlx));
#pragma unroll
      for (int r = 0; r < 16; ++r) { const int key = crow(r, 0); c0[r] = (key <= tlx) ? c0[r] : NEG; c1[r] = (key + 32 <= tlx) ? c1[r] : NEG; }
    }
    m = rowmax32(c0, c1);
    f32x16 x0, x1;
#define WIN_STEP(C0, C1, X0, X1) do { \
      NSA_STEP(n + 1); \
      float ps, pmn; \
      qk_exp(X0, X1, smem + ((n + 1) & 3) * 32768, qf, kbe, kbo, C0, C1, m, ps); \
      l += ps; \
      pv_max(o, vr0 + (n & 3) * 32768, vr1 + (n & 3) * 32768, C0, C1, X0, X1, pmn); \
      pmn = xhalf_max(pmn); \
      osm_decide(pmn, m, l, o); } while (0)
    int n = na;
    for (; n + 1 < nb; n += 2) { WIN_STEP(c0, c1, x0, x1); ++n; WIN_STEP(x0, x1, c0, c1); --n; }
    if (n < nb) { WIN_STEP(c0, c1, x0, x1); c0 = x0; c1 = x1; }
#undef WIN_STEP
    if (nwin == 9) {
      int tlx = tl - 4 * h; asm volatile("" : "+v"(tlx));
#pragma unroll
      for (int r = 0; r < 16; ++r) { const int key = crow(r, 0); c0[r] = (key > tlx) ? c0[r] : NEG; c1[r] = (key + 32 > tlx) ? c1[r] : NEG; }
    }
#pragma unroll
    for (int i = 0; i < 8; ++i) pvs[i] = *(const f16x8*)(otg + i * 8192);
#pragma unroll
    for (int i = 0; i < 8; ++i) gts[i] = *(const f16x8*)(Zc + (size_t)(grow0 + (unsigned)i * (unsigned)(ZW * 2)));
    { float ps; exp_only(c0, c1, m, ps); l += ps; pv_tile(o, vr0 + (nb & 3) * 32768, vr1 + (nb & 3) * 32768, c0, c1); }
  }
#undef NSA_STEP
#undef NSA_ISSUE
  const float scw = g2 / xhalf_sum(l);
  {
    LAS unsigned char* stg = lds + (unsigned)((NTILE + (wid >> 2)) & 3) * 32768u + (unsigned)(wid & 3) * 8192u;
    const int tok_l = l31 >> 2;
    const unsigned k4 = (unsigned)((((tok_l & 1) << 2) | rr) << 4);
    const unsigned wb = ((unsigned)tok_l * 1024u + (unsigned)rr * 256u + (unsigned)h * 8u) ^ k4;
#pragma unroll
    for (int d = 0; d < 4; ++d)
#pragma unroll
      for (int g2_ = 0; g2_ < 2; ++g2_) {
        const f16x8 pv = pvs[2 * d + g2_];
#pragma unroll
        for (int q = 0; q < 2; ++q) {
          const int gg = 2 * g2_ + q;
          f16x4 v;
#pragma unroll
          for (int e = 0; e < 4; ++e) v[e] = (f16)((float)pv[4 * q + e] + scw * o[d][4 * gg + e]);
          *(LAS f16x4*)(stg + (wb ^ (unsigned)((4 * d + gg) << 4))) = v;
        }
      }
    asm volatile("s_waitcnt lgkmcnt(0)" ::: "memory");
    __builtin_amdgcn_wave_barrier();
    const int hc = lane >> 4, jc = lane & 15;
#pragma unroll
    for (int i = 0; i < 8; ++i) {
      const unsigned ra = (unsigned)i * 1024u + (unsigned)hc * 256u + (((unsigned)jc ^ (unsigned)(((i & 1) << 2) | hc)) << 4);
      const f16x8 f = *(const LAS f16x8*)(stg + ra);
      const f16x8 gt = gts[i]; f16x8 v;
#pragma unroll
      for (int e = 0; e < 8; ++e) v[e] = (f16)((float)f[e] * siluf_((float)gt[e]));
      *(f16x8*)(Zc + (size_t)(grow0 + (unsigned)i * (unsigned)(ZW * 2))) = v;
    }
  }
  ring_bar();
}

DI void mem_unit(const Params& p, int b, int hm, int half, char* smem) {
  const int wid = __builtin_amdgcn_readfirstlane(threadIdx.x >> 6);
  int tid_ = threadIdx.x; asm volatile("" : "+v"(tid_)); const int tid = tid_, lane = tid & 63, l31 = lane & 31, h = lane >> 5;
  f16* Z = (f16*)(p.ws + WS_Z);
  LAS unsigned char* lds = (LAS unsigned char*)smem;
  const unsigned ldsw = (unsigned)wid * 1024u;
  const char* Kb = p.ws + WS_KVM + ((size_t)(b * 256) * 1024 + hm * 128) * 2;
  const char* Vb = Kb + 1024;
  const unsigned kvo = dma_voff128(wid, lane, 2048);
  const size_t row0 = (size_t)b * NT + 1024 * half + 32 * wid + l31;
  wait_count((unsigned*)(p.ws + WS_CTR) + 80 + b, 4u);
  f16x8 qf[8];
#define MEM_QLOAD(i_) do { const f16* qrow = Z + (row0 + 256 * (i_)) * ZW + ZC_QM + hm * 128 + 8 * h; \
    _Pragma("unroll") for (int s = 0; s < 8; ++s) qf[s] = *(const f16x8*)(qrow + 16 * s); } while (0)
  MEM_QLOAD(0);
#pragma unroll
  for (int i = 0; i < 4; ++i) dma_kv128(lds + i * 32768, ldsw, Kb + (size_t)(64 * i) * 2048, Vb + (size_t)(64 * i) * 2048, kvo, 2048);
  const unsigned kbe = 2048 * (l31 >> 3) + 64 * (l31 & 7) + 16 * ((h) ^ ((l31 >> 2) & 3));
  const unsigned kbo = 2048 * (l31 >> 3) + 64 * (l31 & 7) + 16 * ((2 + h) ^ ((l31 >> 2) & 3));
  const int q4 = (lane & 15) >> 2, p4 = lane & 3, blk = (lane >> 4) & 1;
  const unsigned sbase = (unsigned)(uintptr_t)smem;
  const unsigned vr0 = sbase + 16384 + 64 * (4 * h + q4) + 16 * ((2 * blk + (p4 >> 1)) ^ (h)) + 8 * (p4 & 1);
  const unsigned vr1 = sbase + 16384 + 64 * (4 * h + q4) + 16 * ((2 * blk + (p4 >> 1)) ^ (2 + h)) + 8 * (p4 & 1);
  asm volatile("s_waitcnt vmcnt(0)" ::: "memory");
  ring_bar();
#pragma unroll 1
  for (int i = 0; i < 4; ++i) {
    f32x16 o[4]; zero_o(o);
    float m, l = 0.f;
    f32x16 c0, c1, x0, x1;
    qk128(c0, c1, smem, qf, kbe, kbo);
    m = rowmax32(c0, c1);
#define MEM_STEP(C0, C1, X0, X1, n_) do { float ps, pmn; \
      qk_exp(X0, X1, smem + ((n_) + 1) * 32768, qf, kbe, kbo, C0, C1, m, ps); l += ps; \
      pv_max(o, vr0 + (n_) * 32768, vr1 + (n_) * 32768, C0, C1, X0, X1, pmn); \
      pmn = xhalf_max(pmn); osm_decide(pmn, m, l, o); } while (0)
    MEM_STEP(c0, c1, x0, x1, 0);
    MEM_STEP(x0, x1, c0, c1, 1);
    MEM_STEP(c0, c1, x0, x1, 2);
#undef MEM_STEP
    const unsigned grow0 = ((unsigned)(b * NT + 1024 * half + 256 * i + 32 * wid + (lane >> 4)) * (unsigned)ZW + (unsigned)(ZC_GATE + 1536 + hm * 128 + 8 * (lane & 15))) * 2u;
    f16x8 gts[8];
#pragma unroll
    for (int j = 0; j < 8; ++j) gts[j] = *(const f16x8*)((const char*)Z + (size_t)(grow0 + (unsigned)(4 * j) * (unsigned)(ZW * 2)));
    if (i + 1 < 4) MEM_QLOAD(i + 1);
    { float ps; exp_only(x0, x1, m, ps); l += ps; pv_tile(o, vr0 + 3 * 32768, vr1 + 3 * 32768, x0, x1); }
    const float inv = 1.f / xhalf_sum(l);
    {
      LAS unsigned char* stg = lds + 131072u + (unsigned)wid * 2048u;
      const unsigned wb = ((unsigned)(l31 & 7) * 256u + (unsigned)h * 8u) ^ ((unsigned)(l31 & 7) << 4);
      const int rc = lane >> 4, jc = lane & 15;
#pragma unroll
      for (int pz = 0; pz < 4; ++pz) {
        if ((l31 >> 3) == pz) {
#pragma unroll
          for (int d = 0; d < 4; ++d)
#pragma unroll
            for (int gg = 0; gg < 4; ++gg) {
              f16x4 v;
#pragma unroll
              for (int e = 0; e < 4; ++e) v[e] = (f16)(o[d][4 * gg + e] * inv);
              *(LAS f16x4*)(stg + (wb ^ (unsigned)((4 * d + gg) << 4))) = v;
            }
        }
        asm volatile("s_waitcnt lgkmcnt(0)" ::: "memory");
        __builtin_amdgcn_wave_barrier();
#pragma unroll
        for (int ii = 0; ii < 2; ++ii) {
          const int rl = 4 * ii + rc;
          const f16x8 f = *(const LAS f16x8*)(stg + (unsigned)rl * 256u + (((unsigned)jc ^ (unsigned)rl) << 4));
          const f16x8 gt = gts[2 * pz + ii]; f16x8 v;
#pragma unroll
          for (int e = 0; e < 8; ++e) v[e] = (f16)((float)f[e] * siluf_((float)gt[e]));
          *(f16x8*)((char*)Z + (size_t)(grow0 + (unsigned)(8 * pz + 4 * ii) * (unsigned)(ZW * 2))) = v;
        }
        asm volatile("s_waitcnt lgkmcnt(0)" ::: "memory");
        __builtin_amdgcn_wave_barrier();
      }
    }
  }
#undef MEM_QLOAD
  ring_bar();
}

DI void ret_qk(f32x16& n0, f32x16& n1, const char* stg, const f16x8 (&qf)[4], int l31, int h, int xx) {
  const f32x16 zero = {0.f, 0.f, 0.f, 0.f, 0.f, 0.f, 0.f, 0.f, 0.f, 0.f, 0.f, 0.f, 0.f, 0.f, 0.f, 0.f};
#pragma unroll
  for (int s = 0; s < 4; ++s) {
    const unsigned cxs = (unsigned)(((2 * s + h) ^ xx) << 4);
    const f16x8 k0 = *(const f16x8*)(stg + l31 * 128 + cxs);
    const f16x8 k1 = *(const f16x8*)(stg + (l31 + 32) * 128 + cxs);
    n0 = MFMA(k0, qf[s], s == 0 ? zero : n0); n1 = MFMA(k1, qf[s], s == 0 ? zero : n1);
  }
}
DI void ret_qk_decay(f32x16& n0, f32x16& n1, const char* stg, const f16x8 (&qf)[4], int l31, int h, int xx, f32x16& c0, f32x16& c1, const float (&fac)[16], float base, float e32) {
  const f32x16 zero = {0.f, 0.f, 0.f, 0.f, 0.f, 0.f, 0.f, 0.f, 0.f, 0.f, 0.f, 0.f, 0.f, 0.f, 0.f, 0.f};
  const float base1 = base * e32;
#pragma unroll
  for (int s = 0; s < 4; ++s) {
    const unsigned cxs = (unsigned)(((2 * s + h) ^ xx) << 4);
    const f16x8 k0 = *(const f16x8*)(stg + l31 * 128 + cxs);
    const f16x8 k1 = *(const f16x8*)(stg + (l31 + 32) * 128 + cxs);
    n0 = MFMA(k0, qf[s], s == 0 ? zero : n0); n1 = MFMA(k1, qf[s], s == 0 ? zero : n1);
#pragma unroll
    for (int j = 0; j < 4; ++j) { const int r = 4 * s + j; c0[r] *= base * fac[r]; c1[r] *= base1 * fac[r]; }
  }
}
DI void ret_decay(f32x16& c0, f32x16& c1, const float (&fac)[16], float base, float e32) {
  const float base1 = base * e32;
#pragma unroll
  for (int r = 0; r < 16; ++r) { c0[r] *= base * fac[r]; c1[r] *= base1 * fac[r]; }
}
DI void ret_unit(const Params& p, int b, int hr, int tq, char* smem) {
  const int wid = __builtin_amdgcn_readfirstlane(threadIdx.x >> 6);
  int tid_ = threadIdx.x; asm volatile("" : "+v"(tid_)); const int tid = tid_, lane = tid & 63, l31 = lane & 31, h = lane >> 5;
  const int t = 256 * tq + 32 * wid + l31;
  const size_t row = (size_t)b * NT + t;
  f16* Z = (f16*)(p.ws + WS_Z);
  LAS unsigned char* lds = (LAS unsigned char*)smem;
  const unsigned ldsw = (unsigned)wid * 1024u;
  const char* Kb = p.ws + WS_Z + ((size_t)b * NT * ZW + ZC_KR + hr * 64) * 2;
  const char* Vb = p.ws + WS_Z + ((size_t)b * NT * ZW + ZC_VR + hr * 128) * 2;
  const unsigned kvo = dma_voff64(wid, lane, ZW * 2), vvo = dma_voff128(wid, lane, ZW * 2);
  const int ntile = 4 * (tq + 1);
#define RET_ISSUE(n_) do { const int n__ = (n_); LAS unsigned char* st__ = lds + (n__ & 3) * 32768; const size_t ko__ = (size_t)(64 * n__) * ZW * 2; \
    glds16(Kb + ko__ + (size_t)kvo, st__ + ldsw); glds16(Vb + ko__ + (size_t)vvo, st__ + 16384 + ldsw); glds16(Vb + ko__ + (size_t)32 * ZW * 2 + (size_t)vvo, st__ + 16384 + ldsw + 8192); } while (0)
#define RET_STEP(n_) do { ring_wait3(issued - 1 - (n_)); ring_bar(); while (issued <= (n_) + 2 && issued < ntile) { RET_ISSUE(issued); ++issued; } } while (0)
  RET_ISSUE(0); RET_ISSUE(1); RET_ISSUE(2);
  int issued = 3;
  f16x8 qf[4];
  {
    const f16* qrow = Z + row * ZW + ZC_QR + hr * 64 + 8 * h;
#pragma unroll
    for (int s = 0; s < 4; ++s) qf[s] = *(const f16x8*)(qrow + 16 * s);
  }
  const float lg = log2f(1.f - exp2f(-5.f - (float)hr));
  float fac[16];
#pragma unroll
  for (int r = 0; r < 16; ++r) fac[r] = fexp2(-lg * (float)crow(r, h));
  const float e32 = fexp2(-lg * 32.f);
  const int xx = (l31 >> 1) & 7;
  const int q4 = (lane & 15) >> 2, p4 = lane & 3, blk = (lane >> 4) & 1;
  const unsigned sbase = (unsigned)(uintptr_t)smem;
  const unsigned vr0 = sbase + 16384 + 64 * (4 * h + q4) + 16 * ((2 * blk + (p4 >> 1)) ^ (h)) + 8 * (p4 & 1);
  const unsigned vr1 = sbase + 16384 + 64 * (4 * h + q4) + 16 * ((2 * blk + (p4 >> 1)) ^ (2 + h)) + 8 * (p4 & 1);
  f32x16 o[4]; zero_o(o);
  const int mykt = 4 * tq + (wid >> 1);
  const int tlw = 32 * (wid & 1) + l31;
  f32x16 c0, c1, x0, x1;
  RET_STEP(0);
  ret_qk(c0, c1, smem, qf, l31, h, xx);
#define RET_BODY(C0, C1, X0, X1) do { \
    RET_STEP(kt + 1); \
    if (kt <= mykt) { \
      const float base = fexp2(lg * (float)(t - 64 * kt)); \
      if (kt < mykt) ret_qk_decay(X0, X1, smem + ((kt + 1) & 3) * 32768, qf, l31, h, xx, C0, C1, fac, base, e32); \
      else { \
        ret_decay(C0, C1, fac, base, e32); \
        int tlx = tlw - 4 * h; asm volatile("" : "+v"(tlx)); \
        _Pragma("unroll") for (int r = 0; r < 16; ++r) { const int key = crow(r, 0); C0[r] = (key <= tlx) ? C0[r] : 0.f; C1[r] = (key + 32 <= tlx) ? C1[r] : 0.f; } \
      } \
      pv_tile(o, vr0 + (kt & 3) * 32768, vr1 + (kt & 3) * 32768, C0, C1); \
    } } while (0)
  int kt = 0;
  for (; kt + 2 < ntile; kt += 2) { RET_BODY(c0, c1, x0, x1); ++kt; RET_BODY(x0, x1, c0, c1); --kt; }
  if (kt + 1 < ntile) { RET_BODY(c0, c1, x0, x1); c0 = x0; c1 = x1; ++kt; }
  const unsigned grow0 = ((unsigned)(b * NT + 256 * tq + 32 * wid + (lane >> 4)) * (unsigned)ZW + (unsigned)(ZC_GATE + 1024 + hr * 128 + 8 * (lane & 15))) * 2u;
  f16x8 gts[8];
#pragma unroll
  for (int i = 0; i < 8; ++i) gts[i] = *(const f16x8*)((const char*)Z + (size_t)(grow0 + (unsigned)(4 * i) * (unsigned)(ZW * 2)));
  if (kt <= mykt) {
    const float base = fexp2(lg * (float)(t - 64 * kt));
    ret_decay(c0, c1, fac, base, e32);
    int tlx = tlw - 4 * h; asm volatile("" : "+v"(tlx));
#pragma unroll
    for (int r = 0; r < 16; ++r) { const int key = crow(r, 0); c0[r] = (key <= tlx) ? c0[r] : 0.f; c1[r] = (key + 32 <= tlx) ? c1[r] : 0.f; }
    pv_tile(o, vr0 + (kt & 3) * 32768, vr1 + (kt & 3) * 32768, c0, c1);
  }
#undef RET_BODY
#undef RET_STEP
#undef RET_ISSUE
  const float* gn = p.ret_gn + hr * 128 + 4 * h;
  f32x4 gvs[16];
#pragma unroll
  for (int i = 0; i < 16; ++i) gvs[i] = *(const f32x4*)(gn + 32 * (i >> 2) + 8 * (i & 3));
  float s1 = 0.f;
#pragma unroll
  for (int d = 0; d < 4; ++d)
#pragma unroll
    for (int r = 0; r < 16; ++r) s1 += o[d][r];
  s1 = xhalf_sum(s1);
  const float mu = s1 * (1.f / 128.f);
  float s2 = 0.f;
#pragma unroll
  for (int d = 0; d < 4; ++d)
#pragma unroll
    for (int r = 0; r < 16; ++r) { float c = o[d][r] - mu; s2 += c * c; }
  s2 = xhalf_sum(s2);
  const float rstd = rsqrtf(s2 * (1.f / 128.f) + 1e-6f);
  {
    LAS unsigned char* stg = lds + (unsigned)(wid >> 2) * 32768u + (unsigned)(wid & 3) * 8192u;
    const unsigned wb = ((unsigned)l31 * 256u + (unsigned)h * 8u) ^ ((unsigned)(l31 & 15) << 4);
#pragma unroll
    for (int d = 0; d < 4; ++d)
#pragma unroll
      for (int gg = 0; gg < 4; ++gg) {
        const f32x4 gv = gvs[4 * d + gg]; f16x4 v;
#pragma unroll
        for (int e = 0; e < 4; ++e) v[e] = (f16)((o[d][4 * gg + e] - mu) * rstd * gv[e]);
        *(LAS f16x4*)(stg + (wb ^ (unsigned)((4 * d + gg) << 4))) = v;
      }
    asm volatile("s_waitcnt lgkmcnt(0)" ::: "memory");
    __builtin_amdgcn_wave_barrier();
    const int rc = lane >> 4, jc = lane & 15;
#pragma unroll
    for (int i = 0; i < 8; ++i) {
      const int rl = 4 * i + rc;
      const f16x8 f = *(const LAS f16x8*)(stg + (unsigned)rl * 256u + (((unsigned)jc ^ (unsigned)(rl & 15)) << 4));
      const f16x8 gt = gts[i]; f16x8 v;
#pragma unroll
      for (int e = 0; e < 8; ++e) v[e] = (f16)((float)f[e] * siluf_((float)gt[e]));
      *(f16x8*)((char*)Z + (size_t)(grow0 + (unsigned)(4 * i) * (unsigned)(ZW * 2))) = v;
    }
  }
  ring_bar();
}

constexpr int ATTN_UNITS = 288 + 64 + 512 + 128 + 1024;
DI unsigned* attn_dispatch(const Params& p, int u, char* smem) {
  int kind, a0, a1;
  if (u < 256) { kind = 3; a0 = u >> 5; a1 = u & 31; }
  else if (u < 288) { kind = 4; a0 = 0; a1 = u - 256; }
  else if (u < 352) { kind = 6; a0 = (u - 288) & 3; a1 = (u - 288) >> 2; }
  else {
    const int v = u - 352;
    if (v < 512) { kind = 1; a0 = 7 - ((v >> 3) & 7); a1 = (v >> 6) * 8 + (v & 7); }
    else if (v < 640) { const int w = v - 512; kind = 2; a0 = w & 1; a1 = w >> 1; }
    else { const int w = v - 640; kind = 0; a0 = 31 - (w >> 5); a1 = w & 31; }
  }
  unsigned* ctrs = (unsigned*)(p.ws + WS_CTR);
  unsigned* pend = nullptr;
  if (p.dry > 1) { const int kb = (kind == 0) ? 2 : (kind == 1) ? 4 : (kind == 2) ? 8 : 16; if (!(p.dry & kb)) return nullptr; }
  if (kind == 0) nsa_unit(p, a1 >> 1, a1 & 1, a0, smem);
  else if (kind == 1) ret_unit(p, a1 >> 2, a1 & 3, a0, smem);
  else if (kind == 2) mem_unit(p, a1 >> 2, a1 & 3, a0, smem);
  else if (kind == 6) { memkv_unit(p, a1, a0, smem); unit_drain(); pend = ctrs + 80 + a1; }
  else if (kind == 3) { csplit_unit(p, a1 >> 4, a1 & 15, a0, smem); pend = ctrs + 16 + a1; }
  else { cfin_unit(p, a1 >> 4, a1 & 15, smem); pend = ctrs + 64 + (a1 & 15); }
  return pend;
}

DI void phase_attn(const Params& p, char* smem, int ulo, int uhi, int cidx) {
  unsigned* ctr = (unsigned*)(p.ws + WS_CTR) + cidx;
  int* su = (int*)(smem + LDS_IMG + 16);
  unsigned* pend = nullptr;
  int nextu = 0;
  if (threadIdx.x == 0) nextu = ulo + (int)blockIdx.x;
  for (;;) {
    if (threadIdx.x == 0) {
      if (pend) publish_arrive(pend);
      *su = nextu;
    }
    __syncthreads();
    const int u = *su;
    __syncthreads();
    if (u >= uhi) { pend = nullptr; break; }
    if (threadIdx.x == 0) nextu = ulo + (int)gridDim.x + (int)atomicAdd(ctr, 1u);
    pend = attn_dispatch(p, u, smem);
  }
}

struct FinPre { f32x4 x0[4]; };
DI void fin_prefetch(const Params& p, FinPre& fp) {
  int tid_ = threadIdx.x; asm volatile("" : "+v"(tid_));
  const int lane = tid_ & 63, wid = __builtin_amdgcn_readfirstlane((tid_ & 511) >> 6);
  const float* xi_ = p.x + (size_t)((int)blockIdx.x * 8 + wid) * 1024;
#pragma unroll
  for (int i = 0; i < 4; ++i) fp.x0[i] = *(const f32x4*)(xi_ + i * 256 + lane * 4);
}
template <bool PRE>
DI void phase_final(const Params& p, const FinPre& fp) {
  int tid_ = threadIdx.x; asm volatile("" : "+v"(tid_));
  const int tid = tid_ & 511, lane = tid & 63, wid = __builtin_amdgcn_readfirstlane(tid >> 6);
  const float* PSS = (const float*)(p.ws + WS_PSS);
  const int G = gridDim.x;
  f32x4 g[4];
#pragma unroll
  for (int i = 0; i < 4; ++i) g[i] = *(const f32x4*)(p.norm_post + i * 256 + lane * 4);
#define FIN_LOAD(Y, X, S, u_) do { const int row_ = (u_) * 8 + wid; \
    S = (lane < 16) ? PSS[(size_t)row_ * 16 + lane] : 0.f; \
    const f16* yi_ = (const f16*)(p.ws + WS_Y) + (size_t)row_ * 1024; const float* xi_ = p.x + (size_t)row_ * 1024; \
    _Pragma("unroll") for (int i = 0; i < 4; ++i) { Y[i] = *(const f16x4*)(yi_ + i * 256 + lane * 4); X[i] = *(const f32x4*)(xi_ + i * 256 + lane * 4); } } while (0)
#define FIN_ROW(Y, X, S, u_) do { float ss_ = S; \
    _Pragma("unroll") for (int o = 8; o >= 1; o >>= 1) ss_ += __shfl_xor(ss_, o); \
    ss_ = __shfl(ss_, 0); \
    const float rstd_ = rsqrtf(ss_ * (1.f / 1024.f) + 1e-6f); \
    float* yo_ = p.out + (size_t)((u_) * 8 + wid) * 1024; \
    _Pragma("unroll") for (int i = 0; i < 4; ++i) { const f16x4 y_ = Y[i]; f32x4 r_; \
      r_[0] = X[i][0] + (float)y_[0] * rstd_ * g[i][0]; r_[1] = X[i][1] + (float)y_[1] * rstd_ * g[i][1]; \
      r_[2] = X[i][2] + (float)y_[2] * rstd_ * g[i][2]; r_[3] = X[i][3] + (float)y_[3] * rstd_ * g[i][3]; \
      *(f32x4*)(yo_ + i * 256 + lane * 4) = r_; } } while (0)
  f16x4 ya[4], yb[4]; f32x4 xa[4], xb[4]; float sa = 0.f, sb = 0.f;
  int u = blockIdx.x;
  if (u < NTOK / 8) {
    if (PRE && wid != 0) {
      const int row_ = u * 8 + wid; sa = (lane < 16) ? PSS[(size_t)row_ * 16 + lane] : 0.f;
      const f16* yi_ = (const f16*)(p.ws + WS_Y) + (size_t)row_ * 1024;
#pragma unroll
      for (int i = 0; i < 4; ++i) { ya[i] = *(const f16x4*)(yi_ + i * 256 + lane * 4); xa[i] = fp.x0[i]; }
    } else FIN_LOAD(ya, xa, sa, u);
  }
  while (u < NTOK / 8) {
    { const int un = u + G; if (un < NTOK / 8) FIN_LOAD(yb, xb, sb, un); FIN_ROW(ya, xa, sa, u); u = un; }
    if (u >= NTOK / 8) break;
    { const int un = u + G; if (un < NTOK / 8) FIN_LOAD(ya, xa, sa, un); FIN_ROW(yb, xb, sb, u); u = un; }
  }
#undef FIN_LOAD
#undef FIN_ROW
}

#define XB_TMO      128
#define XB_XCNT(j)  (256  + 64 * (j))
#define XB_XSUB(j)  (1280 + 64 * (j))
#define XB_XGEN(j)  (2304 + 64 * (j))
#define XB_TOP      3328
#define XB_TOPGEN   3392
#define XCD_BAR_WORDS 3456
#define XB_SPIN_CAP (1u << 22)
DI unsigned xb_ld(unsigned* p) { return __hip_atomic_load(p, __ATOMIC_RELAXED, __HIP_MEMORY_SCOPE_AGENT); }
DI unsigned xb_add(unsigned* p, unsigned v) { return __hip_atomic_fetch_add(p, v, __ATOMIC_RELAXED, __HIP_MEMORY_SCOPE_AGENT); }
DI unsigned xb_xcc_id() { return (unsigned)__builtin_amdgcn_s_getreg((3 << 11) | 20) & 0xFu; }
#define XB_SPIN(cond, bar) do { unsigned _sp = 0; while (cond) { __builtin_amdgcn_s_sleep(1); \
    if ((++_sp & 255u) == 0u) { if (xb_ld(&(bar)[XB_TMO])) break; if (_sp > XB_SPIN_CAP) { atomicAdd(&(bar)[XB_TMO], 1u); break; } } } } while (0)
struct XcdBarrier { unsigned* bar; unsigned x; volatile LAS unsigned* st; };
DI XcdBarrier xcd_barrier_post(unsigned* bar, volatile LAS unsigned* st) {
  XcdBarrier b; b.bar = bar; b.x = xb_xcc_id(); b.st = st;
  if (threadIdx.x == 0) (void)xb_add(&bar[XB_XCNT(b.x)], 1u);
  return b;
}
DI void xcd_barrier_complete(unsigned* bar, unsigned x, unsigned& nloc, unsigned& nx) {
  const unsigned G = gridDim.x * gridDim.y * gridDim.z;
  unsigned sum, cnt, mine, sp = 0u;
  for (;;) {
    sum = 0u; cnt = 0u; mine = 0u;
#pragma unroll
    for (unsigned j = 0; j < 16; ++j) { const unsigned c = xb_ld(&bar[XB_XCNT(j)]); sum += c; cnt += (c > 0u) ? 1u : 0u; mine = (j == x) ? c : mine; }
    if (sum == G) break;
    __builtin_amdgcn_s_sleep(1);
    if ((++sp & 255u) == 0u) { if (xb_ld(&bar[XB_TMO])) break; if (sp > XB_SPIN_CAP) { atomicAdd(&bar[XB_TMO], 1u); break; } }
  }
  nloc = mine > 0u ? mine : 1u; nx = cnt > 0u ? cnt : 1u;
}
struct XbNone { DI void operator()() const {} };
template <class F>
DI void xcd_barrier(const XcdBarrier& b, const F& during) {
  asm volatile("s_waitcnt vmcnt(0)" ::: "memory");
  __syncthreads();
  if (threadIdx.x >= 64) during();
  if (threadIdx.x == 0) {
    unsigned* bar = b.bar;
    __builtin_amdgcn_s_waitcnt(0);
    unsigned nloc = b.st[0], nx = b.st[1];
    if (nloc == 0u) { xcd_barrier_complete(bar, b.x, nloc, nx); b.st[0] = nloc; b.st[1] = nx; }
    const unsigned old = xb_add(&bar[XB_XSUB(b.x)], 1u);
    const unsigned gen = old / nloc;
    if (old + 1u == (gen + 1u) * nloc) {
      __builtin_amdgcn_fence(__ATOMIC_RELEASE, "agent");
      asm volatile("s_waitcnt vmcnt(0)" ::: "memory");
      const unsigned og = xb_add(&bar[XB_TOP], 1u);
      const unsigned tg = og / nx;
      if (og + 1u == (tg + 1u) * nx) xb_add(&bar[XB_TOPGEN], 1u);
      else XB_SPIN(xb_ld(&bar[XB_TOPGEN]) == tg, bar);
      __builtin_amdgcn_fence(__ATOMIC_ACQUIRE, "agent");
      asm volatile("s_waitcnt vmcnt(0)" ::: "memory");
    } else {
      XB_SPIN(xb_ld(&bar[XB_TOPGEN]) == gen, bar);
      __builtin_amdgcn_fence(__ATOMIC_ACQUIRE, "agent");
      asm volatile("s_waitcnt vmcnt(0)" ::: "memory");
    }
  }
  __syncthreads();
}
DI void xcd_barrier(const XcdBarrier& b) { xcd_barrier(b, XbNone()); }

template <int PH>
__global__ void __launch_bounds__(512, 2) hybrid_kernel(Params p) {
  __shared__ __attribute__((aligned(16))) char smem[LDS_BYTES];
  if (PH == -1) {
    unsigned* bar = (unsigned*)(p.ws + WS_BAR);
    volatile LAS unsigned* xst = (volatile LAS unsigned*)(smem + LDS_IMG);
    if (threadIdx.x == 0) { xst[0] = 0u; xst[1] = 0u; }
    __syncthreads();
    XcdBarrier xb = xcd_barrier_post(bar, xst);
    phase_prep(p, smem); xcd_barrier(xb);
    phase_gemm1(p, smem); xcd_barrier(xb);
    phase_attn(p, smem, 0, ATTN_UNITS, 0); xcd_barrier(xb);
    phase_gemm2(p, smem);
    FinPre fp;
#pragma unroll
    for (int i = 0; i < 4; ++i) fp.x0[i] = (f32x4){0.f, 0.f, 0.f, 0.f};
    xcd_barrier(xb, [&]() { fin_prefetch(p, fp); });
    phase_final<true>(p, fp);
  } else {
    if (PH == 0) phase_prep(p, smem);
    if (PH == 1) phase_gemm1(p, smem);
    if (PH == 3) phase_attn(p, smem, 0, ATTN_UNITS, 0);
    if (PH == 4) phase_gemm2(p, smem);
    if (PH == 5) { FinPre fp; phase_final<false>(p, fp); }
  }
}

extern "C" void kernel_launch(void* const* d_in, const int* in_sizes, int n_in, void* d_out, int out_size, void* d_ws, size_t ws_size, hipStream_t stream) {
  if (ws_size < WS_END) { fprintf(stderr, "kernel_launch: workspace too small: %zu < %zu\n", ws_size, (size_t)WS_END); return; }
  Params p{};
  p.x = (const float*)d_in[0]; p.mem = (const float*)d_in[1]; p.pos = (const int*)d_in[2]; p.norm_pre = (const float*)d_in[3]; p.w_in = (const float*)d_in[4];
  p.cpk = (const float*)d_in[5]; p.w1k = (const float*)d_in[6]; p.w2k = (const float*)d_in[7]; p.cpv = (const float*)d_in[8]; p.w1v = (const float*)d_in[9]; p.w2v = (const float*)d_in[10];
  p.ret_gn = (const float*)d_in[11]; p.mem_norm = (const float*)d_in[12]; p.w_mem_kv = (const float*)d_in[13]; p.w_out = (const float*)d_in[14]; p.norm_post = (const float*)d_in[15];
  p.out = (float*)d_out; p.ws = (char*)d_ws;
#if MEGA
  static int grid_blocks = 0;
  if (!grid_blocks) {
    int dev = 0, cus = 0, per_cu = 0;
    hipGetDevice(&dev); hipDeviceGetAttribute(&cus, hipDeviceAttributeMultiprocessorCount, dev);
    hipOccupancyMaxActiveBlocksPerMultiprocessor(&per_cu, hybrid_kernel<-1>, 512, 0);
    if (per_cu < 1) { fprintf(stderr, "kernel_launch: occupancy query returned %d\n", per_cu); return; }
    grid_blocks = cus;
  }
  (void)hipMemsetAsync(p.ws + WS_CTR, 0, WS_Y - WS_CTR, stream);
  hipLaunchKernelGGL(hybrid_kernel<-1>, dim3(grid_blocks), dim3(512), 0, stream, p);
  hipError_t e = hipGetLastError();
  if (e != hipSuccess) fprintf(stderr, "launch failed: %s (grid %d)\n", hipGetErrorString(e), grid_blocks);
#else
  hipLaunchKernelGGL(hybrid_kernel<0>, dim3(256), dim3(512), 0, stream, p);
  if (PROBE_DUP == 0) hipLaunchKernelGGL(hybrid_kernel<0>, dim3(256), dim3(512), 0, stream, p);
  hipLaunchKernelGGL(hybrid_kernel<1>, dim3(256), dim3(512), 0, stream, p);
  if (PROBE_DUP == 1) hipLaunchKernelGGL(hybrid_kernel<1>, dim3(256), dim3(512), 0, stream, p);
  hipLaunchKernelGGL(hybrid_kernel<3>, dim3(256), dim3(512), 0, stream, p);
  if (PROBE_DUP == 3) { Params q = p; q.dry = PROBE_ATT; (void)hipMemsetAsync(p.ws + WS_CTR, 0, 4, stream); hipLaunchKernelGGL(hybrid_kernel<3>, dim3(256), dim3(512), 0, stream, q); }
  hipLaunchKernelGGL(hybrid_kernel<4>, dim3(256), dim3(512), 0, stream, p);
  if (PROBE_DUP == 4) hipLaunchKernelGGL(hybrid_kernel<4>, dim3(256), dim3(512), 0, stream, p);
  hipLaunchKernelGGL(hybrid_kernel<5>, dim3(256), dim3(512), 0, stream, p);
#endif
}
```
